# Optimizing an MI355X kernel written in HIP

```python
import math
import jax, jax.numpy as jnp
from jax import lax
import numpy as np

D_MODEL = 1024
BATCH = 8
SEQ = 8192
DEPTH = 2

N_MIXERS = 2
MEM_LEN = 256
HEAD_DIM = 64
MIX_WIDTH = D_MODEL
MEM_HEADS = 4
MEM_WIDTH = MEM_HEADS * HEAD_DIM
TOK_WIDTH = MIX_WIDTH - MEM_WIDTH
LRU_BLOCKS = TOK_WIDTH // HEAD_DIM
LRU_BLOCK = TOK_WIDTH // LRU_BLOCKS
CONV_W = 4
LRU_C = 8.0
ATTN_HEADS = TOK_WIDTH // HEAD_DIM
KV_LATENT = 128
IDX_HEADS = 4
IDX_DIM = 64
TOPK_MAX = 256
Q_BLOCK = 128
REL_BUCKETS = 32
REL_MAX_DIST = 128
N_EXPERTS = 32
TOP_K = 4
D_EXPERT = D_MODEL
SWIGLU_LIMIT = 7.0
SWIGLU_ALPHA = 1.702
EXPERT_BLOCK = 128
DN_ALPHA = (2 * DEPTH) ** 0.25
DN_BETA = (8 * DEPTH) ** -0.25
N_A = (DEPTH + 1) // 2
N_B = DEPTH // 2
W_IN_A = 2 * TOK_WIDTH + MEM_WIDTH
B_SPLITS = [TOK_WIDTH, TOK_WIDTH + KV_LATENT, TOK_WIDTH + KV_LATENT + IDX_HEADS * IDX_DIM,
            TOK_WIDTH + KV_LATENT + IDX_HEADS * IDX_DIM + IDX_DIM,
            TOK_WIDTH + KV_LATENT + IDX_HEADS * IDX_DIM + IDX_DIM + IDX_HEADS]
W_IN_B = B_SPLITS[-1] + MEM_WIDTH

kernel_name = "hybrid_rglru_dsa_moe_block"


def layer_norm(x, g, b, eps=1e-5):
    xf = x.astype(jnp.float32)
    mu = jnp.mean(xf, axis=-1, keepdims=True)
    xc = xf - mu
    var = jnp.mean(xc * xc, axis=-1, keepdims=True)
    return (xc * lax.rsqrt(var + eps) * g + b).astype(x.dtype)


def rms_norm(x, g, eps=1e-6):
    xf = x.astype(jnp.float32)
    return (xf * lax.rsqrt(jnp.mean(xf * xf, axis=-1, keepdims=True) + eps) * g).astype(x.dtype)


def t5_bucket(rel):
    n = jnp.maximum(rel, 0)
    max_exact = REL_BUCKETS // 2
    large = max_exact + (jnp.log(jnp.maximum(n, 1).astype(jnp.float32) / max_exact)
                         / math.log(REL_MAX_DIST / max_exact) * (REL_BUCKETS - max_exact)).astype(jnp.int32)
    large = jnp.minimum(large, REL_BUCKETS - 1)
    return jnp.where(n < max_exact, n, large)


def causal_dwconv(x, w, b):
    C = x.shape[-1]
    y = lax.conv_general_dilated(x, w[:, None, :], window_strides=(1,), padding=[(CONV_W - 1, 0)],
                                 dimension_numbers=('NWC', 'WIO', 'NWC'), feature_group_count=C)
    return y + b


def rg_lru(xc, w_r, b_r, w_i, b_i, lam):
    B_, S_, C = xc.shape
    xb = xc.reshape(B_, S_, LRU_BLOCKS, LRU_BLOCK)
    r = jax.nn.sigmoid(jnp.einsum('bsnc,ncd->bsnd', xb, w_r).reshape(B_, S_, C) + b_r)
    i = jax.nn.sigmoid(jnp.einsum('bsnc,ncd->bsnd', xb, w_i).reshape(B_, S_, C) + b_i)
    log_a = -LRU_C * r.astype(jnp.float32) * jax.nn.softplus(-lam.astype(jnp.float32))
    a = jnp.exp(log_a)
    u = jnp.sqrt(-jnp.expm1(2.0 * log_a)) * (i * xc).astype(jnp.float32)

    def combine(e1, e2):
        return (e1[0] * e2[0], e2[0] * e1[1] + e2[1])

    _, h = lax.associative_scan(combine, (a, u), axis=1)
    return h.astype(xc.dtype)


def memory_cross_attention(q, mem, w_mem_kv):
    B_, S_ = q.shape[:2]
    k, v = jnp.split(mem @ w_mem_kv, 2, axis=-1)
    qh = q.reshape(B_, S_, MEM_HEADS, HEAD_DIM)
    kh = k.reshape(B_, -1, MEM_HEADS, HEAD_DIM)
    vh = v.reshape(B_, -1, MEM_HEADS, HEAD_DIM)
    logits = jnp.einsum('bshd,bmhd->bhsm', qh, kh).astype(jnp.float32) * HEAD_DIM ** -0.5
    p = jax.nn.softmax(logits, axis=-1).astype(vh.dtype)
    return jnp.einsum('bhsm,bmhd->bshd', p, vh).reshape(B_, S_, MEM_WIDTH)


def dsa_attention(q, c_kv, iq, ik, iw, w_uk, w_uv, rel_bias):
    B_, S_ = c_kv.shape[:2]
    k_sel = min(TOPK_MAX, S_ // 4)
    nqb = S_ // Q_BLOCK
    q_lat = jnp.einsum('bshd,rhd->bshr', q, w_uk) * HEAD_DIM ** -0.5
    iw = iw.astype(jnp.float32) * (IDX_HEADS ** -0.5 * IDX_DIM ** -0.5)
    key_pos = jnp.arange(S_, dtype=jnp.int32)

    def to_blocks(t):
        return jnp.moveaxis(t.reshape(B_, nqb, Q_BLOCK, *t.shape[2:]), 1, 0)

    def block(args):
        ql, iqb, iwb, start = args
        qpos = start + jnp.arange(Q_BLOCK, dtype=jnp.int32)
        s = jnp.einsum('bqhd,bsd->bqhs', iqb, ik).astype(jnp.float32)
        score = jnp.einsum('bqhs,bqh->bqs', jax.nn.relu(s), iwb)
        score = jnp.where(key_pos[None, None, :] <= qpos[None, :, None], score, -jnp.inf)
        _, idx = lax.top_k(score, k_sel)
        c_sel = jax.vmap(lambda cb, ib: cb[ib])(c_kv, idx)
        rel = qpos[None, :, None] - idx
        bias = jnp.moveaxis(rel_bias[t5_bucket(rel)], -1, -2)
        logits = jnp.einsum('bqhr,bqkr->bqhk', ql, c_sel).astype(jnp.float32) + bias.astype(jnp.float32)
        logits = jnp.where((rel >= 0)[:, :, None, :], logits, -jnp.inf)
        p = jax.nn.softmax(logits, axis=-1).astype(c_sel.dtype)
        o_lat = jnp.einsum('bqhk,bqkr->bqhr', p, c_sel)
        return jnp.einsum('bqhr,rhd->bqhd', o_lat, w_uv)

    starts = jnp.arange(nqb, dtype=jnp.int32) * Q_BLOCK
    out = lax.map(block, (to_blocks(q_lat), to_blocks(iq), to_blocks(iw), starts))
    return jnp.moveaxis(out, 0, 1).reshape(B_, S_, ATTN_HEADS * HEAD_DIM)


def moe(x, router_w, router_b, w1, b1, w2, b2):
    B_, S_, D = x.shape
    xt = x.reshape(-1, D)
    T = xt.shape[0]
    logits = (xt @ router_w + router_b).astype(jnp.float32)
    top_v, top_e = lax.top_k(logits, TOP_K)
    gate = jax.nn.softmax(top_v, axis=-1)
    A = T * TOP_K
    e_flat = top_e.reshape(-1)
    g_flat = gate.reshape(-1).astype(x.dtype)
    tok_flat = jnp.arange(A, dtype=jnp.int32) // TOP_K
    order = jnp.argsort(e_flat)
    se = e_flat[order]
    counts = jnp.bincount(e_flat, length=N_EXPERTS)
    padded = (counts + EXPERT_BLOCK - 1) // EXPERT_BLOCK * EXPERT_BLOCK
    pend = jnp.cumsum(padded)
    pstart = pend - padded
    ustart = jnp.cumsum(counts) - counts
    dest = pstart[se] + jnp.arange(A, dtype=jnp.int32) - ustart[se]
    nblk = -(-A // EXPERT_BLOCK) + N_EXPERTS
    P = nblk * EXPERT_BLOCK
    row_tok = jnp.zeros((P,), jnp.int32).at[dest].set(tok_flat[order])
    row_g = jnp.zeros((P,), x.dtype).at[dest].set(g_flat[order])
    blk_e = jnp.minimum(jnp.searchsorted(pend, jnp.arange(nblk, dtype=jnp.int32) * EXPERT_BLOCK, side='right'),
                        N_EXPERTS - 1)

    def expert_block(args):
        tok, g, e = args
        h = xt[tok] @ w1[e] + b1[e]
        gt = jnp.minimum(h[:, :D_EXPERT], SWIGLU_LIMIT)
        up = jnp.clip(h[:, D_EXPERT:], -SWIGLU_LIMIT, SWIGLU_LIMIT)
        act = (up + 1.0) * (gt * jax.nn.sigmoid(SWIGLU_ALPHA * gt))
        return (act @ w2[e] + b2[e]) * g[:, None]

    y = lax.map(expert_block, (row_tok.reshape(nblk, EXPERT_BLOCK), row_g.reshape(nblk, EXPERT_BLOCK), blk_e))
    y = jax.ops.segment_sum(y.reshape(P, D), row_tok, num_segments=T)
    return y.reshape(B_, S_, D)


def setup_inputs(seed: int = 0) -> dict:
    key = jax.random.key(seed)
    ks = jax.random.split(key, 32)
    f32 = jnp.float32

    def nrm(k, shape, scale):
        return jax.random.normal(k, shape, f32) * scale

    u = jax.random.uniform(ks[9], (N_A, TOK_WIDTH), f32, 0.9, 0.999)
    p = u ** (1.0 / LRU_C)
    a_lambda = jnp.log(p) - jnp.log1p(-p)
    mem_kv_scale = jnp.concatenate([jnp.ones((MEM_WIDTH,), f32), jnp.full((MEM_WIDTH,), DN_BETA, f32)])
    return {
        'x': nrm(ks[0], (BATCH, SEQ, D_MODEL), 1.0),
        'mem': nrm(ks[1], (BATCH, MEM_LEN, D_MODEL), 1.0),
        'rel_bias': nrm(ks[2], (REL_BUCKETS, ATTN_HEADS), 0.5),
        'a_w_in': nrm(ks[3], (N_A, D_MODEL, W_IN_A), D_MODEL ** -0.5),
        'a_conv_w': nrm(ks[4], (N_A, CONV_W, TOK_WIDTH), CONV_W ** -0.5),
        'a_conv_b': nrm(ks[5], (N_A, TOK_WIDTH), 0.01),
        'a_wr': nrm(ks[6], (N_A, LRU_BLOCKS, LRU_BLOCK, LRU_BLOCK), LRU_BLOCK ** -0.5),
        'a_br': nrm(ks[7], (N_A, TOK_WIDTH), 0.01),
        'a_wi': nrm(ks[8], (N_A, LRU_BLOCKS, LRU_BLOCK, LRU_BLOCK), LRU_BLOCK ** -0.5),
        'a_bi': nrm(ks[10], (N_A, TOK_WIDTH), 0.01),
        'a_lambda': a_lambda,
        'b_w_in': nrm(ks[11], (N_B, D_MODEL, W_IN_B), D_MODEL ** -0.5),
        'b_kv_norm_g': 1.0 + nrm(ks[12], (N_B, KV_LATENT), 0.01),
        'b_w_uk': nrm(ks[13], (N_B, KV_LATENT, ATTN_HEADS, HEAD_DIM), KV_LATENT ** -0.5),
        'b_w_uv': nrm(ks[14], (N_B, KV_LATENT, ATTN_HEADS, HEAD_DIM), KV_LATENT ** -0.5 * DN_BETA),
        'b_idx_norm_g': 1.0 + nrm(ks[15], (N_B, IDX_DIM), 0.01),
        'b_idx_norm_b': nrm(ks[16], (N_B, IDX_DIM), 0.01),
        'w_mem_kv': nrm(ks[17], (DEPTH, D_MODEL, 2 * MEM_WIDTH), D_MODEL ** -0.5) * mem_kv_scale,
        'w_out': nrm(ks[18], (DEPTH, MIX_WIDTH, D_MODEL), MIX_WIDTH ** -0.5 * DN_BETA),
        'ln1_g': 1.0 + nrm(ks[19], (DEPTH, D_MODEL), 0.01),
        'ln1_b': nrm(ks[20], (DEPTH, D_MODEL), 0.01),
        'router_w': nrm(ks[21], (DEPTH, D_MODEL, N_EXPERTS), D_MODEL ** -0.5),
        'router_b': nrm(ks[22], (DEPTH, N_EXPERTS), 0.01),
        'exp_w1': nrm(ks[23], (DEPTH, N_EXPERTS, D_MODEL, 2 * D_EXPERT), D_MODEL ** -0.5),
        'exp_b1': nrm(ks[24], (DEPTH, N_EXPERTS, 2 * D_EXPERT), 0.01),
        'exp_w2': nrm(ks[25], (DEPTH, N_EXPERTS, D_EXPERT, D_MODEL), D_EXPERT ** -0.5 * DN_BETA),
        'exp_b2': nrm(ks[26], (DEPTH, N_EXPERTS, D_MODEL), 0.01),
        'ln2_g': 1.0 + nrm(ks[27], (DEPTH, D_MODEL), 0.01),
        'ln2_b': nrm(ks[28], (DEPTH, D_MODEL), 0.01),
    }


def reference(x, mem, rel_bias, a_w_in, a_conv_w, a_conv_b, a_wr, a_br, a_wi, a_bi, a_lambda,
              b_w_in, b_kv_norm_g, b_w_uk, b_w_uv, b_idx_norm_g, b_idx_norm_b,
              w_mem_kv, w_out, ln1_g, ln1_b, router_w, router_b, exp_w1, exp_b1, exp_w2, exp_b2,
              ln2_g, ln2_b):
    B_, S_, _ = x.shape
    for layer in range(DEPTH):
        j = layer // N_MIXERS
        if layer % N_MIXERS == 0:
            proj = x @ a_w_in[j]
            xb, gb, mq = jnp.split(proj, [TOK_WIDTH, 2 * TOK_WIDTH], axis=-1)
            xc = causal_dwconv(xb, a_conv_w[j], a_conv_b[j])
            h = rg_lru(xc, a_wr[j], a_br[j], a_wi[j], a_bi[j], a_lambda[j])
            tok = h * jax.nn.gelu(gb)
        else:
            proj = x @ b_w_in[j]
            q, c, iq, ik, iw, mq = jnp.split(proj, B_SPLITS, axis=-1)
            q = q.reshape(B_, S_, ATTN_HEADS, HEAD_DIM)
            c = rms_norm(c, b_kv_norm_g[j])
            iq = iq.reshape(B_, S_, IDX_HEADS, IDX_DIM)
            ik = layer_norm(ik, b_idx_norm_g[j], b_idx_norm_b[j])
            tok = dsa_attention(q, c, iq, ik, iw, b_w_uk[j], b_w_uv[j], rel_bias)
        mix = jnp.concatenate([tok, memory_cross_attention(mq, mem, w_mem_kv[layer])], axis=-1)
        x = layer_norm(DN_ALPHA * x + mix @ w_out[layer], ln1_g[layer], ln1_b[layer])
        ffn = moe(x, router_w[layer], router_b[layer], exp_w1[layer], exp_b1[layer], exp_w2[layer], exp_b2[layer])
        x = layer_norm(DN_ALPHA * x + ffn, ln2_g[layer], ln2_b[layer])
    return x
```

```cpp
#include <hip/hip_runtime.h>
#include <cstdio>
#include <cstdint>

#ifndef DIAG_INIT
#define DIAG_INIT 0
#endif
#ifndef DIAG_LAST
#define DIAG_LAST 17
#endif
#ifndef DIAG_DUMP
#define DIAG_DUMP 0
#define DIAG_SKIPMEM 0
#define DIAG_WUVQ 0
#endif
#ifndef PROBE_CHECK
#define PROBE_CHECK 0
#endif
#ifndef PROBE_SEL
#define PROBE_SEL 0
#endif
#ifndef PROBE_PASS3
#define PROBE_PASS3 0
#endif
#ifndef PROBE_NOFB
#define PROBE_NOFB 0
#endif
#ifndef PROBE_NORETRY
#define PROBE_NORETRY 0
#endif
#ifndef PROBE_DSA
#define PROBE_DSA 0
#endif
#ifndef PROBE_SEL2
#define PROBE_SEL2 0
#endif
#ifndef MK_SPLIT
#define MK_SPLIT 0
#endif

#ifndef DBL_MASK
#define DBL_MASK 0
#endif
#define DBL(site) ((((unsigned)DBL_MASK) >> (site)) & 1u)

#define LAS __attribute__((address_space(3)))
#define GAS __attribute__((address_space(1)))
typedef unsigned short bf16_t;
typedef short bf16x8 __attribute__((ext_vector_type(8)));
typedef short s16x4 __attribute__((ext_vector_type(4)));
typedef float f32x4 __attribute__((ext_vector_type(4)));
typedef float f32x2 __attribute__((ext_vector_type(2)));
typedef unsigned u32x4 __attribute__((ext_vector_type(4)));
typedef unsigned u32x2 __attribute__((ext_vector_type(2)));
#define DI __device__ __forceinline__
#define MFMA16(a, b, c) __builtin_amdgcn_mfma_f32_16x16x32_bf16((a), (b), (c), 0, 0, 0)

constexpr int D = 1024, NB = 8, SEQ = 8192, T = NB * SEQ;
constexpr int TOKW = 768, MEMW = 256, MEML = 256;
constexpr int WINA = 1792, WINB = 1476, WINBP = 1536;
constexpr int NEXP = 32, DEXP = 1024;
constexpr float LN_EPS = 1e-5f;
constexpr float DN_ALPHA = 1.41421356237309515f;
constexpr int PMAX = 270336;
constexpr int B_C = 768, B_IQ = 896, B_IK = 1152, B_MQ = 1216, B_IW = 1472;

constexpr size_t MiB = 1u << 20;
constexpr size_t WS_CTL = 0, CTL_BYTES = 1 * MiB;
constexpr size_t WS_WINA = 1 * MiB;
constexpr size_t WS_WINB = 5 * MiB;
constexpr size_t WS_WKV = 8 * MiB;
constexpr size_t WS_WOUT = 10 * MiB;
constexpr size_t WS_WRT = 14 * MiB;
constexpr size_t WS_WUK = 14 * MiB + 256 * 1024;
constexpr size_t WS_WUVT = 14 * MiB + 512 * 1024;
constexpr size_t WS_ROUT = 15 * MiB;
constexpr size_t WS_MEMBF = 16 * MiB;
constexpr size_t WS_KV = 20 * MiB;
constexpr size_t WS_LSUM = 24 * MiB;
constexpr size_t WS_LIST = 32 * MiB;
constexpr size_t WS_TOKSLOT = 40 * MiB;
constexpr size_t WS_TOKGATE = 41 * MiB;
constexpr size_t WS_CN = 48 * MiB;
constexpr size_t WS_IKN = 64 * MiB;
constexpr size_t WS_IDX = 72 * MiB;
constexpr size_t WS_W1 = 112 * MiB;
constexpr size_t WS_W2 = 368 * MiB;
constexpr size_t WS_XB8 = 240 * MiB;
constexpr size_t WS_XA = 496 * MiB;
constexpr size_t WS_XBF = 752 * MiB;
constexpr size_t WS_ACT = 880 * MiB;
constexpr size_t WS_QLAT = WS_ACT, WS_OLAT = WS_ACT + 192 * MiB;
constexpr size_t WS_PROJ = 1408 * MiB;
constexpr size_t WS_MIX = 1632 * MiB;
constexpr size_t WS_Z = 1760 * MiB;
constexpr size_t WS_Y = 1408 * MiB;
constexpr size_t WS_END = 2016 * MiB;
constexpr int CW_BAR = 4096;
constexpr int CW_ERR = 8192;
constexpr int CW_CNT = 16384;
constexpr int CW_IQ = 20480;

constexpr int STAGE_BYTES = 131072;
constexpr int TOKTAB_OFF = STAGE_BYTES;
constexpr int LDS_BYTES = 163840;
constexpr int GMTAB_OFF = STAGE_BYTES + 2048;
constexpr int MISC_OFF = LDS_BYTES - 2048;
constexpr int MTAB_OFF = MISC_OFF + 512;
constexpr int PTAB_OFF = MISC_OFF + 1024;

typedef __bf16 bf16x2_t __attribute__((ext_vector_type(2)));
DI unsigned cvt_pk_bf16(float lo, float hi) { const f32x2 v = {lo, hi}; const bf16x2_t r = __builtin_convertvector(v, bf16x2_t); return __builtin_bit_cast(unsigned, r); }
DI unsigned pk4_fp8(float a, float b, float c, float d) { unsigned w = 0u; w = (unsigned)__builtin_amdgcn_cvt_pk_fp8_f32(a, b, (int)w, false); w = (unsigned)__builtin_amdgcn_cvt_pk_fp8_f32(c, d, (int)w, true); return w; }
DI float bf2f(unsigned short b) { return __uint_as_float(((unsigned)b) << 16); }
DI float bflo(unsigned w) { return __uint_as_float(w << 16); }
DI float bfhi(unsigned w) { return __uint_as_float(w & 0xffff0000u); }
DI unsigned short f2bf(float f) { return (unsigned short)(cvt_pk_bf16(f, 0.f) & 0xffffu); }
DI float sigmoidf_(float x) { return __builtin_amdgcn_rcpf(1.0f + __expf(-x)); }
DI int shfl_lane() { unsigned m = 0xffffffffu; asm volatile("" : "+v"(m)); return (int)__builtin_amdgcn_mbcnt_hi(m, __builtin_amdgcn_mbcnt_lo(m, 0u)); }
DI float shx(float v, int o) { return __int_as_float(__builtin_amdgcn_ds_bpermute((shfl_lane() ^ o) << 2, __float_as_int(v))); }
DI int shup_i(int v, int o) { return __builtin_amdgcn_ds_bpermute((shfl_lane() - o) << 2, v); }
DI float rows4_max(float x) { unsigned u = __float_as_uint(x);
    auto a = __builtin_amdgcn_permlane16_swap(u, u, false, false); float m = fmaxf(__uint_as_float(a[0]), __uint_as_float(a[1])); u = __float_as_uint(m);
    auto b = __builtin_amdgcn_permlane32_swap(u, u, false, false); return fmaxf(__uint_as_float(b[0]), __uint_as_float(b[1])); }
DI float rows4_sum(float x) { unsigned u = __float_as_uint(x);
    auto a = __builtin_amdgcn_permlane16_swap(u, u, false, false); float m = __uint_as_float(a[0]) + __uint_as_float(a[1]); u = __float_as_uint(m);
    auto b = __builtin_amdgcn_permlane32_swap(u, u, false, false); return __uint_as_float(b[0]) + __uint_as_float(b[1]); }
DI float wave_sum(float v) {
#pragma unroll
    for (int o = 1; o < 64; o <<= 1) v += shx(v, o);
    return v;
}
DI u32x4 zero4_local() { unsigned z = 0u; asm volatile("" : "+v"(z)); return (u32x4){z, z, z, z}; }
DI float wave_sum_fast(float v) {
    int x = __float_as_int(v);
#define WSF_STEP(ctrl) x = __float_as_int(__int_as_float(x) + __int_as_float(__builtin_amdgcn_update_dpp(0, x, ctrl, 0xf, 0xf, true)));
    WSF_STEP(0x101) WSF_STEP(0x102) WSF_STEP(0x104) WSF_STEP(0x108)
#undef WSF_STEP
    return (__int_as_float(__builtin_amdgcn_readlane(x, 0)) + __int_as_float(__builtin_amdgcn_readlane(x, 16))) + (__int_as_float(__builtin_amdgcn_readlane(x, 32)) + __int_as_float(__builtin_amdgcn_readlane(x, 48)));
}
#define LDS_WAIT() asm volatile("s_waitcnt lgkmcnt(0)" ::: "memory")
#define VM_WAIT() asm volatile("s_waitcnt vmcnt(0)" ::: "memory")

#define XB_TMO      128
#define XB_XCNT(j)  (256  + 64 * (j))
#define XB_XSUB(j)  (1280 + 64 * (j))
#define XB_XGEN(j)  (2304 + 64 * (j))
#define XB_TOP      3328
#define XB_TOPGEN   3392
#define XCD_BAR_WORDS 3456
#define XB_SPIN_CAP (1u << 22)

DI unsigned xb_ld(unsigned* p)              { return __hip_atomic_load(p, __ATOMIC_RELAXED, __HIP_MEMORY_SCOPE_AGENT); }
DI unsigned xb_add(unsigned* p, unsigned v) { return __hip_atomic_fetch_add(p, v, __ATOMIC_RELAXED, __HIP_MEMORY_SCOPE_AGENT); }
DI unsigned xb_xcc_id() { return (unsigned)__builtin_amdgcn_s_getreg((3 << 11) | 20) & 0xFu; }
#define XB_SPIN(cond, bar) do { unsigned _sp = 0; while (cond) { __builtin_amdgcn_s_sleep(1); \
    if ((++_sp & 255u) == 0u) { if (xb_ld(&(bar)[XB_TMO])) break; if (_sp > XB_SPIN_CAP) { atomicAdd(&(bar)[XB_TMO], 1u); break; } } } } while (0)

struct XcdBarrier { unsigned* bar; unsigned x; volatile LAS unsigned* st; };

DI XcdBarrier xcd_barrier_post(unsigned* bar, volatile LAS unsigned* st) {
    XcdBarrier b; b.bar = bar; b.x = xb_xcc_id(); b.st = st;
    if (threadIdx.x == 0) (void)xb_add(&bar[XB_XCNT(b.x)], 1u);
    return b;
}
DI void xcd_barrier_complete(unsigned* bar, unsigned x, unsigned& nloc, unsigned& nx) {
    const unsigned G = gridDim.x * gridDim.y * gridDim.z;
    unsigned sum, cnt, mine, sp = 0u;
    for (;;) {
        sum = 0u; cnt = 0u; mine = 0u;
#pragma unroll
        for (unsigned j = 0; j < 16; ++j) { const unsigned c = xb_ld(&bar[XB_XCNT(j)]); sum += c; cnt += (c > 0u) ? 1u : 0u; mine = (j == x) ? c : mine; }
        if (sum == G) break;
        __builtin_amdgcn_s_sleep(1);
        if ((++sp & 255u) == 0u) { if (xb_ld(&bar[XB_TMO])) break; if (sp > XB_SPIN_CAP) { atomicAdd(&bar[XB_TMO], 1u); break; } }
    }
    nloc = mine > 0u ? mine : 1u; nx = cnt > 0u ? cnt : 1u;
}
DI void xcd_barrier(const XcdBarrier& b) {
    asm volatile("s_waitcnt vmcnt(0)" ::: "memory");
    __syncthreads();
    if (threadIdx.x == 0) {
        unsigned* bar = b.bar;
        __builtin_amdgcn_s_waitcnt(0);
        unsigned nloc = b.st[0], nx = b.st[1];
        if (nloc == 0u) { xcd_barrier_complete(bar, b.x, nloc, nx); b.st[0] = nloc; b.st[1] = nx; }
        const unsigned old = xb_add(&bar[XB_XSUB(b.x)], 1u);
        const unsigned gen = old / nloc;
        if (old + 1u == (gen + 1u) * nloc) {
            __builtin_amdgcn_fence(__ATOMIC_RELEASE, "agent");
            asm volatile("s_waitcnt vmcnt(0)" ::: "memory");
            const unsigned og = xb_add(&bar[XB_TOP], 1u);
            const unsigned tg = og / nx;
            if (og + 1u == (tg + 1u) * nx) xb_add(&bar[XB_TOPGEN], 1u);
            else XB_SPIN(xb_ld(&bar[XB_TOPGEN]) == tg, bar);
            __builtin_amdgcn_fence(__ATOMIC_ACQUIRE, "agent");
            xb_add(&bar[XB_XGEN(b.x)], 1u);
            asm volatile("s_waitcnt vmcnt(0)" ::: "memory");
        } else {
            XB_SPIN(xb_ld(&bar[XB_XGEN(b.x)]) == gen, bar);
            __builtin_amdgcn_fence(__ATOMIC_ACQUIRE, "agent");
            asm volatile("s_waitcnt vmcnt(0)" ::: "memory");
        }
    }
    __syncthreads();
}

namespace pg8 {
constexpr int BM = 256, BK = 64, HALF = 128, HTB = HALF * BK * 2;
DI int lds_byte(int r, int c) { const int st = (r >> 4) * 2 + (c >> 5), rr = r & 15, cc = c & 31, ob = rr * 64 + cc * 2; return st * 1024 + (ob ^ (((ob >> 9) & 1) << 5)); }
DI void stage_rc(int b, int& R, int& C) { const int st = b / 1024, sb = b % 1024, swz = sb ^ (((sb >> 9) & 1) << 5); R = (st >> 1) * 16 + swz / 64; C = (st & 1) * 32 + (swz % 64) / 2; }
DI int perm32(int rho) { const int n = rho >> 4, i = rho & 15; return 8 * (i >> 2) + 4 * n + (i & 3); }

struct Unit { int arow, brow, orow, ocol, e; };
struct Gemm { const void* A; const void* Bt; int K; const unsigned* list; const void* A2; const void* Bt2; int sa, sb; };

template <int nM, int nN, int nx2> struct DenseOrderT {
    static constexpr bool DUAL = true;
    static constexpr int nwg = nM * nN;
    int G, c;
    DI void init(int G_, int c_) { G = G_; c = c_; }
    DI bool next(int i, Unit& u) const {
        const int L = i * G + c; if (L >= nwg + nx2) return false;
        if (L >= nwg) { const int q = L - nwg; u.arow = (q >> 2) * BM; u.brow = (q & 3) * BM; u.orow = u.arow; u.ocol = u.brow; u.e = 1; return true; }
        int wgid = L; { constexpr int q = nwg / 8, r = nwg % 8; const int xcd = wgid % 8, off = wgid / 8; wgid = (xcd < r ? xcd * (q + 1) : r * (q + 1) + (xcd - r) * q) + off; }
        constexpr int nig = 8 * nN; const int gid = wgid / nig, fm = gid * 8, gsz = (nM - fm) < 8 ? (nM - fm) : 8;
        const int rem = wgid % nig; const int pm = fm + (gsz == 8 ? (rem & 7) : (rem % gsz)), pn = gsz == 8 ? (rem >> 3) : (rem / gsz);
        u.arow = pm * BM; u.brow = pn * BM; u.orow = pm * BM; u.ocol = pn * BM; u.e = 0; return true;
    }
};
template <int NN, bool GATHER> struct MoeOrder {
    static constexpr bool DUAL = false;
    const LAS int* mtab; const LAS unsigned* gmtab; int G, c, nrowsB;
    DI bool next(int i, Unit& u) const {
        constexpr int MG = 32 / NN;
        const int x = c & 7, j = c >> 3;
        const int per = G >> 3;
        const int TM = __builtin_amdgcn_readfirstlane(mtab[32]);
        const int slot = i * per + j;
        const int grp = (slot / 32) * 8 + x, within = slot % 32;
        const int gm = grp * MG + within / NN, pn = within % NN;
        if (gm >= TM) return false;
        const unsigned pk = (unsigned)__builtin_amdgcn_readfirstlane((int)gmtab[gm]);
        const int e = (int)(pk >> 16), mt = (int)(pk & 0xffffu);
        u.e = e; u.arow = GATHER ? (e * 65536 + mt * 256) : gm * 256; u.brow = e * nrowsB + pn * 256; u.orow = gm * 256; u.ocol = pn * 256; return true;
    }
};

template <bool DUALOUT> struct EpiBf16 {
    static constexpr bool PERM = true;
    bf16_t* O; int ldc; bf16_t* O2; int ldc2;
    DI void operator()(const f32x4 (&acc)[2][2][4][2], const Unit& u, int wr, int wc, int fr, int fq) const {
        const int row0 = u.orow + wr * 64 + fr, col0 = u.ocol + wc * 32 + 8 * fq;
        bf16_t* Ob = O; int ld = ldc; if (DUALOUT && u.e != 0) { Ob = O2; ld = ldc2; }
#pragma unroll
        for (int ai = 0; ai < 2; ++ai)
#pragma unroll
            for (int m = 0; m < 4; ++m) { bf16_t* rowp = Ob + (size_t)(row0 + ai * HALF + m * 16) * ld + col0;
#pragma unroll
                for (int bj = 0; bj < 2; ++bj) { const f32x4 v0 = acc[ai][bj][m][0], v1 = acc[ai][bj][m][1];
                    u32x4 w; w.x = cvt_pk_bf16(v0[0], v0[1]); w.y = cvt_pk_bf16(v0[2], v0[3]); w.z = cvt_pk_bf16(v1[0], v1[1]); w.w = cvt_pk_bf16(v1[2], v1[3]);
                    *(u32x4*)(rowp + bj * HALF) = w; } }
    }
};
struct EpiBf16Bias {
    static constexpr bool PERM = true;
    bf16_t* O; int ldc; const float* bias;
    DI void operator()(const f32x4 (&acc)[2][2][4][2], const Unit& u, int wr, int wc, int fr, int fq) const {
        const int row0 = u.orow + wr * 64 + fr, col0 = u.ocol + wc * 32 + 8 * fq;
        f32x4 bv[2][2];
#pragma unroll
        for (int bj = 0; bj < 2; ++bj) { bv[bj][0] = *(const f32x4*)(bias + u.e * 1024 + col0 + bj * HALF); bv[bj][1] = *(const f32x4*)(bias + u.e * 1024 + col0 + bj * HALF + 4); }
#pragma unroll
        for (int ai = 0; ai < 2; ++ai)
#pragma unroll
            for (int m = 0; m < 4; ++m) { bf16_t* rowp = O + (size_t)(row0 + ai * HALF + m * 16) * ldc + col0;
#pragma unroll
                for (int bj = 0; bj < 2; ++bj) { const f32x4 v0 = acc[ai][bj][m][0] + bv[bj][0], v1 = acc[ai][bj][m][1] + bv[bj][1];
                    u32x4 w; w.x = cvt_pk_bf16(v0[0], v0[1]); w.y = cvt_pk_bf16(v0[2], v0[3]); w.z = cvt_pk_bf16(v1[0], v1[1]); w.w = cvt_pk_bf16(v1[2], v1[3]);
                    *(u32x4*)(rowp + bj * HALF) = w; } }
    }
};
struct EpiFp8Bias {
    static constexpr bool PERM = true;
    unsigned char* O; int ldc; const float* bias;
    DI void operator()(const f32x4 (&acc)[2][2][4][2], const Unit& u, int wr, int wc, int fr, int fq) const {
        const int row0 = u.orow + wr * 64 + fr, col0 = u.ocol + wc * 32 + 8 * fq;
        f32x4 bv[2][2];
#pragma unroll
        for (int bj = 0; bj < 2; ++bj) { bv[bj][0] = *(const f32x4*)(bias + u.e * 1024 + col0 + bj * HALF); bv[bj][1] = *(const f32x4*)(bias + u.e * 1024 + col0 + bj * HALF + 4); }
#pragma unroll
        for (int ai = 0; ai < 2; ++ai)
#pragma unroll
            for (int m = 0; m < 4; ++m) { unsigned char* rowp = O + (size_t)(row0 + ai * HALF + m * 16) * ldc + col0;
#pragma unroll
                for (int bj = 0; bj < 2; ++bj) { const f32x4 v0 = (acc[ai][bj][m][0] + bv[bj][0]) * 16.0f, v1 = (acc[ai][bj][m][1] + bv[bj][1]) * 16.0f;
                    u32x2 w; w.x = pk4_fp8(v0[0], v0[1], v0[2], v0[3]); w.y = pk4_fp8(v1[0], v1[1], v1[2], v1[3]);
                    *(u32x2*)(rowp + bj * HALF) = w; } }
    }
};
struct EpiResF32 {
    static constexpr bool PERM = false;
    float* Z; const float* res; float alpha; const bf16_t* resb;
    DI void operator()(const f32x4 (&acc)[2][2][4][2], const Unit& u, int wr, int wc, int fr, int fq) const {
        const int row0 = u.orow + wr * 64 + fr, col0 = u.ocol + wc * 32 + 4 * fq;
#pragma unroll
        for (int ai = 0; ai < 2; ++ai)
#pragma unroll
            for (int m = 0; m < 4; ++m) { const size_t off = (size_t)(row0 + ai * HALF + m * 16) * D + col0;
#pragma unroll
                for (int bj = 0; bj < 2; ++bj)
#pragma unroll
                    for (int n = 0; n < 2; ++n) { f32x4 r;
                        if (resb) { const u32x2 rw = *(const u32x2*)(resb + off + bj * HALF + n * 16); r = (f32x4){bflo(rw.x), bfhi(rw.x), bflo(rw.y), bfhi(rw.y)}; }
                        else r = *(const f32x4*)(res + off + bj * HALF + n * 16);
                        *(f32x4*)(Z + off + bj * HALF + n * 16) = r * alpha + acc[ai][bj][m][n]; }
                asm volatile("" ::: "memory"); }
    }
};
struct EpiResBf16 {
    static constexpr bool PERM = true;
    bf16_t* Z; const float* res; float alpha; const bf16_t* resb;
    DI void operator()(const f32x4 (&acc)[2][2][4][2], const Unit& u, int wr, int wc, int fr, int fq) const {
        const int row0 = u.orow + wr * 64 + fr, col0 = u.ocol + wc * 32 + 8 * fq;
#pragma unroll
        for (int ai = 0; ai < 2; ++ai)
#pragma unroll
            for (int m = 0; m < 4; ++m) { const size_t off = (size_t)(row0 + ai * HALF + m * 16) * D + col0;
#pragma unroll
                for (int bj = 0; bj < 2; ++bj) { f32x4 r0, r1;
                    if (resb) { const u32x4 rw = *(const u32x4*)(resb + off + bj * HALF); r0 = (f32x4){bflo(rw.x), bfhi(rw.x), bflo(rw.y), bfhi(rw.y)}; r1 = (f32x4){bflo(rw.z), bfhi(rw.z), bflo(rw.w), bfhi(rw.w)}; }
                    else { r0 = *(const f32x4*)(res + off + bj * HALF); r1 = *(const f32x4*)(res + off + bj * HALF + 4); }
                    const f32x4 v0 = r0 * alpha + acc[ai][bj][m][0], v1 = r1 * alpha + acc[ai][bj][m][1];
                    u32x4 w; w.x = cvt_pk_bf16(v0[0], v0[1]); w.y = cvt_pk_bf16(v0[2], v0[3]); w.z = cvt_pk_bf16(v1[0], v1[1]); w.w = cvt_pk_bf16(v1[2], v1[3]);
                    *(u32x4*)(Z + off + bj * HALF) = w; }
                asm volatile("" ::: "memory"); }
    }
};
struct EpiSwiglu {
    static constexpr bool PERM = true;
    unsigned char* O; const float* b1;
    DI void operator()(const f32x4 (&acc)[2][2][4][2], const Unit& u, int wr, int wc, int fr, int fq) const {
        const int row0 = u.orow + wr * 64 + fr, g0 = (u.ocol >> 1) + wc * 32 + 8 * fq;
        f32x4 bg[2], bu[2];
#pragma unroll
        for (int n = 0; n < 2; ++n) { bg[n] = *(const f32x4*)(b1 + (size_t)u.e * 2048 + g0 + 4 * n); bu[n] = *(const f32x4*)(b1 + (size_t)u.e * 2048 + 1024 + g0 + 4 * n); }
#pragma unroll
        for (int ai = 0; ai < 2; ++ai)
#pragma unroll
            for (int m = 0; m < 4; ++m) { unsigned char* rowp = O + (size_t)(row0 + ai * HALF + m * 16) * DEXP + g0;
                float o[8];
#pragma unroll
                for (int n = 0; n < 2; ++n)
#pragma unroll
                    for (int q = 0; q < 4; q += 2) {
                        f32x2 gt = (f32x2){acc[ai][0][m][n][q], acc[ai][0][m][n][q + 1]} + (f32x2){bg[n][q], bg[n][q + 1]};
                        f32x2 up = (f32x2){acc[ai][1][m][n][q], acc[ai][1][m][n][q + 1]} + (f32x2){bu[n][q], bu[n][q + 1]};
                        gt.x = fminf(gt.x, 7.0f); gt.y = fminf(gt.y, 7.0f);
                        up.x = __builtin_amdgcn_fmed3f(up.x, -7.0f, 7.0f); up.y = __builtin_amdgcn_fmed3f(up.y, -7.0f, 7.0f);
                        const f32x2 x = gt * (-2.45546696f);
                        f32x2 e; e.x = __builtin_amdgcn_exp2f(x.x); e.y = __builtin_amdgcn_exp2f(x.y);
                        const f32x2 d = e + 1.0f;
                        f32x2 sg; sg.x = __builtin_amdgcn_rcpf(d.x); sg.y = __builtin_amdgcn_rcpf(d.y);
                        const f32x2 u4 = up * 4.0f + 4.0f;
                        const f32x2 r = u4 * (gt * sg);
                        o[n * 4 + q] = r.x; o[n * 4 + q + 1] = r.y;
                    }
                u32x2 w; w.x = pk4_fp8(o[0], o[1], o[2], o[3]); w.y = pk4_fp8(o[4], o[5], o[6], o[7]);
                *(u32x2*)rowp = w; }
    }
};

typedef int v8i_t __attribute__((ext_vector_type(8)));
template <class Epi, class Sched, int AM, bool FP8 = false>
DI void gemm_phase(LAS unsigned char* lds, const Gemm g, const Sched& S, const Epi& E, const int tid) {
    constexpr bool GATHER = (AM != 0);
    const int wid = __builtin_amdgcn_readfirstlane(tid >> 6), lane = tid & 63, wr = wid >> 2, wc = wid & 3, fr = lane & 15, fq = lane >> 4;
    const int K = g.K, nt = K / (BK * 2);
    unsigned voffA[2], voffB[2];
#pragma unroll
    for (int i = 0; i < 2; ++i) { int R, C; stage_rc(tid * 16 + i * 8192, R, C); const int Rb = Epi::PERM ? ((R & ~31) + perm32(R & 31)) : R;
        voffA[i] = (unsigned)(R * K + C * 2); voffB[i] = (unsigned)(Rb * K + C * 2); }
    const size_t kstep = (size_t)(BK * 2);
    const size_t hstep = (size_t)HALF * K;
    const unsigned ldsw = (unsigned)wid * 1024u;
    const int aoff = lds_byte(wr * 64 + fr, fq * 8), boff = lds_byte(wc * 32 + fr, fq * 8);
    LAS unsigned* toktab = (LAS unsigned*)(lds + TOKTAB_OFF);
#define PG8_SA(b, h) (((b) * 2 + (h)) * HTB)
#define PG8_SB(b, h) ((4 + (b) * 2 + (h)) * HTB)
#define PG8_STAGE(bufoff, gbase, voff) do { _Pragma("unroll") for (int _i = 0; _i < 2; ++_i) \
        __builtin_amdgcn_global_load_lds((const unsigned*)((const char*)(gbase) + (voff)[_i]), (LAS unsigned*)(lds + (bufoff) + ldsw + _i * 8192), 16, 0, 0); } while (0)
#define PG8_STAGE_A(bufoff, base, h) do { if constexpr (GATHER) { _Pragma("unroll") for (int _i = 0; _i < 2; ++_i) \
        __builtin_amdgcn_global_load_lds((const unsigned*)((const char*)(base) + vA[h][_i]), (LAS unsigned*)(lds + (bufoff) + ldsw + _i * 8192), 16, 0, 0); } \
        else { PG8_STAGE(bufoff, (const char*)(base) + (h) * hstep, voffA); } } while (0)
#define PG8_VA_DIRECT(row0) do { _Pragma("unroll") for (int h = 0; h < 2; ++h) _Pragma("unroll") for (int i = 0; i < 2; ++i) { int R, C; stage_rc(tid * 16 + i * 8192, R, C); \
        vA[h][i] = (unsigned)((row0) + h * HALF + R) * (unsigned)K + (unsigned)C * 2u; } } while (0)
#define PG8_VA_FROM(tab) do { _Pragma("unroll") for (int h = 0; h < 2; ++h) _Pragma("unroll") for (int i = 0; i < 2; ++i) { int R, C; stage_rc(tid * 16 + i * 8192, R, C); \
        const unsigned tk = (tab)[h * HALF + R] & 0xffffu; vA[h][i] = tk * (unsigned)K + (unsigned)C * 2u; } } while (0)
#define PG8_LD2(p) __builtin_bit_cast(v8i_t, __builtin_shufflevector(*(const LAS bf16x8*)(p), *(const LAS bf16x8*)((p) + 1024), 0, 1, 2, 3, 4, 5, 6, 7, 8, 9, 10, 11, 12, 13, 14, 15))
#define PG8_LDA(dst, b, h) do { _Pragma("unroll") for (int m = 0; m < 4; ++m) dst[m] = PG8_LD2(lds + PG8_SA(b, h) + aoff + m * 2048); } while (0)
#define PG8_LDB(dst, b, h) do { _Pragma("unroll") for (int n = 0; n < 2; ++n) dst[n] = PG8_LD2(lds + PG8_SB(b, h) + boff + n * 2048); } while (0)
#define PG8_HALF(v, k) __builtin_bit_cast(bf16x8, __builtin_shufflevector(v, v, 4 * (k), 4 * (k) + 1, 4 * (k) + 2, 4 * (k) + 3))
#define PG8_MMA(ai, bj, At, Bt) do { __builtin_amdgcn_s_setprio(1); _Pragma("unroll") for (int m = 0; m < 4; ++m) _Pragma("unroll") for (int n = 0; n < 2; ++n) { \
        if constexpr (FP8) { acc[ai][bj][m][n] = __builtin_amdgcn_mfma_scale_f32_16x16x128_f8f6f4(Bt[n], At[m], acc[ai][bj][m][n], 0, 0, 0, g.sb, 0, g.sa); } \
        else { acc[ai][bj][m][n] = __builtin_amdgcn_mfma_f32_16x16x32_bf16(PG8_HALF(Bt[n], 0), PG8_HALF(At[m], 0), acc[ai][bj][m][n], 0, 0, 0); \
               acc[ai][bj][m][n] = __builtin_amdgcn_mfma_f32_16x16x32_bf16(PG8_HALF(Bt[n], 1), PG8_HALF(At[m], 1), acc[ai][bj][m][n], 0, 0, 0); } } \
        __builtin_amdgcn_s_setprio(0); } while (0)
#define PG8_WAIT_V(n) asm volatile("s_waitcnt vmcnt(" #n ")" ::: "memory")
#define PG8_WAIT_L(n) asm volatile("s_waitcnt lgkmcnt(" #n ")" ::: "memory")
#define PG8_BAR __builtin_amdgcn_s_barrier()
#define PG8_SCHED __builtin_amdgcn_sched_barrier(0)
    Unit cur, nxt; int ui = 0;
    if (!S.next(0, cur)) return;
    f32x4 acc[2][2][4][2];
#pragma unroll
    for (int a = 0; a < 2; ++a)
#pragma unroll
        for (int b = 0; b < 2; ++b)
#pragma unroll
            for (int m = 0; m < 4; ++m)
#pragma unroll
                for (int n = 0; n < 2; ++n) acc[a][b][m][n] = (f32x4){0.f, 0.f, 0.f, 0.f};
    v8i_t At[4], B0[2], B1[2];
    unsigned vA[2][2];
    if constexpr (AM == 1) { PG8_VA_FROM(g.list + cur.arow); } else if constexpr (AM == 2) { PG8_VA_DIRECT(cur.arow); }
    else {
#pragma unroll
        for (int h = 0; h < 2; ++h)
#pragma unroll
            for (int i = 0; i < 2; ++i) vA[h][i] = 0u;
    }
    const char* cA = GATHER ? (const char*)g.A : (const char*)((Sched::DUAL && cur.e) ? g.A2 : g.A) + (size_t)cur.arow * K;
    const char* cB = (const char*)((Sched::DUAL && cur.e) ? g.Bt2 : g.Bt) + (size_t)cur.brow * K;
    PG8_STAGE(PG8_SB(0, 0), cB, voffB); PG8_STAGE(PG8_SB(0, 1), cB + hstep, voffB); PG8_STAGE_A(PG8_SA(0, 0), cA, 0); PG8_STAGE_A(PG8_SA(0, 1), cA, 1);
    if (wr == 1) PG8_BAR;
    PG8_WAIT_V(2); PG8_BAR;
    PG8_STAGE(PG8_SB(1, 0), cB + kstep, voffB); PG8_STAGE_A(PG8_SA(1, 0), cA + kstep, 0); PG8_STAGE(PG8_SB(1, 1), cB + hstep + kstep, voffB);
    PG8_WAIT_V(6); PG8_BAR;
    for (;;) {
        const bool has_next = S.next(ui + 1, nxt);
        const char* nA = GATHER ? (const char*)g.A : (has_next ? (const char*)((Sched::DUAL && nxt.e) ? g.A2 : g.A) + (size_t)nxt.arow * K : cA);
        const char* nB = has_next ? (const char*)((Sched::DUAL && nxt.e) ? g.Bt2 : g.Bt) + (size_t)nxt.brow * K : cB;
        if constexpr (AM == 1) {
            if (has_next && wid < 4)
                __builtin_amdgcn_global_load_lds((const unsigned*)(g.list + nxt.arow + wid * 64 + lane), (LAS unsigned*)(toktab + ((ui + 1) & 1) * 256 + wid * 64), 4, 0, 0);
        }
#pragma clang loop unroll(disable)
        for (int t = 0; t < nt; t += 2) {
            const bool last = (t == nt - 2);
            const char* a1 = cA + (size_t)(t + 1) * kstep;
            const char* a2 = last ? nA : cA + (size_t)(t + 2) * kstep; const char* b2 = last ? nB : cB + (size_t)(t + 2) * kstep;
            const char* a3 = a2 + kstep; const char* b3 = b2 + kstep;
            PG8_LDB(B0, 0, 0); PG8_LDB(B1, 0, 1); PG8_SCHED; PG8_LDA(At, 0, 0); PG8_STAGE_A(PG8_SA(1, 1), a1, 1);
            if constexpr (AM == 1) { if (last && has_next) { PG8_VA_FROM(toktab + ((ui + 1) & 1) * 256); } } else if constexpr (AM == 2) { if (last && has_next) { PG8_VA_DIRECT(nxt.arow); } }
            PG8_WAIT_V(8); PG8_WAIT_L(0); PG8_BAR; PG8_MMA(0, 0, At, B0); PG8_MMA(0, 1, At, B1); PG8_BAR; PG8_SCHED;
            PG8_LDA(At, 0, 1); PG8_STAGE(PG8_SB(0, 0), b2, voffB); PG8_STAGE(PG8_SB(0, 1), b2 + hstep, voffB); PG8_STAGE_A(PG8_SA(0, 0), a2, 0);
            PG8_WAIT_V(8); PG8_WAIT_L(0); PG8_BAR; PG8_MMA(1, 0, At, B0); PG8_MMA(1, 1, At, B1); PG8_BAR; PG8_SCHED;
            PG8_LDB(B0, 1, 0); PG8_LDB(B1, 1, 1); PG8_SCHED; PG8_LDA(At, 1, 0); PG8_STAGE_A(PG8_SA(0, 1), a2, 1);
            PG8_WAIT_V(8); PG8_WAIT_L(0); PG8_BAR; PG8_MMA(0, 0, At, B0); PG8_MMA(0, 1, At, B1); PG8_BAR; PG8_SCHED;
            PG8_LDA(At, 1, 1); PG8_STAGE(PG8_SB(1, 0), b3, voffB); PG8_STAGE(PG8_SB(1, 1), b3 + hstep, voffB); PG8_STAGE_A(PG8_SA(1, 0), a3, 0);
            PG8_WAIT_V(8); PG8_WAIT_L(0); PG8_BAR; PG8_MMA(1, 0, At, B0); PG8_MMA(1, 1, At, B1); PG8_BAR; PG8_SCHED;
        }
        if (wr == 0) PG8_BAR;
        E(acc, cur, wr, wc, fr, fq);
        if (!has_next) break;
#pragma unroll
        for (int a = 0; a < 2; ++a)
#pragma unroll
            for (int b = 0; b < 2; ++b)
#pragma unroll
                for (int m = 0; m < 4; ++m)
#pragma unroll
                    for (int n = 0; n < 2; ++n) acc[a][b][m][n] = (f32x4){0.f, 0.f, 0.f, 0.f};
        cur = nxt; cA = nA; cB = nB; ++ui;
        if (wr == 1) PG8_BAR;
    }
    PG8_WAIT_V(0);
    PG8_BAR;
#undef PG8_SA
#undef PG8_SB
#undef PG8_STAGE
#undef PG8_STAGE_A
#undef PG8_VA_FROM
#undef PG8_VA_DIRECT
#undef PG8_LDA
#undef PG8_LD2
#undef PG8_HALF
#undef PG8_LDB
#undef PG8_MMA
#undef PG8_WAIT_V
#undef PG8_WAIT_L
#undef PG8_BAR
#undef PG8_SCHED
}
}

struct Ctx {
    LAS unsigned char* lds;
    int tid, lane, wave, G, bx;
    unsigned* ctl;
    unsigned char* ws;
    float* out;
};
DI const float* inp(const Ctx& F, int i) {
    const LAS unsigned* p = (const LAS unsigned*)(F.lds + PTAB_OFF) + 2 * i;
    const unsigned lo = (unsigned)__builtin_amdgcn_readfirstlane((int)p[0]), hi = (unsigned)__builtin_amdgcn_readfirstlane((int)p[1]);
    return (const float*)(const GAS float*)(((unsigned long long)hi << 32) | lo);
}
DI void launder(Ctx& F) { int t = F.wave * 64 + shfl_lane(); asm volatile("" : "+v"(t)); F.tid = t; F.lane = t & 63;
    const unsigned long long w = (unsigned long long)F.ws; int wl = __builtin_amdgcn_readfirstlane((int)(unsigned)w), wh = __builtin_amdgcn_readfirstlane((int)(unsigned)(w >> 32));
    asm volatile("" : "+s"(wl), "+s"(wh)); F.ws = (unsigned char*)(GAS unsigned char*)(((unsigned long long)(unsigned)wh << 32) | (unsigned)wl); F.ctl = (unsigned*)(F.ws + WS_CTL);
    int ll = __builtin_amdgcn_readfirstlane((int)(unsigned)(size_t)F.lds); asm volatile("" : "+s"(ll)); F.lds = (LAS unsigned char*)(size_t)(unsigned)ll;
    int gg = __builtin_amdgcn_readfirstlane(F.G), bb = __builtin_amdgcn_readfirstlane(F.bx); asm volatile("" : "+s"(gg), "+s"(bb)); F.G = gg; F.bx = bb; }
enum { I_X = 0, I_MEM, I_RELB, I_AWIN, I_ACONVW, I_ACONVB, I_AWR, I_ABR, I_AWI, I_ABI, I_ALAM, I_BWIN, I_BKVG, I_BWUK, I_BWUV, I_BIDXG, I_BIDXB,
       I_WMEMKV, I_WOUT, I_LN1G, I_LN1B, I_ROUTW, I_ROUTB, I_W1, I_B1, I_W2, I_B2, I_LN2G, I_LN2B };

DI void tr_item(const float* W, int sstride, bf16_t* dst, int dstride, int k0, int nvalid, LAS float* scr, int lane, bf16_t* dst_lo) {
    float v[32];
#pragma unroll
    for (int i = 0; i < 32; ++i) { const int kk = 2 * i + (lane >> 5), nn = lane & 31; const float x = W[(size_t)(k0 + kk) * sstride + (nn < nvalid ? nn : 0)]; v[i] = (nn < nvalid) ? x : 0.f; }
#pragma unroll
    for (int i = 0; i < 32; ++i) { const int kk = 2 * i + (lane >> 5); scr[kk * 33 + (lane & 31)] = v[i]; }
    LDS_WAIT();
    const int c = lane & 7;
#pragma unroll
    for (int j = 0; j < 4; ++j) { const int n = (lane >> 3) + 8 * j; const LAS float* s = scr + (8 * c) * 33 + n;
        float f[8];
#pragma unroll
        for (int q = 0; q < 8; ++q) f[q] = s[q * 33];
        u32x4 o; o.x = cvt_pk_bf16(f[0], f[1]); o.y = cvt_pk_bf16(f[2], f[3]); o.z = cvt_pk_bf16(f[4], f[5]); o.w = cvt_pk_bf16(f[6], f[7]);
        if (n < nvalid) *(u32x4*)(dst + (size_t)n * dstride + k0 + 8 * c) = o;
        if (dst_lo) {
            float r[8];
            r[0] = f[0] - bflo(o.x); r[1] = f[1] - bfhi(o.x); r[2] = f[2] - bflo(o.y); r[3] = f[3] - bfhi(o.y);
            r[4] = f[4] - bflo(o.z); r[5] = f[5] - bfhi(o.z); r[6] = f[6] - bflo(o.w); r[7] = f[7] - bfhi(o.w);
            u32x4 l; l.x = cvt_pk_bf16(r[0], r[1]); l.y = cvt_pk_bf16(r[2], r[3]); l.z = cvt_pk_bf16(r[4], r[5]); l.w = cvt_pk_bf16(r[6], r[7]);
            if (n < nvalid) *(u32x4*)(dst_lo + (size_t)n * dstride + k0 + 8 * c) = l;
        }
    }
    LDS_WAIT();
}

DI void tr8_load(const float* W, int sstride, int k0, int lane, float (&v)[32]) {
#pragma unroll
    for (int i = 0; i < 32; ++i) { const int kk = 2 * i + (lane >> 5), nn = lane & 31; v[i] = W[(size_t)(k0 + kk) * sstride + nn]; }
}
DI void tr8_store(const float (&v)[32], unsigned char* dst, int dstride, int k0, float scale, LAS float* scr, int lane) {
#pragma unroll
    for (int i = 0; i < 32; ++i) { const int kk = 2 * i + (lane >> 5); scr[kk * 33 + (lane & 31)] = v[i] * scale; }
    LDS_WAIT();
    const int c = lane & 3;
#pragma unroll
    for (int j = 0; j < 2; ++j) { const int n = (lane >> 2) + 16 * j; const LAS float* sp = scr + (16 * c) * 33 + n;
        float f[16];
#pragma unroll
        for (int q = 0; q < 16; ++q) f[q] = sp[q * 33];
        u32x4 o; o.x = pk4_fp8(f[0], f[1], f[2], f[3]); o.y = pk4_fp8(f[4], f[5], f[6], f[7]); o.z = pk4_fp8(f[8], f[9], f[10], f[11]); o.w = pk4_fp8(f[12], f[13], f[14], f[15]);
        *(u32x4*)(dst + (size_t)n * dstride + k0 + 16 * c) = o; }
    LDS_WAIT();
}
DI void tr8_item(const float* W, int sstride, unsigned char* dst, int dstride, int k0, int nvalid, float scale, LAS float* scr, int lane) {
    float v[32];
#pragma unroll
    for (int i = 0; i < 32; ++i) { const int kk = 2 * i + (lane >> 5), nn = lane & 31; const float x = W[(size_t)(k0 + kk) * sstride + (nn < nvalid ? nn : 0)]; v[i] = (nn < nvalid) ? x : 0.f; }
#pragma unroll
    for (int i = 0; i < 32; ++i) { const int kk = 2 * i + (lane >> 5); scr[kk * 33 + (lane & 31)] = v[i] * scale; }
    LDS_WAIT();
    const int c = lane & 3;
#pragma unroll
    for (int j = 0; j < 2; ++j) { const int n = (lane >> 2) + 16 * j; const LAS float* sp = scr + (16 * c) * 33 + n;
        float f[16];
#pragma unroll
        for (int q = 0; q < 16; ++q) f[q] = sp[q * 33];
        u32x4 o; o.x = pk4_fp8(f[0], f[1], f[2], f[3]); o.y = pk4_fp8(f[4], f[5], f[6], f[7]); o.z = pk4_fp8(f[8], f[9], f[10], f[11]); o.w = pk4_fp8(f[12], f[13], f[14], f[15]);
        if (n < nvalid) *(u32x4*)(dst + (size_t)n * dstride + k0 + 16 * c) = o; }
    LDS_WAIT();
}
struct Tr8Item { const float* W; int sstride; unsigned char* dst; int k0; float scale; };
DI Tr8Item tr8_decode(const Ctx& F, int it) {
    constexpr int I1 = 16 * 64, I2 = 16 * 32;
    const int le = it / (I1 + I2); int r = it % (I1 + I2); Tr8Item t;
    if (r < I1) { const int kb = r / 64, nb = r % 64; const int n0 = nb * 32;
        const int drow = (n0 < 1024) ? (256 * (n0 / 128) + (n0 % 128)) : (256 * ((n0 - 1024) / 128) + 128 + ((n0 - 1024) % 128));
        t.W = inp(F, I_W1) + (size_t)le * 1024 * 2048 + n0; t.sstride = 2048; t.dst = F.ws + WS_W1 + ((size_t)le * 2048 + drow) * 1024; t.k0 = kb * 64; t.scale = 32.0f;
    } else { r -= I1; const int kb = r / 32, nb = r % 32; const int n0 = nb * 32;
        t.W = inp(F, I_W2) + (size_t)le * 1024 * 1024 + n0; t.sstride = 1024; t.dst = F.ws + WS_W2 + ((size_t)le * 1024 + n0) * 1024; t.k0 = kb * 64; t.scale = 64.0f; }
    return t;
}

DI void p0_prologue(Ctx& F) {
    LAS float* scr = (LAS float*)(F.lds + F.wave * 16384);
    const int gw = F.bx * 8 + F.wave, NGW = F.G * 8, lane = F.lane;
    unsigned char* ws = F.ws;
    {
        constexpr int NIT = 64 * (16 * 64 + 16 * 32);
        float v[32];
        Tr8Item cur = tr8_decode(F, gw < NIT ? gw : 0);
        if (gw < NIT) tr8_load(cur.W, cur.sstride, cur.k0, lane, v);
        for (int it = gw; it < NIT; it += NGW) {
            float vn[32]; Tr8Item nx = cur;
            const bool more = it + NGW < NIT;
            if (more) { nx = tr8_decode(F, it + NGW); tr8_load(nx.W, nx.sstride, nx.k0, lane, vn); }
            __builtin_amdgcn_sched_barrier(0);
            tr8_store(v, cur.dst, 1024, cur.k0, cur.scale, scr, lane);
            if (more) {
#pragma unroll
                for (int i = 0; i < 32; ++i) v[i] = vn[i];
            }
            cur = nx;
        }
    }
    {
        constexpr int IA = 16 * 56;
        constexpr int IB = 16 * 47;
        constexpr int IKV = 2 * 16 * 16;
        constexpr int IO = 2 * 16 * 32;
        constexpr int IR = 12 * 2 * 2;
        constexpr int IUV = 12 * 2 * 2;
        constexpr int IRT = 2 * 16;
        constexpr int NIT = IA + IB + IKV + IO + IR + IUV + IRT;
        for (int it = gw; it < NIT; it += NGW) {
            int r = it;
            if (r < IA) { const int kb = r / 56, nb = r % 56; tr8_item(inp(F, I_AWIN) + nb * 32, WINA, ws + WS_WINA + (size_t)(nb * 32) * 1024, 1024, kb * 64, 32, 32.0f, scr, lane); continue; } r -= IA;
            if (r < IB) { const int kb = r / 47, nb = r % 47;
                const int scol = (nb < 38) ? nb * 32 : (nb == 38) ? 1216 : 1220 + (nb - 39) * 32, drow = (nb < 38) ? nb * 32 : (nb == 38) ? B_IW : B_MQ + (nb - 39) * 32, nv = (nb == 38) ? 4 : 32;
                tr8_item(inp(F, I_BWIN) + scol, WINB, ws + WS_WINB + (size_t)drow * 1024, 1024, kb * 64, nv, 32.0f, scr, lane); continue; } r -= IB;
            if (r < IKV) { const int l = r / 256, q = r % 256, kb = q / 16, nb = q % 16; tr_item(inp(F, I_WMEMKV) + (size_t)l * 1024 * 512 + nb * 32, 512, (bf16_t*)(ws + WS_WKV) + (size_t)(l * 512 + nb * 32) * 1024, 1024, kb * 64, 32, scr, lane, nullptr); continue; } r -= IKV;
            if (r < IO) { const int l = r / 512, q = r % 512, kb = q / 32, nb = q % 32;
                if (l == 0) tr_item(inp(F, I_WOUT) + nb * 32, 1024, (bf16_t*)(ws + WS_WOUT) + (size_t)(nb * 32) * 1024, 1024, kb * 64, 32, scr, lane, nullptr);
                else tr8_item(inp(F, I_WOUT) + (size_t)1024 * 1024 + nb * 32, 1024, ws + WS_WOUT + (size_t)1024 * 1024 * 2 + (size_t)(nb * 32) * 1024, 1024, kb * 64, 32, 32.0f, scr, lane);
                continue; } r -= IO;
            if (r < IR) { const int n = r / 4, g = (r >> 1) & 1, nb = r & 1; const float* src = (g ? inp(F, I_AWI) : inp(F, I_AWR)) + (size_t)n * 4096 + nb * 32;
                tr_item(src, 64, (bf16_t*)(ws + WS_WRT) + ((size_t)(n * 2 + g) * 64 + nb * 32) * 64, 64, 0, 32, scr, lane, nullptr); continue; } r -= IR;
            if (r < IUV) { const int h = r / 4, kb = (r >> 1) & 1, nb = r & 1; tr_item(inp(F, I_BWUV) + h * 64 + nb * 32, 768, (bf16_t*)(ws + WS_WUVT) + ((size_t)h * 64 + nb * 32) * 128, 128, kb * 64, 32, scr, lane, nullptr); continue; } r -= IUV;
            { const int l = r / 16, kb = r % 16; bf16_t* hi = (bf16_t*)(ws + WS_ROUT) + (size_t)(l * 2) * 32 * 1024; tr_item(inp(F, I_ROUTW) + (size_t)l * 1024 * 32, 32, hi, 1024, kb * 64, 32, scr, lane, hi + 32 * 1024); }
        }
    }
    {
        const size_t gt = (size_t)F.bx * 512 + F.tid, NT = (size_t)F.G * 512;
        const f32x4* x4 = (const f32x4*)inp(F, I_X); unsigned* xb = (unsigned*)(ws + WS_XB8);
        for (size_t i = gt; i < (size_t)T * D / 4; i += NT) { const f32x4 v = x4[i]; xb[i] = pk4_fp8(v[0] * 4.0f, v[1] * 4.0f, v[2] * 4.0f, v[3] * 4.0f); }
        const f32x4* m4 = (const f32x4*)inp(F, I_MEM); u32x2* mb = (u32x2*)(ws + WS_MEMBF);
        for (size_t i = gt; i < (size_t)NB * MEML * D / 4; i += NT) { const f32x4 v = m4[i]; u32x2 o; o.x = cvt_pk_bf16(v[0], v[1]); o.y = cvt_pk_bf16(v[2], v[3]); mb[i] = o; }
        bf16_t* wuk = (bf16_t*)(ws + WS_WUK);
        for (size_t i = gt; i < (size_t)128 * 12 * 64; i += NT) { const int d = (int)(i & 63), h = (int)((i >> 6) % 12), rr = (int)(i / 768); wuk[((size_t)h * 128 + rr) * 64 + d] = f2bf(inp(F, I_BWUK)[i]); }
        unsigned* pad = (unsigned*)(ws + WS_WINB + (size_t)WINB * 1024);
        for (size_t i = gt; i < (size_t)(WINBP - WINB) * 1024 / 4; i += NT) pad[i] = 0u;
    }
}

constexpr int LC = 128, NCHUNK = SEQ / LC;
template <int PASS> DI void lru_phase(Ctx& F) {
    LAS unsigned char* lds = F.lds;
    LAS bf16_t* XC = (LAS bf16_t*)lds;
    LAS float* AA = (LAS float*)(lds + 18432);
    LAS float* UU = (LAS float*)(lds + 51200);
    LAS float* SEG = (LAS float*)(lds + 83968);
    LAS float* CSEG = (LAS float*)(lds + 88832);
    LAS float* PARA = (LAS float*)(lds + 92928);
    LAS float* CW = (LAS float*)(lds + 92928 + 9216);
    const int tid = F.tid, lane = F.lane, w = F.wave, fr = lane & 15, fq = lane >> 4;
    const bf16_t* PROJ = (const bf16_t*)(F.ws + WS_PROJ);
    const bf16_t* WRT = (const bf16_t*)(F.ws + WS_WRT);
    float* LSUM = (float*)(F.ws + WS_LSUM);
    bf16_t* MIX = (bf16_t*)(F.ws + WS_MIX);
    __syncthreads();
    for (int i = tid; i < TOKW; i += 512) { PARA[i] = inp(F, I_ABR)[i]; PARA[TOKW + i] = inp(F, I_ABI)[i]; PARA[2 * TOKW + i] = 8.0f * log1pf(__expf(-inp(F, I_ALAM)[i])); CW[4 * TOKW + i] = inp(F, I_ACONVB)[i]; }
    for (int i = tid; i < 4 * TOKW; i += 512) CW[i] = inp(F, I_ACONVW)[i];
    u32x4 xin[2][4];
#define LRU_LOAD_X(uu) do { const int n_ = (uu) % 12, k_ = ((uu) / 12) % NCHUNK, b_ = (uu) / (12 * NCHUNK); const size_t r0_ = (size_t)b_ * SEQ + (size_t)k_ * LC; \
        _Pragma("unroll") for (int it = 0; it < 2; ++it) { const int item = tid + 512 * it, t = item >> 3, c8 = item & 7, ch = n_ * 64 + c8 * 8; \
            _Pragma("unroll") for (int j = 0; j < 4; ++j) { const int sp = k_ * LC + t - 3 + j; xin[it][j] = (sp >= 0) ? *(const u32x4*)(PROJ + (r0_ + t - 3 + j) * WINA + ch) : (u32x4){0u, 0u, 0u, 0u}; } } } while (0)
    if (F.bx < NB * NCHUNK * 12) LRU_LOAD_X(F.bx);
    for (int u = F.bx; u < NB * NCHUNK * 12; u += F.G) {
        const int n = u % 12, k = (u / 12) % NCHUNK, b = u / (12 * NCHUNK);
        const size_t row0 = (size_t)b * SEQ + (size_t)k * LC;
        __syncthreads();
        const LAS float* PAR = PARA + n * 64;
        if (PASS == 1) {
            const int d = tid & 63, seg = tid >> 6; float A = 1.f, H = 0.f; f32x2 sv[8];
#pragma unroll
            for (int q = 0; q < 8; ++q) { const int kk = seg * 8 + q; sv[q] = (kk < k) ? *(const f32x2*)(LSUM + (((size_t)b * NCHUNK + kk) * TOKW + n * 64 + d) * 2) : (f32x2){1.f, 0.f}; }
#pragma unroll
            for (int q = 0; q < 8; ++q) { H = sv[q].x * H + sv[q].y; A *= sv[q].x; }
            CSEG[(seg * 64 + d) * 2] = A; CSEG[(seg * 64 + d) * 2 + 1] = H;
        }
#pragma unroll
        for (int it = 0; it < 2; ++it) {
            const int item = tid + 512 * it, t = item >> 3, c8 = item & 7, ch = n * 64 + c8 * 8;
            float accv[8];
            { const f32x4 b0 = *(const LAS f32x4*)(CW + 4 * TOKW + ch), b1 = *(const LAS f32x4*)(CW + 4 * TOKW + ch + 4);
#pragma unroll
              for (int q = 0; q < 4; ++q) { accv[q] = b0[q]; accv[4 + q] = b1[q]; } }
#pragma unroll
            for (int j = 0; j < 4; ++j) {
                const u32x4 xv = xin[it][j];
                const f32x4 w0 = *(const LAS f32x4*)(CW + j * TOKW + ch), w1 = *(const LAS f32x4*)(CW + j * TOKW + ch + 4);
                accv[0] += w0[0] * bflo(xv.x); accv[1] += w0[1] * bfhi(xv.x); accv[2] += w0[2] * bflo(xv.y); accv[3] += w0[3] * bfhi(xv.y);
                accv[4] += w1[0] * bflo(xv.z); accv[5] += w1[1] * bfhi(xv.z); accv[6] += w1[2] * bflo(xv.w); accv[7] += w1[3] * bfhi(xv.w);
            }
            u32x4 o; o.x = cvt_pk_bf16(accv[0], accv[1]); o.y = cvt_pk_bf16(accv[2], accv[3]); o.z = cvt_pk_bf16(accv[4], accv[5]); o.w = cvt_pk_bf16(accv[6], accv[7]);
            *(LAS u32x4*)(XC + t * 72 + c8 * 8) = o;
        }
        if (u + F.G < NB * NCHUNK * 12) LRU_LOAD_X(u + F.G);
        unsigned short gbv[16];
        if (PASS == 1) { const bf16_t* gbp = PROJ + (row0 + (tid >> 6) * 16) * WINA + TOKW + n * 64 + (tid & 63);
#pragma unroll
            for (int q = 0; q < 16; ++q) gbv[q] = gbp[(size_t)q * WINA]; }
        __syncthreads();
        {
            bf16x8 xb[2];
#pragma unroll
            for (int ks = 0; ks < 2; ++ks) xb[ks] = *(const LAS bf16x8*)(XC + (16 * w + fr) * 72 + ks * 32 + fq * 8);
            f32x4 acc[2][4];
#pragma unroll
            for (int g = 0; g < 2; ++g)
#pragma unroll
                for (int j = 0; j < 4; ++j) { acc[g][j] = (f32x4){0.f, 0.f, 0.f, 0.f};
#pragma unroll
                    for (int ks = 0; ks < 2; ++ks) { const bf16x8 wf = *(const bf16x8*)(WRT + ((size_t)(n * 2 + g) * 64 + 16 * j + fr) * 64 + ks * 32 + fq * 8); acc[g][j] = MFMA16(wf, xb[ks], acc[g][j]); } }
            const int t = 16 * w + fr;
#pragma unroll
            for (int j = 0; j < 4; ++j) {
                const int d0 = 16 * j + 4 * fq;
                const f32x4 br = *(const LAS f32x4*)(PAR + d0), bi = *(const LAS f32x4*)(PAR + TOKW + d0), sp = *(const LAS f32x4*)(PAR + 2 * TOKW + d0);
                const u32x2 xw = *(const LAS u32x2*)(XC + t * 72 + d0);
                const float xcv[4] = {bflo(xw.x), bfhi(xw.x), bflo(xw.y), bfhi(xw.y)};
                f32x4 av, uv;
#pragma unroll
                for (int q = 0; q < 4; ++q) {
                    const float rg = sigmoidf_(acc[0][j][q] + br[q]), ig = sigmoidf_(acc[1][j][q] + bi[q]);
                    const float la = -sp[q] * rg; const float a = __expf(la); const float x2 = 2.0f * la;
                    const float om = (x2 > -0.1f) ? (-x2 * (1.0f + x2 * (0.5f + x2 * (0.16666667f + x2 * 0.041666667f)))) : (1.0f - a * a);
                    av[q] = a; uv[q] = sqrtf(om) * ig * xcv[q];
                }
                *(LAS f32x4*)(AA + t * 64 + d0) = av; *(LAS f32x4*)(UU + t * 64 + d0) = uv;
            }
        }
        __syncthreads();
        const int d = tid & 63, seg = tid >> 6;
        {
            float A = 1.f, H = 0.f;
#pragma unroll
            for (int q = 0; q < 16; ++q) { const int t = seg * 16 + q; const float a = AA[t * 64 + d], uu = UU[t * 64 + d]; H = a * H + uu; A *= a; }
            SEG[(seg * 64 + d) * 2] = A; SEG[(seg * 64 + d) * 2 + 1] = H;
        }
        __syncthreads();
        if (PASS == 0) {
            if (tid < 64) { float A = 1.f, H = 0.f;
#pragma unroll
                for (int s = 0; s < 8; ++s) { const float As = SEG[(s * 64 + tid) * 2], Hs = SEG[(s * 64 + tid) * 2 + 1]; H = As * H + Hs; A *= As; }
                *(f32x2*)(LSUM + (((size_t)b * NCHUNK + k) * TOKW + n * 64 + tid) * 2) = (f32x2){A, H}; }
        } else {
            float h = 0.f;
#pragma unroll
            for (int s = 0; s < 8; ++s) h = CSEG[(s * 64 + d) * 2] * h + CSEG[(s * 64 + d) * 2 + 1];
#pragma unroll
            for (int s = 0; s < 8; ++s) if (s < seg) h = SEG[(s * 64 + d) * 2] * h + SEG[(s * 64 + d) * 2 + 1];
            bf16_t* op = MIX + (row0 + seg * 16) * D + n * 64 + d;
#pragma unroll
            for (int q = 0; q < 16; ++q) { const int t = seg * 16 + q; h = AA[t * 64 + d] * h + UU[t * 64 + d];
                const float g = bf2f(gbv[q]); const float y = 0.7978845608f * (g + 0.044715f * g * g * g); const float th = 1.0f - 2.0f * __builtin_amdgcn_rcpf(__expf(2.0f * y) + 1.0f);
                op[(size_t)q * D] = f2bf(h * 0.5f * g * (1.0f + th)); }
        }
    }
    __syncthreads();
#undef LRU_LOAD_X
}

DI void memattn_phase(Ctx& F, int layer, int ldp, int mqcol) {
    LAS unsigned char* lds = F.lds;
    LAS bf16_t* Kt = (LAS bf16_t*)lds;
    LAS bf16_t* Vt = (LAS bf16_t*)(lds + 36864);
    const int tid = F.tid, lane = F.lane, w = F.wave, fr = lane & 15, fq = lane >> 4;
    const bf16_t* PROJ = (const bf16_t*)(F.ws + WS_PROJ);
    const bf16_t* KV = (const bf16_t*)(F.ws + WS_KV);
    bf16_t* MIX = (bf16_t*)(F.ws + WS_MIX);
    for (int u = F.bx; u < NB * 4 * 8; u += F.G) {
        const int qc = u & 7, h = (u >> 3) & 3, b = u >> 5;
        __syncthreads();
#pragma unroll
        for (int it = 0; it < 4; ++it) { const int p = tid + 512 * it, key = p >> 3, c8 = p & 7;
            *(LAS u32x4*)(Kt + key * 72 + c8 * 8) = *(const u32x4*)(KV + (size_t)(b * MEML + key) * 1024 + layer * 512 + h * 64 + c8 * 8); }
        { const int key = tid & 255, dh = tid >> 8;
#pragma unroll
          for (int c = 0; c < 4; ++c) { const u32x4 v = *(const u32x4*)(KV + (size_t)(b * MEML + key) * 1024 + layer * 512 + 256 + h * 64 + dh * 32 + c * 8);
              const unsigned wv[4] = {v.x, v.y, v.z, v.w};
#pragma unroll
              for (int q = 0; q < 4; ++q) { const int dd = dh * 32 + c * 8 + 2 * q; Vt[dd * 264 + key] = (bf16_t)(wv[q] & 0xffffu); Vt[(dd + 1) * 264 + key] = (bf16_t)(wv[q] >> 16); } } }
        __syncthreads();
        for (int it = 0; it < 8; ++it) {
            const size_t q0 = (size_t)b * SEQ + qc * 1024 + it * 128 + w * 16;
            bf16x8 qf[2];
#pragma unroll
            for (int ks = 0; ks < 2; ++ks) qf[ks] = *(const bf16x8*)(PROJ + (q0 + fr) * ldp + mqcol + h * 64 + ks * 32 + fq * 8);
            f32x4 s[16];
#pragma unroll
            for (int jg = 0; jg < 4; ++jg) { bf16x8 kf[4][2];
#pragma unroll
                for (int jj = 0; jj < 4; ++jj)
#pragma unroll
                    for (int ks = 0; ks < 2; ++ks) kf[jj][ks] = *(const LAS bf16x8*)(Kt + (16 * (4 * jg + jj) + fr) * 72 + ks * 32 + fq * 8);
#pragma unroll
                for (int jj = 0; jj < 4; ++jj) { const int j = 4 * jg + jj; s[j] = (f32x4){0.f, 0.f, 0.f, 0.f};
#pragma unroll
                    for (int ks = 0; ks < 2; ++ks) s[j] = MFMA16(kf[jj][ks], qf[ks], s[j]); }
                asm volatile("" ::: "memory"); }
            float mx = -3.0e38f;
#pragma unroll
            for (int j = 0; j < 16; ++j) mx = fmaxf(mx, fmaxf(fmaxf(s[j][0], s[j][1]), fmaxf(s[j][2], s[j][3])));
            mx = rows4_max(mx);
            float l = 0.f; bf16x8 pf[8];
#pragma unroll
            for (int ks = 0; ks < 8; ++ks) { float p[8];
#pragma unroll
                for (int q = 0; q < 4; ++q) { p[q] = __expf((s[2 * ks][q] - mx) * 0.125f); p[4 + q] = __expf((s[2 * ks + 1][q] - mx) * 0.125f); }
#pragma unroll
                for (int q = 0; q < 8; ++q) l += p[q];
                u32x4 pw; pw.x = cvt_pk_bf16(p[0], p[1]); pw.y = cvt_pk_bf16(p[2], p[3]); pw.z = cvt_pk_bf16(p[4], p[5]); pw.w = cvt_pk_bf16(p[6], p[7]);
                pf[ks] = __builtin_bit_cast(bf16x8, pw); }
            l = rows4_sum(l);
            const float inv = 1.0f / l;
            f32x4 o[4];
#pragma unroll
            for (int dt = 0; dt < 4; ++dt) o[dt] = (f32x4){0.f, 0.f, 0.f, 0.f};
#pragma unroll
            for (int ks = 0; ks < 8; ++ks) { bf16x8 vf[4];
#pragma unroll
                for (int dt = 0; dt < 4; ++dt) { const LAS bf16_t* vp = Vt + (16 * dt + fr) * 264 + 32 * ks + 4 * fq;
                    const s16x4 lo = *(const LAS s16x4*)vp, hi = *(const LAS s16x4*)(vp + 16); vf[dt] = __builtin_shufflevector(lo, hi, 0, 1, 2, 3, 4, 5, 6, 7); }
#pragma unroll
                for (int dt = 0; dt < 4; ++dt) o[dt] = MFMA16(vf[dt], pf[ks], o[dt]); }
#pragma unroll
            for (int dt = 0; dt < 4; ++dt) { u32x2 ow; ow.x = cvt_pk_bf16(o[dt][0] * inv, o[dt][1] * inv); ow.y = cvt_pk_bf16(o[dt][2] * inv, o[dt][3] * inv);
                if (layer == 0) *(u32x2*)(MIX + (q0 + fr) * D + TOKW + h * 64 + 16 * dt + 4 * fq) = ow;
                else *(unsigned*)((unsigned char*)MIX + (q0 + fr) * D + TOKW + h * 64 + 16 * dt + 4 * fq) = pk4_fp8(o[dt][0] * inv * 16.0f, o[dt][1] * inv * 16.0f, o[dt][2] * inv * 16.0f, o[dt][3] * inv * 16.0f); }
            asm volatile("" ::: "memory");
        }
    }
    __syncthreads();
}

DI void build_mtab(Ctx& F, int layer) {
    LAS int* mtab = (LAS int*)(F.lds + MTAB_OFF);
    __syncthreads();
    if (F.tid < 64) {
        const int l = F.tid; unsigned c = 0u;
        if (l < 32) c = __hip_atomic_load(F.ctl + CW_CNT + (layer * 32 + l) * 16, __ATOMIC_RELAXED, __HIP_MEMORY_SCOPE_AGENT);
        const int nt = (int)((c + 255u) >> 8); int incl = nt;
#pragma unroll
        for (int o = 1; o < 32; o <<= 1) { const int u = shup_i(incl, o); if (l >= o) incl += u; }
        if (l < 32) mtab[l] = incl - nt;
        if (l == 31) mtab[32] = incl; }
    __syncthreads();
    LAS unsigned* gmtab = (LAS unsigned*)(F.lds + GMTAB_OFF);
    for (int gm = F.tid; gm < mtab[32] && gm < 1056; gm += 512) { int e = 0;
        for (int q = 1; q < 32; ++q) e += (gm >= mtab[q]) ? 1 : 0;
        gmtab[gm] = ((unsigned)e << 16) | (unsigned)(gm - mtab[e]); }
    __syncthreads();
}

DI unsigned wave_max_u(unsigned v);
DI void ln_router_phase(Ctx& F, int layer) {
    LAS float* WR = (LAS float*)F.lds;
    LAS unsigned* lcnt = (LAS unsigned*)(F.lds + 147456);
    LAS unsigned* lbase = (LAS unsigned*)(F.lds + 147456 + 128);
    LAS unsigned* stash = (LAS unsigned*)(F.lds + 147456 + 256);
    constexpr int ROWS_IT = 16;
    LAS float* stg = (LAS float*)(stash + 8 * ROWS_IT * 4);
    const int tid = F.tid, lane = F.lane, w = F.wave;
    const bf16_t* Z = (const bf16_t*)(F.ws + WS_Z);
    float* XA = (float*)(F.ws + WS_XA);
    bf16_t* XBF = (bf16_t*)(F.ws + WS_XBF); unsigned char* XB8 = F.ws + WS_XB8;
    const float* gam = inp(F, I_LN1G) + layer * D; const float* bet = inp(F, I_LN1B) + layer * D;
    const float* rw = inp(F, I_ROUTW) + (size_t)layer * 1024 * 32; const float* rb = inp(F, I_ROUTB) + layer * 32;
    unsigned* LIST = (unsigned*)(F.ws + WS_LIST); unsigned* TOKSLOT = (unsigned*)(F.ws + WS_TOKSLOT); float* TOKGATE = (float*)(F.ws + WS_TOKGATE);
    __syncthreads();
    for (int p = tid; p < 1024 * 8; p += 512) { const int c = p >> 3, k = p & 7; *(LAS f32x4*)(WR + ((c & 3) * 256 + (c >> 2)) * 36 + 4 * k) = *(const f32x4*)(rw + (size_t)c * 32 + 4 * k); }
    f32x4 g4[4], b4[4];
#pragma unroll
    for (int j = 0; j < 4; ++j) { g4[j] = *(const f32x4*)(gam + 4 * lane + 256 * j); b4[j] = *(const f32x4*)(bet + 4 * lane + 256 * j); }
    const int myexp = (((lane >> 5) & 1) << 4) | (((lane >> 4) & 1) << 3) | (((lane >> 3) & 1) << 2) | (((lane >> 2) & 1) << 1) | ((lane >> 1) & 1);
    const float mybias = rb[myexp];
    const int rows_blk = 8 * ROWS_IT;
    for (int it = 0; (it * F.G + F.bx) * rows_blk < T; ++it) {
        const int row0 = (it * F.G + F.bx) * rows_blk + w * ROWS_IT;
        __syncthreads();
        if (tid < 32) lcnt[tid] = 0u;
        __syncthreads();
        u32x2 vnx[4]; f32x4 rfx[4]; u32x2 rbx[4];
        const float* xres = inp(F, I_X);
#pragma unroll
        for (int j = 0; j < 4; ++j) { vnx[j] = *(const u32x2*)(Z + (size_t)row0 * D + 4 * lane + 256 * j);
            if (layer == 0) rfx[j] = *(const f32x4*)(xres + (size_t)row0 * D + 4 * lane + 256 * j); else rbx[j] = *(const u32x2*)(XBF + (size_t)row0 * D + 4 * lane + 256 * j); }
        for (int rr2 = 0; rr2 < (DBL(5) ? 2 * ROWS_IT : ROWS_IT); ++rr2) {
            const int r = rr2 % ROWS_IT; const bool publish = !DBL(5) || rr2 >= ROWS_IT;
            const size_t row = (size_t)row0 + r;
            f32x4 v[4];
#pragma unroll
            for (int j = 0; j < 4; ++j) { const f32x4 res = (layer == 0) ? rfx[j] : (f32x4){bflo(rbx[j].x), bfhi(rbx[j].x), bflo(rbx[j].y), bfhi(rbx[j].y)};
                v[j] = res * DN_ALPHA + (f32x4){bflo(vnx[j].x), bfhi(vnx[j].x), bflo(vnx[j].y), bfhi(vnx[j].y)}; }
            { const size_t rown = (size_t)row0 + ((rr2 + 1) % ROWS_IT);
#pragma unroll
              for (int j = 0; j < 4; ++j) { vnx[j] = *(const u32x2*)(Z + rown * D + 4 * lane + 256 * j);
                  if (layer == 0) rfx[j] = *(const f32x4*)(xres + rown * D + 4 * lane + 256 * j); else rbx[j] = *(const u32x2*)(XBF + rown * D + 4 * lane + 256 * j); } }
            __builtin_amdgcn_sched_barrier(0);
            float s = 0.f;
#pragma unroll
            for (int j = 0; j < 4; ++j) s += (v[j][0] + v[j][1]) + (v[j][2] + v[j][3]);
            const float mean = wave_sum_fast(s) * (1.0f / D); float s2 = 0.f;
#pragma unroll
            for (int j = 0; j < 4; ++j) { v[j] = v[j] - mean; s2 += (v[j][0] * v[j][0] + v[j][1] * v[j][1]) + (v[j][2] * v[j][2] + v[j][3] * v[j][3]); }
            const float rstd = 1.0f / sqrtf(wave_sum_fast(s2) * (1.0f / D) + LN_EPS);
#pragma unroll
            for (int j = 0; j < 4; ++j) { v[j] = v[j] * rstd * g4[j] + b4[j];
                u32x2 o; o.x = cvt_pk_bf16(v[j][0], v[j][1]); o.y = cvt_pk_bf16(v[j][2], v[j][3]); *(u32x2*)(XBF + row * D + 4 * lane + 256 * j) = o;
                *(unsigned*)(XB8 + row * D + 4 * lane + 256 * j) = pk4_fp8(v[j][0] * 4.0f, v[j][1] * 4.0f, v[j][2] * 4.0f, v[j][3] * 4.0f); }
            f32x4 accv[8], wq[2][8];
#pragma unroll
            for (int k = 0; k < 8; ++k) { accv[k] = (f32x4){0.f, 0.f, 0.f, 0.f}; wq[0][k] = *(const LAS f32x4*)(WR + lane * 36 + 4 * k); }
#pragma unroll
            for (int ci = 0; ci < 16; ++ci) { const int j = ci >> 2, i = ci & 3;
                if (ci + 1 < 16) { const int jn = (ci + 1) >> 2, in = (ci + 1) & 3; const LAS float* wp = WR + (in * 256 + lane + 64 * jn) * 36;
#pragma unroll
                    for (int k = 0; k < 8; ++k) wq[(ci + 1) & 1][k] = *(const LAS f32x4*)(wp + 4 * k); }
                __builtin_amdgcn_sched_barrier(0);
                const float xv = v[j][i];
#pragma unroll
                for (int k = 0; k < 8; ++k) accv[k] += wq[ci & 1][k] * xv;
                __builtin_amdgcn_sched_barrier(0);
            }
            float acc[32];
#pragma unroll
            for (int e = 0; e < 32; ++e) acc[e] = accv[e >> 2][e & 3];
#define RED_LEVEL(o, n) { const bool up = (lane & (o)) != 0; _Pragma("unroll") for (int q = 0; q < (n); ++q) { const float send = up ? acc[q] : acc[q + (n)]; const float keep = up ? acc[q + (n)] : acc[q]; acc[q] = keep + shx(send, (o)); } }
#pragma unroll
            for (int q = 0; q < 16; ++q) { const auto pr = __builtin_amdgcn_permlane32_swap(__float_as_uint(acc[q]), __float_as_uint(acc[q + 16]), false, false); acc[q] = __uint_as_float(pr[0]) + __uint_as_float(pr[1]); }
#pragma unroll
            for (int q = 0; q < 8; ++q) { const auto pr = __builtin_amdgcn_permlane16_swap(__float_as_uint(acc[q]), __float_as_uint(acc[q + 8]), false, false); acc[q] = __uint_as_float(pr[0]) + __uint_as_float(pr[1]); }
            RED_LEVEL(8, 4) RED_LEVEL(4, 2) RED_LEVEL(2, 1)
#undef RED_LEVEL
            float lg = acc[0] + shx(acc[0], 1) + mybias;
            float tv[4]; int te[4];
#pragma unroll
            for (int k = 0; k < 4; ++k) {
                unsigned ub = __float_as_uint(lg); ub ^= (ub >> 31) ? 0xffffffffu : 0x80000000u;
                const unsigned mxk = wave_max_u(ub);
                const unsigned cand = (ub == mxk) ? (unsigned)(32 - myexp) : 0u;
                const int ewin = 32 - (int)wave_max_u(cand);
                unsigned mb = mxk; mb ^= (mb >> 31) ? 0x80000000u : 0xffffffffu;
                tv[k] = __uint_as_float(mb); te[k] = ewin;
                if (myexp == ewin) lg = -3.0e38f;
            }
            float gsum = 0.f, gk[4];
#pragma unroll
            for (int k = 0; k < 4; ++k) { gk[k] = __expf(tv[k] - tv[0]); gsum += gk[k]; }
            const float ginv = 1.0f / gsum;
            if (lane < 4 && publish) { int e = te[0]; float g = gk[0];
#pragma unroll
                for (int k = 1; k < 4; ++k) if (lane == k) { e = te[k]; g = gk[k]; }
                const unsigned pos = __hip_atomic_fetch_add(lcnt + e, 1u, __ATOMIC_RELAXED, __HIP_MEMORY_SCOPE_WORKGROUP);
                stash[(w * ROWS_IT + r) * 4 + lane] = ((unsigned)e << 24) | pos; stg[(w * ROWS_IT + r) * 4 + lane] = g * ginv; }
        }
        __syncthreads();
        if (tid < 32) lbase[tid] = __hip_atomic_fetch_add(F.ctl + CW_CNT + (layer * 32 + tid) * 16, lcnt[tid], __ATOMIC_RELAXED, __HIP_MEMORY_SCOPE_AGENT);
        __syncthreads();
        { const int rr = lane >> 2, k = lane & 3;
          const unsigned sv = stash[(w * ROWS_IT + rr) * 4 + k]; const int e = (int)(sv >> 24); const unsigned slot = lbase[e] + (sv & 0xffffffu);
          const size_t row = (size_t)row0 + rr;
          LIST[(size_t)e * 65536 + slot] = (unsigned)row; TOKSLOT[row * 4 + k] = ((unsigned)e << 20) | slot; TOKGATE[row * 4 + k] = stg[(w * ROWS_IT + rr) * 4 + k]; }
    }
    __syncthreads();
}

DI void combine_ln_phase(Ctx& F, int layer, float* outf) {
    build_mtab(F, layer);
    const LAS int* mtab = (const LAS int*)(F.lds + MTAB_OFF);
    const int lane = F.lane;
    const float* XA = (const float*)(F.ws + WS_XA);
    const unsigned char* Y = F.ws + WS_Y;
    bf16_t* XBF = (bf16_t*)(F.ws + WS_XBF);
    const unsigned* TOKSLOT = (const unsigned*)(F.ws + WS_TOKSLOT); const float* TOKGATE = (const float*)(F.ws + WS_TOKGATE);
    const float* gam = inp(F, I_LN2G) + layer * D; const float* bet = inp(F, I_LN2B) + layer * D;
    const int gw = F.bx * 8 + F.wave, NGW = F.G * 8;
    const bool perr = (PROBE_CHECK || PROBE_DSA) && layer == 1 && __hip_atomic_load(F.ctl + CW_ERR, __ATOMIC_RELAXED, __HIP_MEMORY_SCOPE_AGENT) != 0u;
    f32x4 g4[4], b4[4];
#pragma unroll
    for (int j = 0; j < 4; ++j) { g4[j] = *(const f32x4*)(gam + 4 * lane + 256 * j); b4[j] = *(const f32x4*)(bet + 4 * lane + 256 * j); }
#define CMB_ISSUE(xw_, yw_, ts_, r_) do { const unsigned tsv_[4] = {ts_.x, ts_.y, ts_.z, ts_.w}; \
        _Pragma("unroll") for (int j = 0; j < 4; ++j) xw_[j] = *(const u32x2*)(XBF + (size_t)(r_) * D + 4 * lane + 256 * j); \
        _Pragma("unroll") for (int k = 0; k < 4; ++k) { const int e_ = (int)(tsv_[k] >> 20), slot_ = (int)(tsv_[k] & 0xfffffu); const size_t yrow_ = (size_t)mtab[e_] * 256 + slot_; \
            _Pragma("unroll") for (int j = 0; j < 4; ++j) yw_[k][j] = *(const unsigned*)(Y + yrow_ * D + 4 * lane + 256 * j); } } while (0)
    u32x2 xwc[4]; unsigned ywc[4][4]; f32x4 tgc;
    u32x4 tsn; f32x4 tgn;
    { const int r0 = gw < T ? gw : 0; const u32x4 ts0 = *(const u32x4*)(TOKSLOT + (size_t)r0 * 4); tgc = *(const f32x4*)(TOKGATE + (size_t)r0 * 4);
      const int r1 = (gw + NGW < T) ? gw + NGW : r0; tsn = *(const u32x4*)(TOKSLOT + (size_t)r1 * 4); tgn = *(const f32x4*)(TOKGATE + (size_t)r1 * 4);
      CMB_ISSUE(xwc, ywc, ts0, r0); }
    for (int row = gw; row < T; row += NGW) {
        u32x2 xwn[4]; unsigned ywn[4][4]; const f32x4 tgn1 = tgn;
        { const int r1 = (row + NGW < T) ? row + NGW : row; CMB_ISSUE(xwn, ywn, tsn, r1);
          const int r2 = (row + 2 * NGW < T) ? row + 2 * NGW : row; tsn = *(const u32x4*)(TOKSLOT + (size_t)r2 * 4); tgn = *(const f32x4*)(TOKGATE + (size_t)r2 * 4); }
        __builtin_amdgcn_sched_barrier(0);
        f32x4 v[4];
#pragma unroll
        for (int j = 0; j < 4; ++j) v[j] = (f32x4){bflo(xwc[j].x), bfhi(xwc[j].x), bflo(xwc[j].y), bfhi(xwc[j].y)} * DN_ALPHA;
#pragma unroll
        for (int k = 0; k < 4; ++k) { const float g = tgc[k] * 0.0625f;
#pragma unroll
            for (int j = 0; j < 4; ++j) { const unsigned yw = ywc[k][j]; const f32x2 ya = __builtin_amdgcn_cvt_pk_f32_fp8((int)yw, false), yb = __builtin_amdgcn_cvt_pk_f32_fp8((int)yw, true);
                v[j][0] += g * ya[0]; v[j][1] += g * ya[1]; v[j][2] += g * yb[0]; v[j][3] += g * yb[1]; } }
        float s = 0.f;
#pragma unroll
        for (int j = 0; j < 4; ++j) s += (v[j][0] + v[j][1]) + (v[j][2] + v[j][3]);
        const float mean = wave_sum_fast(s) * (1.0f / D); float s2 = 0.f;
#pragma unroll
        for (int j = 0; j < 4; ++j) { v[j] = v[j] - mean; s2 += (v[j][0] * v[j][0] + v[j][1] * v[j][1]) + (v[j][2] * v[j][2] + v[j][3] * v[j][3]); }
        const float rstd = 1.0f / sqrtf(wave_sum_fast(s2) * (1.0f / D) + LN_EPS);
#pragma unroll
        for (int j = 0; j < 4; ++j) { const int c = 4 * lane + 256 * j; f32x4 y = v[j] * rstd * g4[j] + b4[j];
            if ((PROBE_CHECK || PROBE_DSA) && perr) y = (f32x4){__builtin_nanf(""), __builtin_nanf(""), __builtin_nanf(""), __builtin_nanf("")};
            if (layer == 1) *(f32x4*)(outf + (size_t)row * D + c) = y;
            if (layer == 0) { u32x2 o; o.x = cvt_pk_bf16(y[0], y[1]); o.y = cvt_pk_bf16(y[2], y[3]); *(u32x2*)(XBF + (size_t)row * D + c) = o; }
            if (layer == 0) *(unsigned*)(F.ws + WS_XB8 + (size_t)row * D + c) = pk4_fp8(y[0] * 4.0f, y[1] * 4.0f, y[2] * 4.0f, y[3] * 4.0f); }
        tgc = tgn1;
#pragma unroll
        for (int j = 0; j < 4; ++j) { xwc[j] = xwn[j];
#pragma unroll
            for (int k = 0; k < 4; ++k) ywc[k][j] = ywn[k][j]; }
    }
#undef CMB_ISSUE
}

DI void dsa_prep_phase(Ctx& F) {
    const bf16_t* PROJ = (const bf16_t*)(F.ws + WS_PROJ);
    bf16_t* CN = (bf16_t*)(F.ws + WS_CN); bf16_t* IKN = (bf16_t*)(F.ws + WS_IKN);
    const int sub = F.lane & 15, tq = F.lane >> 4;
    const int gw = F.bx * 8 + F.wave, NGW = F.G * 8;
    for (int t4 = gw; t4 < T / 4; t4 += NGW) {
        const size_t row = (size_t)t4 * 4 + tq;
        const u32x4 cv = *(const u32x4*)(PROJ + row * WINBP + B_C + sub * 8);
        const u32x2 kv = *(const u32x2*)(PROJ + row * WINBP + B_IK + sub * 4);
        float c[8] = {bflo(cv.x), bfhi(cv.x), bflo(cv.y), bfhi(cv.y), bflo(cv.z), bfhi(cv.z), bflo(cv.w), bfhi(cv.w)};
        float k[4] = {bflo(kv.x), bfhi(kv.x), bflo(kv.y), bfhi(kv.y)};
        float ss = 0.f, s1 = 0.f;
#pragma unroll
        for (int q = 0; q < 8; ++q) ss += c[q] * c[q];
#pragma unroll
        for (int q = 0; q < 4; ++q) s1 += k[q];
#pragma unroll
        for (int o = 1; o < 16; o <<= 1) { ss += shx(ss, o); s1 += shx(s1, o); }
        const float rr = 1.0f / sqrtf(ss * (1.0f / 128.0f) + 1e-6f); const float mean = s1 * (1.0f / 64.0f);
        float s2 = 0.f;
#pragma unroll
        for (int q = 0; q < 4; ++q) { k[q] -= mean; s2 += k[q] * k[q]; }
#pragma unroll
        for (int o = 1; o < 16; o <<= 1) s2 += shx(s2, o);
        const float rs = 1.0f / sqrtf(s2 * (1.0f / 64.0f) + LN_EPS);
        const float* g = inp(F, I_BKVG) + sub * 8; const float* ig = inp(F, I_BIDXG) + sub * 4; const float* ib = inp(F, I_BIDXB) + sub * 4;
        u32x4 co; co.x = cvt_pk_bf16(c[0] * rr * g[0], c[1] * rr * g[1]); co.y = cvt_pk_bf16(c[2] * rr * g[2], c[3] * rr * g[3]);
        co.z = cvt_pk_bf16(c[4] * rr * g[4], c[5] * rr * g[5]); co.w = cvt_pk_bf16(c[6] * rr * g[6], c[7] * rr * g[7]);
        *(u32x4*)(CN + row * 128 + sub * 8) = co;
        u32x2 ko; ko.x = cvt_pk_bf16(k[0] * rs * ig[0] + ib[0], k[1] * rs * ig[1] + ib[1]); ko.y = cvt_pk_bf16(k[2] * rs * ig[2] + ib[2], k[3] * rs * ig[3] + ib[3]);
        *(u32x2*)(IKN + row * 64 + sub * 4) = ko;
    }
}

DI int row_suffix_incl(int v) {
    v += __builtin_amdgcn_update_dpp(0, v, 0x101, 0xf, 0xf, true);
    v += __builtin_amdgcn_update_dpp(0, v, 0x102, 0xf, 0xf, true);
    v += __builtin_amdgcn_update_dpp(0, v, 0x104, 0xf, 0xf, true);
    v += __builtin_amdgcn_update_dpp(0, v, 0x108, 0xf, 0xf, true);
    return v;
}
DI unsigned wave_max_u(unsigned v) {
    int x = (int)v;
#define WMX_STEP(ctrl) { const unsigned o = (unsigned)__builtin_amdgcn_update_dpp(0, x, ctrl, 0xf, 0xf, true); x = (int)(((unsigned)x > o) ? (unsigned)x : o); }
    WMX_STEP(0x101) WMX_STEP(0x102) WMX_STEP(0x104) WMX_STEP(0x108)
#undef WMX_STEP
    const unsigned a = (unsigned)__builtin_amdgcn_readlane(x, 0), b = (unsigned)__builtin_amdgcn_readlane(x, 16), c = (unsigned)__builtin_amdgcn_readlane(x, 32), d = (unsigned)__builtin_amdgcn_readlane(x, 48);
    const unsigned ab = a > b ? a : b, cd = c > d ? c : d; return ab > cd ? ab : cd;
}
DI unsigned lowmask(int k) { return k >= 32 ? 0xffffffffu : ((1u << k) - 1u); }
DI void select_top256_x2(LAS unsigned* cand0, LAS unsigned* cand1, LAS unsigned* cnt0, LAS unsigned* cnt1, LAS unsigned* thr0, LAS unsigned* thr1, bool two, LAS unsigned* hist, int lane) {
    LAS unsigned* cand[2] = {cand0, cand1};
    int n[2]; n[0] = (int)*cnt0; n[1] = two ? (int)*cnt1 : 0;
    unsigned x[2][8];
#pragma unroll
    for (int q = 0; q < 2; ++q)
#pragma unroll
        for (int i = 0; i < 8; ++i) x[q][i] = (lane + 64 * i < n[q]) ? cand[q][lane + 64 * i] : 0u;
    unsigned prefix[2]; int fl[2], need[2] = {256, 256};
#pragma unroll
    for (int q = 0; q < 2; ++q) { unsigned m1 = 0u, m2 = 0u;
#pragma unroll
        for (int i = 0; i < 8; ++i) { m1 = x[q][i] > m1 ? x[q][i] : m1; const unsigned c = x[q][i] ? ~x[q][i] : 0u; m2 = c > m2 ? c : m2; }
        const unsigned mx = wave_max_u(m1), mn = ~wave_max_u(m2);
        const unsigned diff = (mx ^ mn) | 1u; fl[q] = 32 - __builtin_clz(diff); prefix[q] = mx & ~lowmask(fl[q]); }
    const int row = lane >> 4;
    for (int guard = 0; guard < 5 && (fl[0] > 0 || fl[1] > 0); ++guard) {
        int sh[2]; unsigned dm[2], pm[2];
#pragma unroll
        for (int q = 0; q < 2; ++q) { sh[q] = fl[q] > 8 ? fl[q] - 8 : 0; dm[q] = (1u << (fl[q] - sh[q])) - 1u; pm[q] = ~lowmask(fl[q]); }
        { const u32x4 z4 = zero4_local();
#pragma unroll
        for (int q = 0; q < 2; ++q) *(LAS u32x4*)(hist + q * 256 + 4 * lane) = z4; }
        LDS_WAIT();
#pragma unroll
        for (int q = 0; q < 2; ++q)
#pragma unroll
            for (int i = 0; i < 8; ++i) if (x[q][i] != 0u && (x[q][i] & pm[q]) == prefix[q]) __hip_atomic_fetch_add(hist + q * 256 + ((x[q][i] >> sh[q]) & dm[q]), 1u, __ATOMIC_RELAXED, __HIP_MEMORY_SCOPE_WORKGROUP);
        LDS_WAIT();
        u32x4 h4[2]; int sl[2], incl[2];
#pragma unroll
        for (int q = 0; q < 2; ++q) h4[q] = *(const LAS u32x4*)(hist + q * 256 + 4 * lane);
#pragma unroll
        for (int q = 0; q < 2; ++q) { sl[q] = (int)(h4[q].x + h4[q].y + h4[q].z + h4[q].w); const int v = row_suffix_incl(sl[q]);
            const int t1 = __builtin_amdgcn_readlane(v, 16), t2 = __builtin_amdgcn_readlane(v, 32), t3 = __builtin_amdgcn_readlane(v, 48);
            incl[q] = v + (row == 0 ? t1 + t2 + t3 : row == 1 ? t2 + t3 : row == 2 ? t3 : 0); }
#pragma unroll
        for (int q = 0; q < 2; ++q) {
            const unsigned long long bal = __ballot(incl[q] >= need[q]);
            const int L = bal ? 63 - __builtin_clzll(bal) : 0;
            int above = __builtin_amdgcn_readlane(incl[q], L) - __builtin_amdgcn_readlane(sl[q], L);
            const int c3 = __builtin_amdgcn_readlane((int)h4[q].w, L), c2 = __builtin_amdgcn_readlane((int)h4[q].z, L), c1 = __builtin_amdgcn_readlane((int)h4[q].y, L);
            int b = 3;
            if (above + c3 < need[q]) { above += c3; b = 2; if (above + c2 < need[q]) { above += c2; b = 1; if (above + c1 < need[q]) { above += c1; b = 0; } } }
            if (fl[q] > 0) { need[q] -= above; prefix[q] |= (unsigned)(4 * L + b) << sh[q]; fl[q] = sh[q]; }
        }
    }
    const unsigned long long lt = (1ull << lane) - 1ull;
#pragma unroll
    for (int q = 0; q < 2; ++q) {
        if (q == 1 && !two) break;
        int base = 0;
#pragma unroll
        for (int i = 0; i < 8; ++i) { const bool keep = x[q][i] >= prefix[q]; const unsigned long long m = __ballot(keep);
            if (keep) cand[q][base + __builtin_popcountll(m & lt)] = x[q][i];
            base += __builtin_popcountll(m); }
    }
    if (lane == 0) { *cnt0 = 256u; *thr0 = prefix[0]; if (two) { *cnt1 = 256u; *thr1 = prefix[1]; } }
}

DI int idx_bin(float sv) { const unsigned bits = __float_as_uint(sv); const int lin = (int)((bits >> 18) & 0x1fffu);
    if (bits >> 31) { int t = lin - (127 - 13) * 32; t = t < 0 ? 0 : (t > 511 ? 511 : t); return 511 - t; }
    int t = lin - (127 - 9) * 32; t = t < 0 ? 0 : (t > 511 ? 511 : t); return 512 + t; }
DI unsigned idx_bin_lowkey(int tb) {
    if (tb >= 512) { const unsigned lin = (unsigned)(tb - 512 + (127 - 9) * 32); return tb == 512 ? 0x80000000u : (0x80000000u | (lin << 18)); }
    const unsigned lin = (unsigned)((511 - tb) + (127 - 13) * 32);
    const unsigned bits_hi = 0x80000000u | (lin << 18) | 0x3ffffu;
    return (~bits_hi) & 0xffffe000u; }
template <int MODE>
DI void idx_pass(LAS unsigned* BUF, LAS unsigned* CNT, LAS unsigned* ZH, const bf16_t* IKN, size_t rowb, const bf16x8 (&qf)[4][2], const float (&iw)[4], int nsteps, int half, int qloc, int qpos, unsigned thr, int fr, int fq, int sstride = 1) {
    asm volatile("" : "+v"(fr), "+v"(fq), "+v"(qloc), "+v"(qpos));
    const bf16_t* kp = IKN + (rowb + half * 64 + fr) * 64 + fq * 8;
    bf16x8 kf[2][2];
#pragma unroll
    for (int tl = 0; tl < 2; ++tl)
#pragma unroll
        for (int ks = 0; ks < 2; ++ks) kf[tl][ks] = *(const bf16x8*)(kp + (16 * tl) * 64 + ks * 32);
    const int nh = 2 * nsteps;
#pragma clang loop unroll(disable)
    for (int hs = 0; hs < nh; hs += sstride) {
        const int kb = (hs >> 1) * 128 + half * 64 + (hs & 1) * 32;
        bf16x8 kn[2][2];
        { const int hn = (hs + sstride < nh) ? hs + sstride : hs; const int kbn = (hn >> 1) * 128 + (hn & 1) * 32;
#pragma unroll
          for (int tl = 0; tl < 2; ++tl)
#pragma unroll
            for (int ks = 0; ks < 2; ++ks) kn[tl][ks] = *(const bf16x8*)(kp + (size_t)(kbn + 16 * tl) * 64 + ks * 32); }
        __builtin_amdgcn_sched_barrier(0);
        unsigned ckv[8]; int nacc = 0;
#pragma unroll
        for (int tl = 0; tl < 2; ++tl) {
            f32x4 sc = (f32x4){0.f, 0.f, 0.f, 0.f};
#pragma unroll
            for (int h = 0; h < 4; ++h) { f32x4 a = (f32x4){0.f, 0.f, 0.f, 0.f}; a = MFMA16(kf[tl][0], qf[h][0], a); a = MFMA16(kf[tl][1], qf[h][1], a);
#pragma unroll
                for (int i = 0; i < 4; ++i) sc[i] += fmaxf(a[i], 0.f) * iw[h]; }
#pragma unroll
            for (int i = 0; i < 4; ++i) {
                const int key = kb + 16 * tl + 4 * fq + i;
                const float sv = sc[i] + 0.0f;
                unsigned ub = __float_as_uint(sv); ub ^= (ub >> 31) ? 0xffffffffu : 0x80000000u;
                if (MODE == 1 || (MODE == 4 && (i & 1) == 0)) {
                    const int bin = idx_bin(sv);
                    if (key <= qpos) { __hip_atomic_fetch_add(BUF + qloc * 512 + (bin >> 1), 1u << ((bin & 1) << 4), __ATOMIC_RELAXED, __HIP_MEMORY_SCOPE_WORKGROUP);
                        if (sv == 0.0f) __hip_atomic_fetch_add(ZH + qloc * 32 + (key >> 8), 1u << (((key >> 7) & 1) << 4), __ATOMIC_RELAXED, __HIP_MEMORY_SCOPE_WORKGROUP); }
                } else if (MODE == 3) {
                    nacc += idx_bin(sv) + (int)(ub >> 20);
                } else {
                    const unsigned ck = (ub & 0xffffe000u) | (unsigned)(8191 - key);
                    const bool acc = (key <= qpos) && (ck > thr);
                    ckv[tl * 4 + i] = acc ? ck : 0u; nacc += acc ? 1 : 0;
                }
            }
        }
        if (MODE == 3) asm volatile("" :: "v"(nacc));
        if (MODE == 2) {
            if (__ballot(nacc > 0)) {
                unsigned pos = __hip_atomic_fetch_add(CNT + qloc, (unsigned)nacc, __ATOMIC_RELAXED, __HIP_MEMORY_SCOPE_WORKGROUP);
#pragma unroll
                for (int j = 0; j < 8; ++j) if (ckv[j] != 0u) { if (pos < 512u) BUF[qloc * 512 + pos] = ckv[j]; ++pos; }
            }
        }
#pragma unroll
        for (int tl = 0; tl < 2; ++tl)
#pragma unroll
            for (int ks = 0; ks < 2; ++ks) kf[tl][ks] = kn[tl][ks];
    }
}
DI unsigned idx_threshold(const LAS unsigned* hist, const LAS unsigned* zh, int lane, int& n_ge, const int rank = 256) {
    const u32x4 wa = *(const LAS u32x4*)(hist + 8 * lane), wb = *(const LAS u32x4*)(hist + 8 * lane + 4);
    const unsigned wd[8] = {wa.x, wa.y, wa.z, wa.w, wb.x, wb.y, wb.z, wb.w};
    int sl = 0;
#pragma unroll
    for (int q = 0; q < 8; ++q) sl += (int)(wd[q] & 0xffffu) + (int)(wd[q] >> 16);
    const int v = row_suffix_incl(sl);
    const int t1 = __builtin_amdgcn_readlane(v, 16), t2 = __builtin_amdgcn_readlane(v, 32), t3 = __builtin_amdgcn_readlane(v, 48);
    const int row = lane >> 4;
    const int incl = v + (row == 0 ? t1 + t2 + t3 : row == 1 ? t2 + t3 : row == 2 ? t3 : 0);
    const unsigned long long bal = __ballot(incl >= rank);
    if (bal == 0ull) { n_ge = __builtin_amdgcn_readlane(incl, 0); return 0u; }
    const int L = 63 - __builtin_clzll(bal);
    int above = __builtin_amdgcn_readlane(incl, L) - __builtin_amdgcn_readlane(sl, L);
    int tb = 16 * L; int cnt_tb = 0; bool found = false;
#pragma unroll
    for (int q = 7; q >= 0; --q) {
        const unsigned wq = (unsigned)__builtin_amdgcn_readlane((int)wd[q], L);
        const int chi = (int)(wq >> 16), clo = (int)(wq & 0xffffu);
        if (!found) { if (above + chi >= rank) { tb = 16 * L + 2 * q + 1; cnt_tb = chi; found = true; } else above += chi; }
        if (!found) { if (above + clo >= rank) { tb = 16 * L + 2 * q; cnt_tb = clo; found = true; } else above += clo; }
    }
    n_ge = above + cnt_tb;
    if (tb == 512 && n_ge > rank + rank / 12) {
        const unsigned zw = (lane < 32) ? zh[lane] : 0u; const int z0 = (int)(zw & 0xffffu), z1 = (int)(zw >> 16);
        int incl2 = z0 + z1;
#pragma unroll
        for (int o = 1; o < 32; o <<= 1) { const int u = shup_i(incl2, o); if (lane >= o) incl2 += u; }
        const int needz = rank - above;
        const unsigned long long b2 = __ballot(lane < 32 && incl2 >= needz);
        int cut = 8192;
        if (b2) { const int L2 = __builtin_ctzll(b2); const int before = __builtin_amdgcn_readlane(incl2, L2) - __builtin_amdgcn_readlane(z0 + z1, L2);
            const int zz0 = __builtin_amdgcn_readlane(z0, L2); cut = (before + zz0 >= needz) ? 128 * (2 * L2 + 1) : 128 * (2 * L2 + 2); }
        const int totz = __builtin_amdgcn_readlane(incl2, 31);
        n_ge = above + (cnt_tb - totz) + ((needz + 127 < totz) ? needz + 127 : totz);
        return cut >= 8192 ? 0x7fffffffu : (0x80000000u | (unsigned)(8191 - cut));
    }
    return tb > 0 ? idx_bin_lowkey(tb) - 1u : 0u;
}
DI unsigned ref_threshold(const LAS unsigned* cand, int n, int lane) {
    unsigned x[8];
#pragma unroll
    for (int i = 0; i < 8; ++i) x[i] = (lane + 64 * i < n) ? cand[lane + 64 * i] : 0u;
    unsigned prefix = 0u;
    for (int bit = 31; bit >= 0; --bit) { const unsigned c = prefix | (1u << bit); int tot = 0;
#pragma unroll
        for (int i = 0; i < 8; ++i) tot += __builtin_popcountll(__ballot(x[i] >= c));
        if (tot >= 256) prefix = c; }
    return prefix;
}
template <int IMODE> DI void indexer_phase(Ctx& F) {
    LAS unsigned* CAND = (LAS unsigned*)F.lds;
    LAS unsigned* CNT = (LAS unsigned*)(F.lds + 131072);
    LAS unsigned* THR = (LAS unsigned*)(F.lds + 131072 + 256);
    LAS unsigned* WL = (LAS unsigned*)(F.lds + 131072 + 512 + 16384);
    LAS unsigned* WLN = WL + 64; LAS unsigned* WLH = WL + 65;
    const int tid = F.tid, lane = F.lane, w = F.wave, fr = lane & 15, fq = lane >> 4;
    const bf16_t* PROJ = (const bf16_t*)(F.ws + WS_PROJ);
    const bf16_t* IKN = (const bf16_t*)(F.ws + WS_IKN);
    unsigned short* IDX = (unsigned short*)(F.ws + WS_IDX);
    const int qg = w & 3, half = w >> 2;
    LAS unsigned* UQ = WL + 68;
    for (;;) {
        __syncthreads();
        if (tid == 0) { unsigned res = 0xffffffffu;
#pragma clang loop unroll(disable)
            for (int k = 0; k < 8; ++k) { const unsigned q = (unsigned)(F.bx + k) & 7u; const unsigned v = __hip_atomic_fetch_add(F.ctl + CW_IQ + (IMODE * 8 + (int)q) * 16, 1u, __ATOMIC_RELAXED, __HIP_MEMORY_SCOPE_AGENT); if (v < 128u) { res = q * 128u + v; break; } }
            *UQ = res; }
        __syncthreads();
        const unsigned uq = *UQ;
        if (uq == 0xffffffffu) break;
        const int b = __builtin_amdgcn_readfirstlane((int)(uq >> 7)), qb = 127 - __builtin_amdgcn_readfirstlane((int)(uq & 127u));
        const int q0 = qb * 64;
        const size_t rowb = (size_t)b * SEQ;
        constexpr int pm = IMODE;
        unsigned short* IDXO = pm ? IDX : (unsigned short*)(F.ws + WS_QLAT);
        __syncthreads();
        if (tid < 64) { CNT[tid] = 0u; THR[tid] = 0u; }
        const int qloc = 16 * qg + fr, qpos = q0 + qloc;
        bf16x8 qf[4][2]; float iw[4];
#pragma unroll
        for (int h = 0; h < 4; ++h) {
#pragma unroll
            for (int ks = 0; ks < 2; ++ks) qf[h][ks] = *(const bf16x8*)(PROJ + (rowb + qpos) * WINBP + B_IQ + h * 64 + ks * 32 + fq * 8);
            iw[h] = bf2f(PROJ[(rowb + qpos) * WINBP + B_IW + h]) * 0.0625f;
        }
        __syncthreads();
        const int nsteps = (q0 + 64 + 127) / 128;
        LAS unsigned* FLG = WL + 66;
        LAS unsigned* ZH = WL + 256;
        bool fast = false;
        if (nsteps >= 6 && pm == 1) {
            { const u32x4 z4 = zero4_local(); for (int u = tid; u < 64 * 512 / 4; u += 512) *(LAS u32x4*)(CAND + 4 * u) = z4; *(LAS u32x4*)(ZH + 4 * tid) = z4; }
            if (tid == 0) *FLG = 0u;
            __syncthreads();
            const bool sampled = nsteps >= 16;
            if (sampled) idx_pass<4>(CAND, CNT, ZH, IKN, rowb, qf, iw, nsteps, half, qloc, qpos, 0u, fr, fq); else idx_pass<1>(CAND, CNT, ZH, IKN, rowb, qf, iw, nsteps, half, qloc, qpos, 0u, fr, fq);
#if PROBE_PASS3
            idx_pass<3>(CAND, CNT, ZH, IKN, rowb, qf, iw, nsteps, half, qloc, qpos, 0u, fr, fq); idx_pass<3>(CAND, CNT, ZH, IKN, rowb, qf, iw, nsteps, half, qloc, qpos, 0u, fr, fq);
#endif
            __syncthreads();
#pragma clang loop unroll(disable)
            for (int qq = 0; qq < 8; ++qq) { int nge; const unsigned t = sampled ? idx_threshold(CAND + (w * 8 + qq) * 512, ZH + (w * 8 + qq) * 32, lane, nge, 184) : idx_threshold(CAND + (w * 8 + qq) * 512, ZH + (w * 8 + qq) * 32, lane, nge, 256);
                if (!sampled && nge > 512 && lane == 0) *FLG = 1u;
                if (lane == 0) { THR[w * 8 + qq] = t; CNT[w * 8 + qq] = 0u; } }
            __syncthreads();
            fast = (*FLG == 0u);
            if (fast) {
                if (tid == 0) { *WLN = 0u; *WLH = 0u; }
                __syncthreads();
                idx_pass<2>(CAND, CNT, ZH, IKN, rowb, qf, iw, nsteps, half, qloc, qpos, THR[qloc], fr, fq);
                __syncthreads();
                LAS unsigned* RTY = WL + 67;
                LAS unsigned* THR2 = WL + 128;
                if (tid == 0) *RTY = 0u;
                if (tid < 64) THR2[tid] = 0xffffffffu;
                __syncthreads();
                if (sampled && lane < 8) { const int ql = w * 8 + lane; const unsigned n = CNT[ql];
                    if (n < 256u) *FLG = 1u;
                    else if (n > 512u && PROBE_NORETRY) *FLG = 1u;
                    else if (n > 512u) { *RTY = 1u; CNT[ql] = 512u; THR2[ql] = 0xfffffffeu; const unsigned p = __hip_atomic_fetch_add(WLN, 1u, __ATOMIC_RELAXED, __HIP_MEMORY_SCOPE_WORKGROUP); if (p < 64u) WL[p] = (unsigned)ql; } }
                __syncthreads();
                if (*FLG == 0u && *RTY != 0u) {
                    const int totr = (int)*WLN;
                    LAS unsigned* hist = (LAS unsigned*)(F.lds + 131072 + 512) + w * 512;
                    for (int guard = 0; guard < 40; ++guard) {
                        int idx = 0; if (lane == 0) idx = (int)__hip_atomic_fetch_add(WLH, 2u, __ATOMIC_RELAXED, __HIP_MEMORY_SCOPE_WORKGROUP);
                        idx = __builtin_amdgcn_readfirstlane(idx);
                        if ((unsigned)idx >= (unsigned)totr) break;
                        const bool two = idx + 1 < totr; const int qla = (int)WL[idx], qlb = two ? (int)WL[idx + 1] : qla;
                        select_top256_x2(CAND + qla * 512, CAND + qlb * 512, CNT + qla, CNT + qlb, THR + qla, THR + qlb, two, hist, lane);
                        LDS_WAIT();
                        if (lane == 0) { THR2[qla] = THR[qla]; CNT[qla] = 0u; if (two) { THR2[qlb] = THR[qlb]; CNT[qlb] = 0u; } }
                    }
                    __syncthreads();
                    if (__ballot(THR2[qloc] != 0xffffffffu) != 0ull)
                        idx_pass<2>(CAND, CNT, ZH, IKN, rowb, qf, iw, nsteps, half, qloc, qpos, THR2[qloc], fr, fq);
                    __syncthreads();
                    if (lane < 8) { const int ql = w * 8 + lane; const unsigned n = CNT[ql]; if (n < 256u || n > 512u || THR2[ql] == 0xfffffffeu) *FLG = 1u; }
                }
                __syncthreads();
                if (tid == 0) { *WLN = 0u; *WLH = 0u; }
                __syncthreads();
                fast = (*FLG == 0u);
                if (lane < 8 && fast) { const int ql = w * 8 + lane; if (CNT[ql] > 256u) { const unsigned p = __hip_atomic_fetch_add(WLN, 1u, __ATOMIC_RELAXED, __HIP_MEMORY_SCOPE_WORKGROUP); WL[p] = (unsigned)ql; } }
                __syncthreads();
                const int total = (int)*WLN;
                LAS unsigned* hist = (LAS unsigned*)(F.lds + 131072 + 512) + w * 512;
                for (int guard = 0; guard < 40; ++guard) {
                    int idx = 0; if (lane == 0) idx = (int)__hip_atomic_fetch_add(WLH, 2u, __ATOMIC_RELAXED, __HIP_MEMORY_SCOPE_WORKGROUP);
                    idx = __builtin_amdgcn_readfirstlane(idx);
                    if ((unsigned)idx >= (unsigned)total) break;
                    const bool two = idx + 1 < total; const int qla = (int)WL[idx], qlb = two ? (int)WL[idx + 1] : qla;
                    select_top256_x2(CAND + qla * 512, CAND + qlb * 512, CNT + qla, CNT + qlb, THR + qla, THR + qlb, two, hist, lane);
                    LDS_WAIT();
                }
                __syncthreads();
            }
        }
        if (!fast) { __syncthreads(); if (tid < 64) { CNT[tid] = 0u; THR[tid] = 0u; } __syncthreads(); }
        int lane_s = lane; asm volatile("" : "+v"(lane_s));
        { const int fr = lane_s & 15, fq = lane_s >> 4, qloc = 16 * qg + fr, qpos = q0 + qloc;
        bf16x8 kf[4][2];
#pragma unroll
        for (int tl = 0; tl < 4; ++tl)
#pragma unroll
            for (int ks = 0; ks < 2; ++ks) kf[tl][ks] = *(const bf16x8*)(IKN + (rowb + half * 64 + 16 * tl + fr) * 64 + ks * 32 + fq * 8);
#pragma clang loop unroll(disable)
        for (int st = 0; st < (fast ? 0 : nsteps); ++st) {
            const int kb = st * 128 + half * 64;
            const unsigned thr = THR[qloc];
            if (tid == 0) { *WLN = 0u; *WLH = 0u; }
            bf16x8 kn[4][2];
            { const int kbn = (st + 1 < nsteps) ? kb + 128 : kb;
#pragma unroll
              for (int tl = 0; tl < 4; ++tl)
#pragma unroll
                for (int ks = 0; ks < 2; ++ks) kn[tl][ks] = *(const bf16x8*)(IKN + (rowb + kbn + 16 * tl + fr) * 64 + ks * 32 + fq * 8); }
            unsigned ckv[16]; int nacc = 0;
#pragma unroll
            for (int tl = 0; tl < 4; ++tl) {
                f32x4 sc = (f32x4){0.f, 0.f, 0.f, 0.f};
#pragma unroll
                for (int h = 0; h < 4; ++h) { f32x4 a = (f32x4){0.f, 0.f, 0.f, 0.f}; a = MFMA16(kf[tl][0], qf[h][0], a); a = MFMA16(kf[tl][1], qf[h][1], a);
#pragma unroll
                    for (int i = 0; i < 4; ++i) sc[i] += fmaxf(a[i], 0.f) * iw[h]; }
#pragma unroll
                for (int i = 0; i < 4; ++i) {
                    const int key = kb + 16 * tl + 4 * fq + i;
                    const float sv = sc[i] + 0.0f;
                    unsigned ub = __float_as_uint(sv); ub ^= (ub >> 31) ? 0xffffffffu : 0x80000000u;
                    const unsigned ck = (ub & 0xffffe000u) | (unsigned)(8191 - key);
                    const bool acc = (key <= qpos) && (ck > thr);
                    ckv[tl * 4 + i] = acc ? ck : 0u; nacc += acc ? 1 : 0;
                }
            }
            if (__ballot(nacc > 0)) {
                unsigned pos = __hip_atomic_fetch_add(CNT + qloc, (unsigned)nacc, __ATOMIC_RELAXED, __HIP_MEMORY_SCOPE_WORKGROUP);
#pragma unroll
                for (int j = 0; j < 16; ++j) if (ckv[j] != 0u) { if (pos < 512u) CAND[qloc * 512 + pos] = ckv[j]; ++pos; }
            }
#pragma unroll
            for (int tl = 0; tl < 4; ++tl)
#pragma unroll
                for (int ks = 0; ks < 2; ++ks) kf[tl][ks] = kn[tl][ks];
            __syncthreads();
            const bool lastst = (st == nsteps - 1);
            {
                if (lane < 8) { const int ql = w * 8 + lane; const unsigned n = CNT[ql];
                    if (n >= 384u || (lastst && n > 256u)) { const unsigned p = __hip_atomic_fetch_add(WLN, 1u, __ATOMIC_RELAXED, __HIP_MEMORY_SCOPE_WORKGROUP); WL[p] = (unsigned)ql; } }
                __syncthreads();
                const int total = (int)*WLN;
                LAS unsigned* hist = (LAS unsigned*)(F.lds + 131072 + 512) + w * 512;
                for (int guard = 0; guard < 40; ++guard) {
                    int idx = 0; if (lane == 0) idx = (int)__hip_atomic_fetch_add(WLH, 2u, __ATOMIC_RELAXED, __HIP_MEMORY_SCOPE_WORKGROUP);
                    idx = __builtin_amdgcn_readfirstlane(idx);
                    if ((unsigned)idx >= (unsigned)total) break;
                    const bool two = idx + 1 < total; const int qla = (int)WL[idx], qlb = two ? (int)WL[idx + 1] : qla;
#if PROBE_SEL
                    const unsigned ra = ref_threshold(CAND + qla * 512, (int)CNT[qla], lane), rb = ref_threshold(CAND + qlb * 512, (int)CNT[qlb], lane);
#endif
                    select_top256_x2(CAND + qla * 512, CAND + qlb * 512, CNT + qla, CNT + qlb, THR + qla, THR + qlb, two, hist, lane);
                    LDS_WAIT();
#if PROBE_SEL
                    if (THR[qla] != ra || (two && THR[qlb] != rb) || CNT[qla] != 256u) { if (lane == 0) __hip_atomic_store(F.ctl + CW_ERR, 1u, __ATOMIC_RELAXED, __HIP_MEMORY_SCOPE_AGENT); }
#endif
                }
            }
            __syncthreads();
        }
        }
        LAS unsigned* bm = (LAS unsigned*)(F.lds + 131072 + 512) + w * 512;
#pragma clang loop unroll(disable)
        for (int qq = 0; qq < 8; ++qq) { const int ql = w * 8 + qq; const int n = (int)CNT[ql];
            unsigned short* dst = IDXO + (rowb + q0 + ql) * 256;
#pragma unroll
            for (int i = 0; i < 4; ++i) bm[lane + 64 * i] = 0u;
#pragma unroll
            for (int i = 0; i < 4; ++i) { const int p = lane + 64 * i; if (p < n) { const unsigned key = 8191u - (CAND[ql * 512 + p] & 0x1fffu); __hip_atomic_fetch_or(bm + (key >> 5), 1u << (key & 31u), __ATOMIC_RELAXED, __HIP_MEMORY_SCOPE_WORKGROUP); } }
            LDS_WAIT();
            const u32x4 wv = *(const LAS u32x4*)(bm + 4 * lane);
            unsigned wd[4] = {wv.x, wv.y, wv.z, wv.w};
            const int cmine = __builtin_popcount(wd[0]) + __builtin_popcount(wd[1]) + __builtin_popcount(wd[2]) + __builtin_popcount(wd[3]);
            int incl = cmine;
#pragma unroll
            for (int o = 1; o < 64; o <<= 1) { const int v = shup_i(incl, o); if (lane >= o) incl += v; }
            int pos = incl - cmine;
#pragma unroll
            for (int jw = 0; jw < 4; ++jw) { unsigned word = wd[jw]; while (word) { const int bpos = __builtin_ctz(word); dst[pos++] = (unsigned short)((4 * lane + jw) * 32 + bpos); word &= word - 1u; } }
#pragma unroll
            for (int i = 0; i < 4; ++i) { const int p = lane + 64 * i; if (p >= n) dst[p] = (unsigned short)0xffffu; }
            LDS_WAIT();
        }
    }
    __syncthreads();
}
DI void idx_compare(Ctx& F) {
    const unsigned* a = (const unsigned*)(F.ws + WS_IDX); const unsigned* b = (const unsigned*)(F.ws + WS_QLAT); bool bad = false;
    for (size_t i = (size_t)F.bx * 512 + F.tid; i < (size_t)T * 128; i += (size_t)F.G * 512) bad |= a[i] != b[i];
    if (__ballot(bad)) { if (F.lane == 0) __hip_atomic_store(F.ctl + CW_ERR, 1u, __ATOMIC_RELAXED, __HIP_MEMORY_SCOPE_AGENT); }
}

DI int rotl4(int k) { return ((k << 1) & 15) | ((k >> 3) & 1); }
DI void dsa_attn_phase(Ctx& F) {
    const int tid = F.tid, lane = F.lane, w = F.wave, fr = lane & 15, fq = lane >> 4;
    LAS unsigned char* wl = F.lds + w * 17408;
    LAS unsigned short* IDL = (LAS unsigned short*)(wl + 16384);
    LAS unsigned char* BKL = wl + 16384 + 512;
    LAS float* RB = (LAS float*)(F.lds + 8 * 17408);
    LAS unsigned char* TBL = (LAS unsigned char*)(F.lds + 8 * 17408 + 1600);
    const bf16_t* PROJ = (const bf16_t*)(F.ws + WS_PROJ);
    const bf16_t* CN = (const bf16_t*)(F.ws + WS_CN);
    const unsigned short* IDX = (const unsigned short*)(F.ws + WS_IDX);
    const bf16_t* WUK = (const bf16_t*)(F.ws + WS_WUK); const bf16_t* WUVT = (const bf16_t*)(F.ws + WS_WUVT);
    bf16_t* QLAT = (bf16_t*)(F.ws + WS_QLAT); bf16_t* OLAT = (bf16_t*)(F.ws + WS_OLAT); bf16_t* MIX = (bf16_t*)(F.ws + WS_MIX);
    __syncthreads();
    if (tid < 384) RB[tid] = inp(F, I_RELB)[tid]; else if (tid < 396) RB[tid] = -1.0e30f;
    if (tid < 128) { int bk = tid; if (tid >= 16) { bk = 16 + (int)(logf((float)tid * (1.0f / 16.0f)) / logf(8.0f) * 16.0f); bk = bk > 31 ? 31 : bk; } TBL[tid] = (unsigned char)bk; }
    __syncthreads();
    for (int it = 0; (it + 1) * ((F.G >> 3) * 8) <= SEQ / 16; ++it) {
        const int tb = (F.bx & 7) * (SEQ / 16) + it * ((F.G >> 3) * 8) + (F.bx >> 3) * 8 + w;
        const size_t t0 = (size_t)tb * 16;
        const int b = (int)(t0 / SEQ);
        for (int h = 0; h < 12; ++h) {
            bf16x8 qf[2];
#pragma unroll
            for (int ks = 0; ks < 2; ++ks) qf[ks] = *(const bf16x8*)(PROJ + (t0 + fr) * WINBP + h * 64 + ks * 32 + fq * 8);
#pragma unroll
            for (int rt = 0; rt < 8; ++rt) { f32x4 a = (f32x4){0.f, 0.f, 0.f, 0.f};
#pragma unroll
                for (int ks = 0; ks < 2; ++ks) { const bf16x8 wf = *(const bf16x8*)(WUK + ((size_t)h * 128 + 16 * rt + fr) * 64 + ks * 32 + fq * 8); a = MFMA16(wf, qf[ks], a); }
                u32x2 o; o.x = cvt_pk_bf16(a[0] * 0.125f, a[1] * 0.125f); o.y = cvt_pk_bf16(a[2] * 0.125f, a[3] * 0.125f);
                *(u32x2*)(QLAT + ((t0 + fr) * 12 + h) * 128 + 16 * rt + 4 * fq) = o; }
        }
        VM_WAIT();
        for (int qi = 0; qi < 16; ++qi) {
            const size_t t = t0 + qi; const int pos = (int)(t % SEQ);
            LDS_WAIT();
            { const u32x2 iw2 = *(const u32x2*)(IDX + t * 256 + 4 * lane);
              const unsigned idv[4] = {iw2.x & 0xffffu, iw2.x >> 16, iw2.y & 0xffffu, iw2.y >> 16}; unsigned pk = 0u;
#pragma unroll
              for (int i = 0; i < 4; ++i) IDL[32 * (lane >> 3) + 8 * i + (lane & 7)] = (unsigned short)idv[i];
#pragma unroll
              for (int i = 0; i < 4; ++i) { const int rel = pos - (int)idv[i]; const bool ok = (idv[i] != 0xffffu) && rel >= 0; const int ti = rel < 0 ? 0 : (rel > 127 ? 127 : rel);
                  const unsigned tb = TBL[ti]; const unsigned bk = !ok ? 32u : (rel > 127 ? 31u : tb); pk |= bk << (8 * i); }
              *(LAS unsigned*)(BKL + 4 * lane) = pk; }
            bf16x8 ql[4];
#pragma unroll
            for (int ks = 0; ks < 4; ++ks) { u32x4 v = (u32x4){0u, 0u, 0u, 0u}; if (fr < 12) v = *(const u32x4*)(QLAT + (t * 12 + fr) * 128 + ks * 32 + fq * 8); ql[ks] = __builtin_bit_cast(bf16x8, v); }
            VM_WAIT(); LDS_WAIT();
            const bf16_t* cb = CN + (size_t)b * SEQ * 128;
#define DSA_ISSUE(c_) do { LAS unsigned char* buf_ = wl + ((c_) & 1) * 8192; const u32x4 iv_ = *(const LAS u32x4*)(IDL + 32 * (c_) + 8 * (lane >> 4)); const unsigned ivw_[4] = {iv_.x, iv_.y, iv_.z, iv_.w}; \
            _Pragma("unroll") for (int i_ = 0; i_ < 8; ++i_) { const int kk_ = 4 * i_ + (lane >> 4); \
                const int id_ = (int)((ivw_[i_ >> 1] >> (16 * (i_ & 1))) & 0x1fffu); const int p_ = (lane & 15) ^ rotl4(kk_ & 15); \
                __builtin_amdgcn_global_load_lds((const unsigned*)(cb + (size_t)id_ * 128 + p_ * 8), (LAS unsigned*)(buf_ + i_ * 1024), 16, 0, 0); } } while (0)
            f32x4 oacc[8];
#pragma unroll
            for (int rt = 0; rt < 8; ++rt) oacc[rt] = (f32x4){0.f, 0.f, 0.f, 0.f};
            float mrun = -INFINITY, lrun = 0.f;
            DSA_ISSUE(0);
            for (int c = 0; c < 8; ++c) {
                if (c < 7) { DSA_ISSUE(c + 1); asm volatile("s_waitcnt vmcnt(8)" ::: "memory"); } else { asm volatile("s_waitcnt vmcnt(0)" ::: "memory"); }
                const LAS unsigned char* buf = wl + (c & 1) * 8192;
                f32x4 sacc[2]; float lg[8];
#pragma unroll
                for (int jt = 0; jt < 2; ++jt) { sacc[jt] = (f32x4){0.f, 0.f, 0.f, 0.f};
#pragma unroll
                    for (int ks = 0; ks < 4; ++ks) { const bf16x8 cf = *(const LAS bf16x8*)(buf + (16 * jt + fr) * 256 + (((ks * 4 + fq) ^ rotl4(fr)) * 16)); sacc[jt] = MFMA16(cf, ql[ks], sacc[jt]); } }
                float mloc = -INFINITY;
                {
                    const unsigned bw0 = *(const LAS unsigned*)(BKL + 32 * c + 4 * fq), bw1 = *(const LAS unsigned*)(BKL + 32 * c + 16 + 4 * fq);
                    const int hh = fr < 12 ? fr : 0;
                    float bv[8]; unsigned bb[8];
#pragma unroll
                    for (int i = 0; i < 4; ++i) { bb[i] = (bw0 >> (8 * i)) & 0xffu; bb[4 + i] = (bw1 >> (8 * i)) & 0xffu; }
#pragma unroll
                    for (int i = 0; i < 8; ++i) bv[i] = RB[bb[i] * 12 + hh];
#pragma unroll
                    for (int i = 0; i < 8; ++i) { const float v = sacc[i >> 2][i & 3] + bv[i]; lg[i] = v; mloc = fmaxf(mloc, v); }
                }
                mloc = rows4_max(mloc);
                const float mnew = fmaxf(mrun, mloc);
                const float scl = __expf(mrun - mnew);
                float p[8], ps = 0.f;
#pragma unroll
                for (int i = 0; i < 8; ++i) { p[i] = __expf(lg[i] - mnew); ps += p[i]; }
                lrun = lrun * scl + ps; mrun = mnew;
                u32x4 pw; pw.x = cvt_pk_bf16(p[0], p[1]); pw.y = cvt_pk_bf16(p[2], p[3]); pw.z = cvt_pk_bf16(p[4], p[5]); pw.w = cvt_pk_bf16(p[6], p[7]);
                const bf16x8 pf = __builtin_bit_cast(bf16x8, pw);
                const int i16 = lane & 15, qr = i16 >> 2, pp = i16 & 3, kk0 = 4 * fq + qr;
                unsigned ta[8];
#pragma unroll
                for (int rt = 0; rt < 8; ++rt) ta[rt] = (unsigned)(size_t)buf + (unsigned)(kk0 * 256 + (((2 * rt + (pp >> 1)) ^ rotl4(kk0)) * 16) + 8 * (pp & 1));
                s16x4 tlo[8], thi[8];
                asm volatile("ds_read_b64_tr_b16 %0, %16\n\tds_read_b64_tr_b16 %8, %16 offset:4096\n\t"
                             "ds_read_b64_tr_b16 %1, %17\n\tds_read_b64_tr_b16 %9, %17 offset:4096\n\t"
                             "ds_read_b64_tr_b16 %2, %18\n\tds_read_b64_tr_b16 %10, %18 offset:4096\n\t"
                             "ds_read_b64_tr_b16 %3, %19\n\tds_read_b64_tr_b16 %11, %19 offset:4096\n\t"
                             "ds_read_b64_tr_b16 %4, %20\n\tds_read_b64_tr_b16 %12, %20 offset:4096\n\t"
                             "ds_read_b64_tr_b16 %5, %21\n\tds_read_b64_tr_b16 %13, %21 offset:4096\n\t"
                             "ds_read_b64_tr_b16 %6, %22\n\tds_read_b64_tr_b16 %14, %22 offset:4096\n\t"
                             "ds_read_b64_tr_b16 %7, %23\n\tds_read_b64_tr_b16 %15, %23 offset:4096\n\t"
                             "s_waitcnt lgkmcnt(0)"
                             : "=&v"(tlo[0]), "=&v"(tlo[1]), "=&v"(tlo[2]), "=&v"(tlo[3]), "=&v"(tlo[4]), "=&v"(tlo[5]), "=&v"(tlo[6]), "=&v"(tlo[7]),
                               "=&v"(thi[0]), "=&v"(thi[1]), "=&v"(thi[2]), "=&v"(thi[3]), "=&v"(thi[4]), "=&v"(thi[5]), "=&v"(thi[6]), "=&v"(thi[7])
                             : "v"(ta[0]), "v"(ta[1]), "v"(ta[2]), "v"(ta[3]), "v"(ta[4]), "v"(ta[5]), "v"(ta[6]), "v"(ta[7]) : "memory");
#pragma unroll
                for (int rt = 0; rt < 8; ++rt) {
                    const bf16x8 cf = __builtin_shufflevector(tlo[rt], thi[rt], 0, 1, 2, 3, 4, 5, 6, 7);
                    oacc[rt] = oacc[rt] * scl; oacc[rt] = MFMA16(cf, pf, oacc[rt]);
                }
                LDS_WAIT();
            }
            lrun = rows4_sum(lrun);
            const float inv = 1.0f / lrun;
            if (fr < 12) {
#pragma unroll
                for (int rt = 0; rt < 8; ++rt) { u32x2 o; o.x = cvt_pk_bf16(oacc[rt][0] * inv, oacc[rt][1] * inv); o.y = cvt_pk_bf16(oacc[rt][2] * inv, oacc[rt][3] * inv);
                    *(u32x2*)(OLAT + (t * 12 + fr) * 128 + 16 * rt + 4 * fq) = o; }
            }
        }
        VM_WAIT();
        for (int h = 0; h < 12; ++h) {
            bf16x8 of[4];
#pragma unroll
            for (int ks = 0; ks < 4; ++ks) of[ks] = *(const bf16x8*)(((DIAG_WUVQ == 1) ? QLAT : OLAT) + ((t0 + fr) * 12 + h) * 128 + ks * 32 + fq * 8);
#pragma unroll
            for (int dt = 0; dt < 4; ++dt) { f32x4 a = (f32x4){0.f, 0.f, 0.f, 0.f};
#pragma unroll
                for (int ks = 0; ks < 4; ++ks) { const bf16x8 wf = *(const bf16x8*)(WUVT + ((size_t)h * 64 + 16 * dt + fr) * 128 + ks * 32 + fq * 8); a = MFMA16(wf, of[ks], a); }
                u32x2 o; o.x = cvt_pk_bf16(a[0], a[1]); o.y = cvt_pk_bf16(a[2], a[3]);
                if (DIAG_WUVQ == 2) { o.x = 0x3f803f80u; o.y = 0x3f803f80u; }
                (void)o; *(unsigned*)((unsigned char*)MIX + (t0 + fr) * D + h * 64 + 16 * dt + 4 * fq) = pk4_fp8(a[0] * 16.0f, a[1] * 16.0f, a[2] * 16.0f, a[3] * 16.0f); }
        }
    }
    __syncthreads();
}

#define WSP(off) (F.ws + (off))
DI void site_proj0(Ctx F) {
    launder(F);
    pg8::DenseOrderT<T / 256, WINA / 256, 0> S; S.init(F.G, F.bx);
    pg8::EpiBf16<true> E{(bf16_t*)WSP(WS_PROJ), WINA, (bf16_t*)WSP(WS_KV), 1024};
    pg8::Gemm g{WSP(WS_XB8), WSP(WS_WINA), 1024, nullptr, nullptr, nullptr, 0x7d7d7d7d, 0x7a7a7a7a};
    pg8::gemm_phase<pg8::EpiBf16<true>, pg8::DenseOrderT<T / 256, WINA / 256, 0>, 2, true>(F.lds, g, S, E, F.tid);
}
DI void site_kv(Ctx F) {
    launder(F);
    pg8::DenseOrderT<0, 4, 32> S; S.init(F.G, F.bx);
    pg8::EpiBf16<true> E{(bf16_t*)WSP(WS_PROJ), WINA, (bf16_t*)WSP(WS_KV), 1024};
    pg8::Gemm g{WSP(WS_MEMBF), WSP(WS_WKV), 2048, nullptr, WSP(WS_MEMBF), WSP(WS_WKV), 0, 0};
    pg8::gemm_phase<pg8::EpiBf16<true>, pg8::DenseOrderT<0, 4, 32>, 0>(F.lds, g, S, E, F.tid);
}
DI void site_proj1(Ctx F) {
    launder(F);
    pg8::DenseOrderT<T / 256, WINBP / 256, 0> S; S.init(F.G, F.bx);
    pg8::EpiBf16<true> E{(bf16_t*)WSP(WS_PROJ), WINBP, (bf16_t*)WSP(WS_KV), 1024};
    pg8::Gemm g{WSP(WS_XB8), WSP(WS_WINB), 1024, nullptr, nullptr, nullptr, 0x7d7d7d7d, 0x7a7a7a7a};
    pg8::gemm_phase<pg8::EpiBf16<true>, pg8::DenseOrderT<T / 256, WINBP / 256, 0>, 2, true>(F.lds, g, S, E, F.tid);
}
DI void site_out0(Ctx F) {
    launder(F);
    pg8::Gemm g{WSP(WS_MIX), WSP(WS_WOUT), 2048, nullptr, nullptr, nullptr, 0, 0};
    pg8::DenseOrderT<T / 256, 4, 0> S; S.init(F.G, F.bx);
    pg8::EpiBf16<false> E{(bf16_t*)WSP(WS_Z), 1024, nullptr, 0};
    pg8::gemm_phase<pg8::EpiBf16<false>, pg8::DenseOrderT<T / 256, 4, 0>, 0>(F.lds, g, S, E, F.tid);
}
DI void site_out1(Ctx F) {
    launder(F);
    pg8::Gemm g{WSP(WS_MIX), WSP(WS_WOUT) + (size_t)1024 * 1024 * 2, 1024, nullptr, nullptr, nullptr, 0x7b7b7b7b, 0x7a7a7a7a};
    pg8::DenseOrderT<T / 256, 4, 0> S; S.init(F.G, F.bx);
    pg8::EpiBf16<false> E{(bf16_t*)WSP(WS_Z), 1024, nullptr, 0};
    pg8::gemm_phase<pg8::EpiBf16<false>, pg8::DenseOrderT<T / 256, 4, 0>, 2, true>(F.lds, g, S, E, F.tid);
}
DI void site_g1(Ctx F, int layer) {
    launder(F);
    build_mtab(F, layer);
    pg8::Gemm g{WSP(WS_XB8), WSP(WS_W1) + (size_t)layer * 32 * 2048 * 1024, 1024, (const unsigned*)WSP(WS_LIST), nullptr, nullptr, 0x7d7d7d7d, 0x7a7a7a7a};
    pg8::MoeOrder<8, true> S{(const LAS int*)(F.lds + MTAB_OFF), (const LAS unsigned*)(F.lds + GMTAB_OFF), F.G, F.bx, 2048};
    pg8::EpiSwiglu E{(unsigned char*)WSP(WS_ACT), inp(F, I_B1) + (size_t)layer * 32 * 2048};
    pg8::gemm_phase<pg8::EpiSwiglu, pg8::MoeOrder<8, true>, 1, true>(F.lds, g, S, E, F.tid);
}
DI void site_g2(Ctx F, int layer) {
    launder(F);
    build_mtab(F, layer);
    pg8::Gemm g{WSP(WS_ACT), WSP(WS_W2) + (size_t)layer * 32 * 1024 * 1024, 1024, nullptr, nullptr, nullptr, 0x7d7d7d7d, 0x79797979};
    pg8::MoeOrder<4, false> S{(const LAS int*)(F.lds + MTAB_OFF), (const LAS unsigned*)(F.lds + GMTAB_OFF), F.G, F.bx, 1024};
    pg8::EpiFp8Bias E{(unsigned char*)WSP(WS_Y), 1024, inp(F, I_B2) + (size_t)layer * 32 * 1024};
    pg8::gemm_phase<pg8::EpiFp8Bias, pg8::MoeOrder<4, false>, 2, true>(F.lds, g, S, E, F.tid);
}
#undef WSP

DI void dsa_check_phase(Ctx& F) {
    if (F.wave != 0) return;
    const int lane = F.lane;
    LAS float* SC = (LAS float*)F.lds;
    LAS float* IQF = (LAS float*)(F.lds + 32768);
    LAS unsigned* BM = (LAS unsigned*)(F.lds + 33792);
    LAS float* QL = (LAS float*)(F.lds + 34816);
    LAS float* OL = (LAS float*)(F.lds + 40960);
    LAS float* PP = (LAS float*)(F.lds + 47104);
    LAS unsigned short* SEL = (LAS unsigned short*)(F.lds + 59392);
    const bf16_t* PROJ = (const bf16_t*)(F.ws + WS_PROJ); const bf16_t* IKN = (const bf16_t*)(F.ws + WS_IKN); const bf16_t* CN = (const bf16_t*)(F.ws + WS_CN);
    const unsigned short* IDX = (const unsigned short*)(F.ws + WS_IDX); const bf16_t* MIX = (const bf16_t*)(F.ws + WS_MIX);
    const bf16_t* WUK = (const bf16_t*)(F.ws + WS_WUK); const bf16_t* WUVT = (const bf16_t*)(F.ws + WS_WUVT);
    const int ptab[8] = {3, 100, 255, 256, 300, 1500, 5000, 8191};
    int pos = 0;
#pragma unroll
    for (int q = 0; q < 8; ++q) if ((F.bx & 7) == q) pos = ptab[q];
    pos = (pos + (F.bx >> 3) * 211) & 8191; const int b = (F.bx >> 3) & 7;
    const size_t rowb = (size_t)b * SEQ, t = rowb + pos;
    unsigned err = 0u;
    for (int i = lane; i < 256; i += 64) IQF[i] = bf2f(PROJ[t * WINBP + B_IQ + i]);
    float iwv[4];
#pragma unroll
    for (int h = 0; h < 4; ++h) iwv[h] = bf2f(PROJ[t * WINBP + B_IW + h]) * 0.0625f;
    LDS_WAIT();
    for (int k = lane; k <= pos; k += 64) {
        float a[4] = {0.f, 0.f, 0.f, 0.f};
        for (int d = 0; d < 64; ++d) { const float kv = bf2f(IKN[(rowb + k) * 64 + d]);
#pragma unroll
            for (int h = 0; h < 4; ++h) a[h] += kv * IQF[h * 64 + d]; }
        float sc = 0.f;
#pragma unroll
        for (int h = 0; h < 4; ++h) sc += fmaxf(a[h], 0.f) * iwv[h];
        SC[k] = sc + 0.0f;
    }
    for (int i = lane; i < 256; i += 64) { BM[i] = 0u; SEL[i] = IDX[t * 256 + i]; }
    LDS_WAIT();
    int nsel = 0;
    for (int i = lane; i < 256; i += 64) { const unsigned id = SEL[i]; if (id != 0xffffu) { ++nsel; __hip_atomic_fetch_or(BM + (id >> 5), 1u << (id & 31u), __ATOMIC_RELAXED, __HIP_MEMORY_SCOPE_WORKGROUP); if ((int)id > pos) err |= 1u; } }
    nsel = (int)wave_sum_fast((float)nsel);
    LDS_WAIT();
    const int want = (pos + 1 < 256) ? pos + 1 : 256;
    if (nsel != want) err |= 2u;
    if (pos + 1 > 256) {
        unsigned prefix = 0u;
        for (int bit = 31; bit >= 0; --bit) { const unsigned c = prefix | (1u << bit); int cnt = 0;
            for (int k = lane; k <= pos; k += 64) { unsigned ub = __float_as_uint(SC[k]); ub ^= (ub >> 31) ? 0xffffffffu : 0x80000000u; cnt += (ub >= c) ? 1 : 0; }
            cnt = (int)wave_sum_fast((float)cnt); if (cnt >= 256) prefix = c; }
        int mism = 0, nge = 0;
        for (int k = lane; k <= pos; k += 64) { unsigned ub = __float_as_uint(SC[k]); ub ^= (ub >> 31) ? 0xffffffffu : 0x80000000u; const bool inr = ub >= prefix; const bool ins = (BM[k >> 5] >> (k & 31)) & 1u; mism += (inr != ins) ? 1 : 0; nge += inr ? 1 : 0; }
        mism = (int)wave_sum_fast((float)mism); nge = (int)wave_sum_fast((float)nge);
        if (mism > 8 + 2 * (nge - 256)) err |= 4u;
    }
    for (int i = lane; i < 12 * 128; i += 64) { const int h = i >> 7, r = i & 127; float a = 0.f;
        for (int d = 0; d < 64; ++d) a += bf2f(PROJ[t * WINBP + h * 64 + d]) * bf2f(WUK[((size_t)h * 128 + r) * 64 + d]);
        QL[i] = bf2f(f2bf(a * 0.125f)); }
    LDS_WAIT();
    for (int j = lane; j < 256; j += 64) { const unsigned id = SEL[j];
        for (int h = 0; h < 12; ++h) { float a = -INFINITY;
            if (id != 0xffffu) { a = 0.f; for (int r = 0; r < 128; ++r) a += QL[h * 128 + r] * bf2f(CN[(rowb + id) * 128 + r]);
                const int rel = pos - (int)id; int bk = rel; if (rel >= 16) { bk = 16 + (int)(logf((float)rel * (1.0f / 16.0f)) / logf(8.0f) * 16.0f); bk = bk > 31 ? 31 : bk; }
                a += inp(F, I_RELB)[bk * 12 + h]; }
            PP[h * 256 + j] = a; } }
    LDS_WAIT();
    for (int h = 0; h < 12; ++h) { float m = -INFINITY; for (int j = lane; j < 256; j += 64) m = fmaxf(m, PP[h * 256 + j]);
#pragma unroll
        for (int o = 1; o < 64; o <<= 1) m = fmaxf(m, shx(m, o));
        float sm = 0.f; for (int j = lane; j < 256; j += 64) { const float v = PP[h * 256 + j]; const float p = (v == -INFINITY) ? 0.f : __expf(v - m); PP[h * 256 + j] = p; sm += p; }
        sm = wave_sum_fast(sm); const float inv = 1.0f / sm; for (int j = lane; j < 256; j += 64) PP[h * 256 + j] *= inv; }
    LDS_WAIT();
    for (int i = lane; i < 12 * 128; i += 64) { const int h = i >> 7, r = i & 127; float a = 0.f;
        for (int j = 0; j < 256; ++j) { const unsigned id = SEL[j]; if (id != 0xffffu) a += PP[h * 256 + j] * bf2f(CN[(rowb + id) * 128 + r]); }
        OL[i] = a; }
    LDS_WAIT();
    float e2 = 0.f, r2 = 0.f;
    for (int i = lane; i < 768; i += 64) { const int h = i >> 6, d = i & 63; float a = 0.f;
        for (int r = 0; r < 128; ++r) a += OL[h * 128 + r] * bf2f(WUVT[((size_t)h * 64 + d) * 128 + r]);
        const float got = bf2f(MIX[t * D + i]); e2 += (a - got) * (a - got); r2 += a * a; }
    e2 = wave_sum_fast(e2); r2 = wave_sum_fast(r2);
    if (!(e2 <= 0.0025f * r2)) err |= 8u;
    if (err && lane == 0) __hip_atomic_fetch_or(F.ctl + CW_ERR, err, __ATOMIC_RELAXED, __HIP_MEMORY_SCOPE_AGENT);
}
DI void ph_dsacheck(Ctx F) { launder(F); dsa_check_phase(F); }
DI void memattn_check_phase(Ctx& F, int layer, int ldp, int mqcol) {
    if (F.wave != 1) return;
    const int lane = F.lane;
    LAS float* PM = (LAS float*)(F.lds + 65536);
    const bf16_t* PROJ = (const bf16_t*)(F.ws + WS_PROJ); const bf16_t* KV = (const bf16_t*)(F.ws + WS_KV); const bf16_t* MIX = (const bf16_t*)(F.ws + WS_MIX);
    const int pos = (F.bx * 131 + 17) & 8191, b = (F.bx >> 2) & 7; const size_t t = (size_t)b * SEQ + pos;
    float e2 = 0.f, r2 = 0.f;
    for (int h = 0; h < 4; ++h) {
        float lg[4];
#pragma unroll
        for (int i = 0; i < 4; ++i) { const int m = lane + 64 * i; float a = 0.f;
            for (int d = 0; d < 64; ++d) a += bf2f(PROJ[t * ldp + mqcol + h * 64 + d]) * bf2f(KV[(size_t)(b * MEML + m) * 1024 + layer * 512 + h * 64 + d]);
            lg[i] = a * 0.125f; }
        float mx = fmaxf(fmaxf(lg[0], lg[1]), fmaxf(lg[2], lg[3]));
#pragma unroll
        for (int o = 1; o < 64; o <<= 1) mx = fmaxf(mx, shx(mx, o));
        float sm = 0.f;
#pragma unroll
        for (int i = 0; i < 4; ++i) { lg[i] = __expf(lg[i] - mx); sm += lg[i]; }
        sm = wave_sum_fast(sm);
#pragma unroll
        for (int i = 0; i < 4; ++i) PM[lane + 64 * i] = lg[i] / sm;
        LDS_WAIT();
        float a = 0.f;
        for (int m = 0; m < 256; ++m) a += PM[m] * bf2f(KV[(size_t)(b * MEML + m) * 1024 + layer * 512 + 256 + h * 64 + lane]);
        const float got = bf2f(MIX[t * D + TOKW + h * 64 + lane]); e2 += (a - got) * (a - got); r2 += a * a;
        LDS_WAIT();
    }
    e2 = wave_sum_fast(e2); r2 = wave_sum_fast(r2);
    if (!(e2 <= 0.0025f * r2) && lane == 0) __hip_atomic_fetch_or(F.ctl + CW_ERR, 16u << layer, __ATOMIC_RELAXED, __HIP_MEMORY_SCOPE_AGENT);
}
DI void ph_memcheck(Ctx F, int layer) { launder(F); if (layer == 0) memattn_check_phase(F, 0, WINA, 2 * TOKW); else memattn_check_phase(F, 1, WINBP, B_MQ); }


DI void ph_prologue(Ctx F) { launder(F); p0_prologue(F); }
DI void ph_lru0(Ctx F) { launder(F); lru_phase<0>(F); }
DI void ph_lru1(Ctx F) { launder(F); lru_phase<1>(F); launder(F); memattn_phase(F, 0, WINA, 2 * TOKW); }
DI void ph_prep(Ctx F) { launder(F); dsa_prep_phase(F); }
template <int IMODE> DI void ph_indexer(Ctx F) { launder(F); indexer_phase<IMODE>(F); }
DI void ph_idxcmp(Ctx F) { launder(F); idx_compare(F); }
DI void ph_attn(Ctx F) { launder(F); dsa_attn_phase(F); launder(F); if (!DIAG_SKIPMEM) memattn_phase(F, 1, WINBP, B_MQ); }
DI void ph_lnr(Ctx F, int layer) { launder(F); ln_router_phase(F, layer); }
DI void ph_combine(Ctx F, int layer) { launder(F); combine_ln_phase(F, layer, F.out); }

constexpr int NPHASE = 18;
struct Args { const float* in[29]; float* out; unsigned char* ws; int ph_lo, ph_hi; };

__global__ void __launch_bounds__(512, 2) mk_fwd(Args args) {
    extern __shared__ __attribute__((aligned(16))) unsigned char lds_raw[];
    Ctx F;
    F.lds = (LAS unsigned char*)lds_raw;
    F.tid = threadIdx.x; F.lane = F.tid & 63; F.wave = __builtin_amdgcn_readfirstlane(F.tid >> 6);
    F.G = gridDim.x; F.bx = blockIdx.x;
    F.ws = args.ws; F.ctl = (unsigned*)(args.ws + WS_CTL); F.out = args.out;
    volatile LAS unsigned* MISC = (volatile LAS unsigned*)(F.lds + MISC_OFF);
#if DIAG_INIT
    for (int u = F.tid; u < MISC_OFF / 4; u += 512) ((LAS unsigned*)F.lds)[u] = 0u;
#endif
    for (int u = F.tid; u < (PTAB_OFF - MISC_OFF) / 4; u += 512) ((LAS unsigned*)(F.lds + MISC_OFF))[u] = 0u;
    if (F.tid == 0) {
#pragma unroll
        for (int i = 0; i < 29; ++i) *(LAS unsigned long long*)(F.lds + PTAB_OFF + 8 * i) = (unsigned long long)args.in[i];
    }
    __syncthreads();
    const int lo = args.ph_lo, hi = args.ph_hi;
    XcdBarrier bar; bar.bar = F.ctl + CW_BAR; bar.x = 0; bar.st = nullptr;
    if (hi - lo > 1) bar = xcd_barrier_post(F.ctl + CW_BAR, MISC + 8);
#ifndef PHASE_MASK
#define PHASE_MASK 0xffff
#endif
#define IN(k) (lo <= (k) && (k) < hi)
#define ON(site) ((((unsigned)PHASE_MASK) >> (site)) & 1u)
#define SEAM(k) do { if (ON(15) && IN(k) && IN((k) + 1)) { XcdBarrier b2_ = bar; { const unsigned long long p_ = (unsigned long long)b2_.bar; int pl_ = __builtin_amdgcn_readfirstlane((int)(unsigned)p_), ph_ = __builtin_amdgcn_readfirstlane((int)(unsigned)(p_ >> 32)); \
        asm volatile("" : "+s"(pl_), "+s"(ph_)); b2_.bar = (unsigned*)(GAS unsigned*)(((unsigned long long)(unsigned)ph_ << 32) | (unsigned)pl_); } \
        xcd_barrier(b2_); if (DBL(15)) { xcd_barrier(b2_); xcd_barrier(b2_); xcd_barrier(b2_); xcd_barrier(b2_); } } } while (0)
#define RUN(site, k, body) do { if (ON(site) && IN(k)) { body; } if (DBL(site) && IN(k)) { body; } } while (0)
    RUN(0, 0, ph_prologue(F));
    SEAM(0);
    for (int layer = 0; layer < 2; ++layer) {
        const int pb = layer ? 9 : 1;
        if (layer == 0) { RUN(1, pb, site_proj0(F)); RUN(1, pb, site_kv(F)); } else { RUN(1, pb, site_proj1(F)); }
        SEAM(pb);
        int po;
        if (layer == 0) {
            RUN(2, 2, ph_lru0(F));
            SEAM(2);
            RUN(3, 3, ph_lru1(F));
#if PROBE_DSA
            SEAM(3);
            if (ON(3) && IN(3)) { ph_memcheck(F, 0); }
#endif
            SEAM(3);
            po = 4;
        } else {
            RUN(10, 10, ph_prep(F));
            SEAM(10);
#if PROBE_CHECK
            if (ON(11) && IN(11)) { ph_indexer<0>(F); }
            SEAM(11);
#endif
            RUN(11, 11, ph_indexer<1>(F));
#if PROBE_CHECK
            SEAM(11);
            if (ON(11) && IN(11)) { ph_idxcmp(F); }
#endif
            SEAM(11);
            RUN(12, 12, ph_attn(F));
#if PROBE_DSA
            SEAM(12);
            if (ON(12) && IN(12)) { ph_dsacheck(F); ph_memcheck(F, 1); }
#endif
            SEAM(12);
            po = 13;
        }
        if (layer == 0) { RUN(4, po, site_out0(F)); } else { RUN(4, po, site_out1(F)); }
        SEAM(po);
        if (ON(5) && IN(po + 1)) { ph_lnr(F, layer); }
        SEAM(po + 1);
        RUN(6, po + 2, site_g1(F, layer));
        SEAM(po + 2);
        RUN(7, po + 3, site_g2(F, layer));
        SEAM(po + 3);
        RUN(8, po + 4, ph_combine(F, layer));
        if (layer == 0) SEAM(po + 4);
    }
#undef RUN
#undef IN
#undef SEAM
#if DIAG_DUMP
    if (lo == 100) {
        const size_t gt = (size_t)F.bx * 512 + F.tid, NT = (size_t)F.G * 512;
        for (size_t i = gt; i < (size_t)T * D; i += NT) {
            float v;
            if (DIAG_DUMP == 1) v = bf2f(((const bf16_t*)(args.ws + WS_MIX))[i]);
            else if (DIAG_DUMP == 2) v = bf2f(((const bf16_t*)(args.ws + WS_Z))[i]);
            else if (DIAG_DUMP == 3) v = ((const float*)(args.ws + WS_XA))[i];
            else if (DIAG_DUMP == 4) v = bf2f(((const bf16_t*)(args.ws + WS_PROJ))[i]);
            else if (DIAG_DUMP == 8) v = ((i & 1023) < 768) ? bf2f(((const bf16_t*)(args.ws + WS_MIX))[i]) : 0.f;
            else if (DIAG_DUMP == 9) v = ((i & 1023) >= 768) ? bf2f(((const bf16_t*)(args.ws + WS_MIX))[i]) : 0.f;
            else if (DIAG_DUMP == 10) v = bf2f(((const bf16_t*)(args.ws + WS_OLAT))[i + 33554432]);
            else if (DIAG_DUMP == 11) v = bf2f(((const bf16_t*)(args.ws + WS_QLAT))[i + 33554432]);
            else if (DIAG_DUMP == 12) v = bf2f(((const bf16_t*)(args.ws + WS_WUVT))[i % 98304]);
            else if (DIAG_DUMP == 6) v = bf2f(((const bf16_t*)(args.ws + WS_QLAT))[i]);
            else if (DIAG_DUMP == 7) v = bf2f(((const bf16_t*)(args.ws + WS_OLAT))[i]);
            else v = (float)((const unsigned short*)(args.ws + WS_IDX))[i % ((size_t)T * 256)];
            if (!(v - v == 0.f)) v = 12345.0f;
            F.out[i] = v; }
    }
#endif
}

extern "C" void kernel_launch(void* const* d_in, const int* in_sizes, int n_in, void* d_out, int out_size, void* d_ws, size_t ws_size, hipStream_t stream) {
    static int grid = 0;
    if (grid == 0) {
        if (n_in != 29 || out_size != T * D || ws_size < WS_END) { fprintf(stderr, "kernel_launch: unexpected shapes (n_in %d, out %d, ws %zu)\n", n_in, out_size, ws_size); grid = -1; return; }
        int dev = 0, cus = 0, per_cu = 0;
        if (hipGetDevice(&dev) != hipSuccess || hipDeviceGetAttribute(&cus, hipDeviceAttributeMultiprocessorCount, dev) != hipSuccess) { grid = -1; return; }
        if (hipFuncSetAttribute((const void*)mk_fwd, hipFuncAttributeMaxDynamicSharedMemorySize, LDS_BYTES) != hipSuccess) { fprintf(stderr, "kernel_launch: hipFuncSetAttribute failed\n"); grid = -1; return; }
        if (hipOccupancyMaxActiveBlocksPerMultiprocessor(&per_cu, (const void*)mk_fwd, 512, LDS_BYTES) != hipSuccess || per_cu < 1) { fprintf(stderr, "kernel_launch: occupancy query says %d\n", per_cu); (void)hipGetLastError(); grid = -1; return; }
        grid = cus;
    }
    if (grid < 0) return;
    if (hipMemsetAsync((char*)d_ws + WS_CTL, 0, CTL_BYTES, stream) != hipSuccess) return;
#if DIAG_INIT
    (void)hipMemsetAsync((char*)d_ws + CTL_BYTES, 0, WS_END - CTL_BYTES, stream);
    (void)hipMemsetAsync(d_out, 0, (size_t)T * D * 4, stream);
#endif
    Args a{};
    for (int i = 0; i < 29; ++i) a.in[i] = (const float*)d_in[i];
    a.out = (float*)d_out; a.ws = (unsigned char*)d_ws;
#if MK_SPLIT
    for (int p = 0; p <= DIAG_LAST && p < NPHASE; ++p) { a.ph_lo = p; a.ph_hi = p + 1; hipLaunchKernelGGL(mk_fwd, dim3(grid), dim3(512), LDS_BYTES, stream, a); }
#if DIAG_DUMP
    a.ph_lo = 100; a.ph_hi = 101; hipLaunchKernelGGL(mk_fwd, dim3(grid), dim3(512), LDS_BYTES, stream, a);
#endif
#elif defined(REPEAT_PHASE)
    a.ph_lo = 0; a.ph_hi = REPEAT_PHASE + 1; hipLaunchKernelGGL(mk_fwd, dim3(grid), dim3(512), LDS_BYTES, stream, a);
    (void)hipMemsetAsync((char*)d_ws + WS_CTL + CW_IQ * 4, 0, 4096, stream);
    a.ph_lo = REPEAT_PHASE; a.ph_hi = REPEAT_PHASE + 1; hipLaunchKernelGGL(mk_fwd, dim3(grid), dim3(512), LDS_BYTES, stream, a);
    if (REPEAT_PHASE + 1 < NPHASE) {
        (void)hipMemsetAsync((char*)d_ws + WS_CTL + CW_BAR * 4, 0, XCD_BAR_WORDS * 4, stream);
        a.ph_lo = REPEAT_PHASE + 1; a.ph_hi = NPHASE; hipLaunchKernelGGL(mk_fwd, dim3(grid), dim3(512), LDS_BYTES, stream, a);
    }
#else
    a.ph_lo = 0; a.ph_hi = NPHASE; hipLaunchKernelGGL(mk_fwd, dim3(grid), dim3(512), LDS_BYTES, stream, a);
#endif
}
```

```cpp
#include <hip/hip_runtime.h>
#include <cstdio>
#include <cstdint>

#ifndef DIAG_INIT
#define DIAG_INIT 0
#endif
#ifndef DIAG_LAST
#define DIAG_LAST 17
#endif
#ifndef DIAG_DUMP
#define DIAG_DUMP 0
#define DIAG_SKIPMEM 0
#define DIAG_WUVQ 0
#endif
#ifndef PROBE_CHECK
#define PROBE_CHECK 0
#endif
#ifndef PROBE_SEL
#define PROBE_SEL 0
#endif
#ifndef PROBE_PASS3
#define PROBE_PASS3 0
#endif
#ifndef PROBE_NOFB
#define PROBE_NOFB 0
#endif
#ifndef PROBE_NORETRY
#define PROBE_NORETRY 0
#endif
#ifndef PROBE_DSA
#define PROBE_DSA 0
#endif
#ifndef PROBE_SEL2
#define PROBE_SEL2 0
#endif
#ifndef MK_SPLIT
#define MK_SPLIT 0
#endif

#ifndef DBL_MASK
#define DBL_MASK 0
#endif
#define DBL(site) ((((unsigned)DBL_MASK) >> (site)) & 1u)

#define LAS __attribute__((address_space(3)))
#define GAS __attribute__((address_space(1)))
typedef unsigned short bf16_t;
typedef short bf16x8 __attribute__((ext_vector_type(8)));
typedef short s16x4 __attribute__((ext_vector_type(4)));
typedef float f32x4 __attribute__((ext_vector_type(4)));
typedef float f32x2 __attribute__((ext_vector_type(2)));
typedef unsigned u32x4 __attribute__((ext_vector_type(4)));
typedef unsigned u32x2 __attribute__((ext_vector_type(2)));
#define DI __device__ __forceinline__
#define MFMA16(a, b, c) __builtin_amdgcn_mfma_f32_16x16x32_bf16((a), (b), (c), 0, 0, 0)

constexpr int D = 1024, NB = 8, SEQ = 8192, T = NB * SEQ;
constexpr int TOKW = 768, MEMW = 256, MEML = 256;
constexpr int WINA = 1792, WINB = 1476, WINBP = 1536;
constexpr int NEXP = 32, DEXP = 1024;
constexpr float LN_EPS = 1e-5f;
constexpr float DN_ALPHA = 1.41421356237309515f;
constexpr int PMAX = 270336;
constexpr int B_C = 768, B_IQ = 896, B_IK = 1152, B_MQ = 1216, B_IW = 1472;

constexpr size_t MiB = 1u << 20;
constexpr size_t WS_CTL = 0, CTL_BYTES = 1 * MiB;
constexpr size_t WS_WINA = 1 * MiB;
constexpr size_t WS_WINB = 5 * MiB;
constexpr size_t WS_WKV = 8 * MiB;
constexpr size_t WS_WOUT = 10 * MiB;
constexpr size_t WS_WRT = 14 * MiB;
constexpr size_t WS_WUK = 14 * MiB + 256 * 1024;
constexpr size_t WS_WUVT = 14 * MiB + 512 * 1024;
constexpr size_t WS_ROUT = 15 * MiB;
constexpr size_t WS_MEMBF = 16 * MiB;
constexpr size_t WS_KV = 20 * MiB;
constexpr size_t WS_LSUM = 24 * MiB;
constexpr size_t WS_LIST = 32 * MiB;
constexpr size_t WS_TOKSLOT = 40 * MiB;
constexpr size_t WS_TOKGATE = 41 * MiB;
constexpr size_t WS_CN = 48 * MiB;
constexpr size_t WS_IKN = 64 * MiB;
constexpr size_t WS_IDX = 72 * MiB;
constexpr size_t WS_W1 = 112 * MiB;
constexpr size_t WS_W2 = 368 * MiB;
constexpr size_t WS_XB8 = 240 * MiB;
constexpr size_t WS_XA = 496 * MiB;
constexpr size_t WS_XBF = 752 * MiB;
constexpr size_t WS_ACT = 880 * MiB;
constexpr size_t WS_QLAT = WS_ACT, WS_OLAT = WS_ACT + 192 * MiB;
constexpr size_t WS_PROJ = 1408 * MiB;
constexpr size_t WS_MIX = 1632 * MiB;
constexpr size_t WS_Z = 1760 * MiB;
constexpr size_t WS_Y = 1408 * MiB;
constexpr size_t WS_END = 2016 * MiB;
constexpr int CW_BAR = 4096;
constexpr int CW_ERR = 8192;
constexpr int CW_CNT = 16384;
constexpr int CW_IQ = 20480;

constexpr int STAGE_BYTES = 131072;
constexpr int TOKTAB_OFF = STAGE_BYTES;
constexpr int LDS_BYTES = 163840;
constexpr int GMTAB_OFF = STAGE_BYTES + 2048;
constexpr int MISC_OFF = LDS_BYTES - 2048;
constexpr int MTAB_OFF = MISC_OFF + 512;
constexpr int PTAB_OFF = MISC_OFF + 1024;

typedef __bf16 bf16x2_t __attribute__((ext_vector_type(2)));
DI unsigned cvt_pk_bf16(float lo, float hi) { const f32x2 v = {lo, hi}; const bf16x2_t r = __builtin_convertvector(v, bf16x2_t); return __builtin_bit_cast(unsigned, r); }
DI unsigned pk4_fp8(float a, float b, float c, float d) { unsigned w = 0u; w = (unsigned)__builtin_amdgcn_cvt_pk_fp8_f32(a, b, (int)w, false); w = (unsigned)__builtin_amdgcn_cvt_pk_fp8_f32(c, d, (int)w, true); return w; }
DI float bf2f(unsigned short b) { return __uint_as_float(((unsigned)b) << 16); }
DI float bflo(unsigned w) { return __uint_as_float(w << 16); }
DI float bfhi(unsigned w) { return __uint_as_float(w & 0xffff0000u); }
DI unsigned short f2bf(float f) { return (unsigned short)(cvt_pk_bf16(f, 0.f) & 0xffffu); }
DI float sigmoidf_(float x) { return __builtin_amdgcn_rcpf(1.0f + __expf(-x)); }
DI int shfl_lane() { unsigned m = 0xffffffffu; asm volatile("" : "+v"(m)); return (int)__builtin_amdgcn_mbcnt_hi(m, __builtin_amdgcn_mbcnt_lo(m, 0u)); }
DI float shx(float v, int o) { return __int_as_float(__builtin_amdgcn_ds_bpermute((shfl_lane() ^ o) << 2, __float_as_int(v))); }
DI int shup_i(int v, int o) { return __builtin_amdgcn_ds_bpermute((shfl_lane() - o) << 2, v); }
DI float rows4_max(float x) { unsigned u = __float_as_uint(x);
    auto a = __builtin_amdgcn_permlane16_swap(u, u, false, false); float m = fmaxf(__uint_as_float(a[0]), __uint_as_float(a[1])); u = __float_as_uint(m);
    auto b = __builtin_amdgcn_permlane32_swap(u, u, false, false); return fmaxf(__uint_as_float(b[0]), __uint_as_float(b[1])); }
DI float rows4_sum(float x) { unsigned u = __float_as_uint(x);
    auto a = __builtin_amdgcn_permlane16_swap(u, u, false, false); float m = __uint_as_float(a[0]) + __uint_as_float(a[1]); u = __float_as_uint(m);
    auto b = __builtin_amdgcn_permlane32_swap(u, u, false, false); return __uint_as_float(b[0]) + __uint_as_float(b[1]); }
DI float wave_sum(float v) {
#pragma unroll
    for (int o = 1; o < 64; o <<= 1) v += shx(v, o);
    return v;
}
DI u32x4 zero4_local() { unsigned z = 0u; asm volatile("" : "+v"(z)); return (u32x4){z, z, z, z}; }
DI float wave_sum_fast(float v) {
    int x = __float_as_int(v);
#define WSF_STEP(ctrl) x = __float_as_int(__int_as_float(x) + __int_as_float(__builtin_amdgcn_update_dpp(0, x, ctrl, 0xf, 0xf, true)));
    WSF_STEP(0x101) WSF_STEP(0x102) WSF_STEP(0x104) WSF_STEP(0x108)
#undef WSF_STEP
    return (__int_as_float(__builtin_amdgcn_readlane(x, 0)) + __int_as_float(__builtin_amdgcn_readlane(x, 16))) + (__int_as_float(__builtin_amdgcn_readlane(x, 32)) + __int_as_float(__builtin_amdgcn_readlane(x, 48)));
}
#define LDS_WAIT() asm volatile("s_waitcnt lgkmcnt(0)" ::: "memory")
#define VM_WAIT() asm volatile("s_waitcnt vmcnt(0)" ::: "memory")

#define XB_TMO      128
#define XB_XCNT(j)  (256  + 64 * (j))
#define XB_XSUB(j)  (1280 + 64 * (j))
#define XB_XGEN(j)  (2304 + 64 * (j))
#define XB_TOP      3328
#define XB_TOPGEN   3392
#define XCD_BAR_WORDS 3456
#define XB_SPIN_CAP (1u << 22)

DI unsigned xb_ld(unsigned* p)              { return __hip_atomic_load(p, __ATOMIC_RELAXED, __HIP_MEMORY_SCOPE_AGENT); }
DI unsigned xb_add(unsigned* p, unsigned v) { return __hip_atomic_fetch_add(p, v, __ATOMIC_RELAXED, __HIP_MEMORY_SCOPE_AGENT); }
DI unsigned xb_xcc_id() { return (unsigned)__builtin_amdgcn_s_getreg((3 << 11) | 20) & 0xFu; }
#define XB_SPIN(cond, bar) do { unsigned _sp = 0; while (cond) { __builtin_amdgcn_s_sleep(1); \
    if ((++_sp & 255u) == 0u) { if (xb_ld(&(bar)[XB_TMO])) break; if (_sp > XB_SPIN_CAP) { atomicAdd(&(bar)[XB_TMO], 1u); break; } } } } while (0)

struct XcdBarrier { unsigned* bar; unsigned x; volatile LAS unsigned* st; };

DI XcdBarrier xcd_barrier_post(unsigned* bar, volatile LAS unsigned* st) {
    XcdBarrier b; b.bar = bar; b.x = xb_xcc_id(); b.st = st;
    if (threadIdx.x == 0) (void)xb_add(&bar[XB_XCNT(b.x)], 1u);
    return b;
}
DI void xcd_barrier_complete(unsigned* bar, unsigned x, unsigned& nloc, unsigned& nx) {
    const unsigned G = gridDim.x * gridDim.y * gridDim.z;
    unsigned sum, cnt, mine, sp = 0u;
    for (;;) {
        sum = 0u; cnt = 0u; mine = 0u;
#pragma unroll
        for (unsigned j = 0; j < 16; ++j) { const unsigned c = xb_ld(&bar[XB_XCNT(j)]); sum += c; cnt += (c > 0u) ? 1u : 0u; mine = (j == x) ? c : mine; }
        if (sum == G) break;
        __builtin_amdgcn_s_sleep(1);
        if ((++sp & 255u) == 0u) { if (xb_ld(&bar[XB_TMO])) break; if (sp > XB_SPIN_CAP) { atomicAdd(&bar[XB_TMO], 1u); break; } }
    }
    nloc = mine > 0u ? mine : 1u; nx = cnt > 0u ? cnt : 1u;
}
DI void xcd_barrier(const XcdBarrier& b) {
    asm volatile("s_waitcnt vmcnt(0)" ::: "memory");
    __syncthreads();
    if (threadIdx.x == 0) {
        unsigned* bar = b.bar;
        __builtin_amdgcn_s_waitcnt(0);
        unsigned nloc = b.st[0], nx = b.st[1];
        if (nloc == 0u) { xcd_barrier_complete(bar, b.x, nloc, nx); b.st[0] = nloc; b.st[1] = nx; }
        const unsigned old = xb_add(&bar[XB_XSUB(b.x)], 1u);
        const unsigned gen = old / nloc;
        if (old + 1u == (gen + 1u) * nloc) {
            __builtin_amdgcn_fence(__ATOMIC_RELEASE, "agent");
            asm volatile("s_waitcnt vmcnt(0)" ::: "memory");
            const unsigned og = xb_add(&bar[XB_TOP], 1u);
            const unsigned tg = og / nx;
            if (og + 1u == (tg + 1u) * nx) xb_add(&bar[XB_TOPGEN], 1u);
            else XB_SPIN(xb_ld(&bar[XB_TOPGEN]) == tg, bar);
            __builtin_amdgcn_fence(__ATOMIC_ACQUIRE, "agent");
            xb_add(&bar[XB_XGEN(b.x)], 1u);
            asm volatile("s_waitcnt vmcnt(0)" ::: "memory");
        } else {
            XB_SPIN(xb_ld(&bar[XB_XGEN(b.x)]) == gen, bar);
            __builtin_amdgcn_fence(__ATOMIC_ACQUIRE, "agent");
            asm volatile("s_waitcnt vmcnt(0)" ::: "memory");
        }
    }
    __syncthreads();
}

namespace pg8 {
constexpr int BM = 256, BK = 64, HALF = 128, HTB = HALF * BK * 2;
DI int lds_byte(int r, int c) { const int st = (r >> 4) * 2 + (c >> 5), rr = r & 15, cc = c & 31, ob = rr * 64 + cc * 2; return st * 1024 + (ob ^ (((ob >> 9) & 1) << 5)); }
DI void stage_rc(int b, int& R, int& C) { const int st = b / 1024, sb = b % 1024, swz = sb ^ (((sb >> 9) & 1) << 5); R = (st >> 1) * 16 + swz / 64; C = (st & 1) * 32 + (swz % 64) / 2; }
DI int perm32(int rho) { const int n = rho >> 4, i = rho & 15; return 8 * (i >> 2) + 4 * n + (i & 3); }

struct Unit { int arow, brow, orow, ocol, e; };
struct Gemm { const void* A; const void* Bt; int K; const unsigned* list; const void* A2; const void* Bt2; int sa, sb; };

template <int nM, int nN, int nx2> struct DenseOrderT {
    static constexpr bool DUAL = true;
    static constexpr int nwg = nM * nN;
    int G, c;
    DI void init(int G_, int c_) { G = G_; c = c_; }
    DI bool next(int i, Unit& u) const {
        const int L = i * G + c; if (L >= nwg + nx2) return false;
        if (L >= nwg) { const int q = L - nwg; u.arow = (q >> 2) * BM; u.brow = (q & 3) * BM; u.orow = u.arow; u.ocol = u.brow; u.e = 1; return true; }
        int wgid = L; { constexpr int q = nwg / 8, r = nwg % 8; const int xcd = wgid % 8, off = wgid / 8; wgid = (xcd < r ? xcd * (q + 1) : r * (q + 1) + (xcd - r) * q) + off; }
        constexpr int nig = 8 * nN; const int gid = wgid / nig, fm = gid * 8, gsz = (nM - fm) < 8 ? (nM - fm) : 8;
        const int rem = wgid % nig; const int pm = fm + (gsz == 8 ? (rem & 7) : (rem % gsz)), pn = gsz == 8 ? (rem >> 3) : (rem / gsz);
        u.arow = pm * BM; u.brow = pn * BM; u.orow = pm * BM; u.ocol = pn * BM; u.e = 0; return true;
    }
};
template <int NN, bool GATHER> struct MoeOrder {
    static constexpr bool DUAL = false;
    const LAS int* mtab; const LAS unsigned* gmtab; int G, c, nrowsB;
    DI bool next(int i, Unit& u) const {
        constexpr int MG = 32 / NN;
        const int x = c & 7, j = c >> 3;
        const int per = G >> 3;
        const int TM = __builtin_amdgcn_readfirstlane(mtab[32]);
        const int slot = i * per + j;
        const int grp = (slot / 32) * 8 + x, within = slot % 32;
        const int gm = grp * MG + within / NN, pn = within % NN;
        if (gm >= TM) return false;
        const unsigned pk = (unsigned)__builtin_amdgcn_readfirstlane((int)gmtab[gm]);
        const int e = (int)(pk >> 16), mt = (int)(pk & 0xffffu);
        u.e = e; u.arow = GATHER ? (e * 65536 + mt * 256) : gm * 256; u.brow = e * nrowsB + pn * 256; u.orow = gm * 256; u.ocol = pn * 256; return true;
    }
};

template <bool DUALOUT> struct EpiBf16 {
    static constexpr bool PERM = true;
    bf16_t* O; int ldc; bf16_t* O2; int ldc2;
    DI void operator()(const f32x4 (&acc)[2][2][4][2], const Unit& u, int wr, int wc, int fr, int fq) const {
        const int row0 = u.orow + wr * 64 + fr, col0 = u.ocol + wc * 32 + 8 * fq;
        bf16_t* Ob = O; int ld = ldc; if (DUALOUT && u.e != 0) { Ob = O2; ld = ldc2; }
#pragma unroll
        for (int ai = 0; ai < 2; ++ai)
#pragma unroll
            for (int m = 0; m < 4; ++m) { bf16_t* rowp = Ob + (size_t)(row0 + ai * HALF + m * 16) * ld + col0;
#pragma unroll
                for (int bj = 0; bj < 2; ++bj) { const f32x4 v0 = acc[ai][bj][m][0], v1 = acc[ai][bj][m][1];
                    u32x4 w; w.x = cvt_pk_bf16(v0[0], v0[1]); w.y = cvt_pk_bf16(v0[2], v0[3]); w.z = cvt_pk_bf16(v1[0], v1[1]); w.w = cvt_pk_bf16(v1[2], v1[3]);
                    *(u32x4*)(rowp + bj * HALF) = w; } }
    }
};
struct EpiBf16Bias {
    static constexpr bool PERM = true;
    bf16_t* O; int ldc; const float* bias;
    DI void operator()(const f32x4 (&acc)[2][2][4][2], const Unit& u, int wr, int wc, int fr, int fq) const {
        const int row0 = u.orow + wr * 64 + fr, col0 = u.ocol + wc * 32 + 8 * fq;
        f32x4 bv[2][2];
#pragma unroll
        for (int bj = 0; bj < 2; ++bj) { bv[bj][0] = *(const f32x4*)(bias + u.e * 1024 + col0 + bj * HALF); bv[bj][1] = *(const f32x4*)(bias + u.e * 1024 + col0 + bj * HALF + 4); }
#pragma unroll
        for (int ai = 0; ai < 2; ++ai)
#pragma unroll
            for (int m = 0; m < 4; ++m) { bf16_t* rowp = O + (size_t)(row0 + ai * HALF + m * 16) * ldc + col0;
#pragma unroll
                for (int bj = 0; bj < 2; ++bj) { const f32x4 v0 = acc[ai][bj][m][0] + bv[bj][0], v1 = acc[ai][bj][m][1] + bv[bj][1];
                    u32x4 w; w.x = cvt_pk_bf16(v0[0], v0[1]); w.y = cvt_pk_bf16(v0[2], v0[3]); w.z = cvt_pk_bf16(v1[0], v1[1]); w.w = cvt_pk_bf16(v1[2], v1[3]);
                    *(u32x4*)(rowp + bj * HALF) = w; } }
    }
};
struct EpiFp8Bias {
    static constexpr bool PERM = true;
    unsigned char* O; int ldc; const float* bias;
    DI void operator()(const f32x4 (&acc)[2][2][4][2], const Unit& u, int wr, int wc, int fr, int fq) const {
        const int row0 = u.orow + wr * 64 + fr, col0 = u.ocol + wc * 32 + 8 * fq;
        f32x4 bv[2][2];
#pragma unroll
        for (int bj = 0; bj < 2; ++bj) { bv[bj][0] = *(const f32x4*)(bias + u.e * 1024 + col0 + bj * HALF); bv[bj][1] = *(const f32x4*)(bias + u.e * 1024 + col0 + bj * HALF + 4); }
#pragma unroll
        for (int ai = 0; ai < 2; ++ai)
#pragma unroll
            for (int m = 0; m < 4; ++m) { unsigned char* rowp = O + (size_t)(row0 + ai * HALF + m * 16) * ldc + col0;
#pragma unroll
                for (int bj = 0; bj < 2; ++bj) { const f32x4 v0 = (acc[ai][bj][m][0] + bv[bj][0]) * 16.0f, v1 = (acc[ai][bj][m][1] + bv[bj][1]) * 16.0f;
                    u32x2 w; w.x = pk4_fp8(v0[0], v0[1], v0[2], v0[3]); w.y = pk4_fp8(v1[0], v1[1], v1[2], v1[3]);
                    *(u32x2*)(rowp + bj * HALF) = w; } }
    }
};
struct EpiResF32 {
    static constexpr bool PERM = false;
    float* Z; const float* res; float alpha; const bf16_t* resb;
    DI void operator()(const f32x4 (&acc)[2][2][4][2], const Unit& u, int wr, int wc, int fr, int fq) const {
        const int row0 = u.orow + wr * 64 + fr, col0 = u.ocol + wc * 32 + 4 * fq;
#pragma unroll
        for (int ai = 0; ai < 2; ++ai)
#pragma unroll
            for (int m = 0; m < 4; ++m) { const size_t off = (size_t)(row0 + ai * HALF + m * 16) * D + col0;
#pragma unroll
                for (int bj = 0; bj < 2; ++bj)
#pragma unroll
                    for (int n = 0; n < 2; ++n) { f32x4 r;
                        if (resb) { const u32x2 rw = *(const u32x2*)(resb + off + bj * HALF + n * 16); r = (f32x4){bflo(rw.x), bfhi(rw.x), bflo(rw.y), bfhi(rw.y)}; }
                        else r = *(const f32x4*)(res + off + bj * HALF + n * 16);
                        *(f32x4*)(Z + off + bj * HALF + n * 16) = r * alpha + acc[ai][bj][m][n]; }
                asm volatile("" ::: "memory"); }
    }
};
struct EpiResBf16 {
    static constexpr bool PERM = true;
    bf16_t* Z; const float* res; float alpha; const bf16_t* resb;
    DI void operator()(const f32x4 (&acc)[2][2][4][2], const Unit& u, int wr, int wc, int fr, int fq) const {
        const int row0 = u.orow + wr * 64 + fr, col0 = u.ocol + wc * 32 + 8 * fq;
#pragma unroll
        for (int ai = 0; ai < 2; ++ai)
#pragma unroll
            for (int m = 0; m < 4; ++m) { const size_t off = (size_t)(row0 + ai * HALF + m * 16) * D + col0;
#pragma unroll
                for (int bj = 0; bj < 2; ++bj) { f32x4 r0, r1;
                    if (resb) { const u32x4 rw = *(const u32x4*)(resb + off + bj * HALF); r0 = (f32x4){bflo(rw.x), bfhi(rw.x), bflo(rw.y), bfhi(rw.y)}; r1 = (f32x4){bflo(rw.z), bfhi(rw.z), bflo(rw.w), bfhi(rw.w)}; }
                    else { r0 = *(const f32x4*)(res + off + bj * HALF); r1 = *(const f32x4*)(res + off + bj * HALF + 4); }
                    const f32x4 v0 = r0 * alpha + acc[ai][bj][m][0], v1 = r1 * alpha + acc[ai][bj][m][1];
                    u32x4 w; w.x = cvt_pk_bf16(v0[0], v0[1]); w.y = cvt_pk_bf16(v0[2], v0[3]); w.z = cvt_pk_bf16(v1[0], v1[1]); w.w = cvt_pk_bf16(v1[2], v1[3]);
                    *(u32x4*)(Z + off + bj * HALF) = w; }
                asm volatile("" ::: "memory"); }
    }
};
struct EpiSwiglu {
    static constexpr bool PERM = true;
    unsigned char* O; const float* b1;
    DI void operator()(const f32x4 (&acc)[2][2][4][2], const Unit& u, int wr, int wc, int fr, int fq) const {
        const int row0 = u.orow + wr * 64 + fr, g0 = (u.ocol >> 1) + wc * 32 + 8 * fq;
        f32x4 bg[2], bu[2];
#pragma unroll
        for (int n = 0; n < 2; ++n) { bg[n] = *(const f32x4*)(b1 + (size_t)u.e * 2048 + g0 + 4 * n); bu[n] = *(const f32x4*)(b1 + (size_t)u.e * 2048 + 1024 + g0 + 4 * n); }
#pragma unroll
        for (int ai = 0; ai < 2; ++ai)
#pragma unroll
            for (int m = 0; m < 4; ++m) { unsigned char* rowp = O + (size_t)(row0 + ai * HALF + m * 16) * DEXP + g0;
                float o[8];
#pragma unroll
                for (int n = 0; n < 2; ++n)
#pragma unroll
                    for (int q = 0; q < 4; q += 2) {
                        f32x2 gt = (f32x2){acc[ai][0][m][n][q], acc[ai][0][m][n][q + 1]} + (f32x2){bg[n][q], bg[n][q + 1]};
                        f32x2 up = (f32x2){acc[ai][1][m][n][q], acc[ai][1][m][n][q + 1]} + (f32x2){bu[n][q], bu[n][q + 1]};
                        gt.x = fminf(gt.x, 7.0f); gt.y = fminf(gt.y, 7.0f);
                        up.x = __builtin_amdgcn_fmed3f(up.x, -7.0f, 7.0f); up.y = __builtin_amdgcn_fmed3f(up.y, -7.0f, 7.0f);
                        const f32x2 x = gt * (-2.45546696f);
                        f32x2 e; e.x = __builtin_amdgcn_exp2f(x.x); e.y = __builtin_amdgcn_exp2f(x.y);
                        const f32x2 d = e + 1.0f;
                        f32x2 sg; sg.x = __builtin_amdgcn_rcpf(d.x); sg.y = __builtin_amdgcn_rcpf(d.y);
                        const f32x2 u4 = up * 4.0f + 4.0f;
                        const f32x2 r = u4 * (gt * sg);
                        o[n * 4 + q] = r.x; o[n * 4 + q + 1] = r.y;
                    }
                u32x2 w; w.x = pk4_fp8(o[0], o[1], o[2], o[3]); w.y = pk4_fp8(o[4], o[5], o[6], o[7]);
                *(u32x2*)rowp = w; }
    }
};

typedef int v8i_t __attribute__((ext_vector_type(8)));
template <class Epi, class Sched, int AM, bool FP8 = false>
DI void gemm_phase(LAS unsigned char* lds, const Gemm g, const Sched& S, const Epi& E, const int tid) {
    constexpr bool GATHER = (AM != 0);
    const int wid = __builtin_amdgcn_readfirstlane(tid >> 6), lane = tid & 63, wr = wid >> 2, wc = wid & 3, fr = lane & 15, fq = lane >> 4;
    const int K = g.K, nt = K / (BK * 2);
    unsigned voffA[2], voffB[2];
#pragma unroll
    for (int i = 0; i < 2; ++i) { int R, C; stage_rc(tid * 16 + i * 8192, R, C); const int Rb = Epi::PERM ? ((R & ~31) + perm32(R & 31)) : R;
        voffA[i] = (unsigned)(R * K + C * 2); voffB[i] = (unsigned)(Rb * K + C * 2); }
    const size_t kstep = (size_t)(BK * 2);
    const size_t hstep = (size_t)HALF * K;
    const unsigned ldsw = (unsigned)wid * 1024u;
    const int aoff = lds_byte(wr * 64 + fr, fq * 8), boff = lds_byte(wc * 32 + fr, fq * 8);
    LAS unsigned* toktab = (LAS unsigned*)(lds + TOKTAB_OFF);
#define PG8_SA(b, h) (((b) * 2 + (h)) * HTB)
#define PG8_SB(b, h) ((4 + (b) * 2 + (h)) * HTB)
#define PG8_STAGE(bufoff, gbase, voff) do { _Pragma("unroll") for (int _i = 0; _i < 2; ++_i) \
        __builtin_amdgcn_global_load_lds((const unsigned*)((const char*)(gbase) + (voff)[_i]), (LAS unsigned*)(lds + (bufoff) + ldsw + _i * 8192), 16, 0, 0); } while (0)
#define PG8_STAGE_A(bufoff, base, h) do { if constexpr (GATHER) { _Pragma("unroll") for (int _i = 0; _i < 2; ++_i) \
        __builtin_amdgcn_global_load_lds((const unsigned*)((const char*)(base) + vA[h][_i]), (LAS unsigned*)(lds + (bufoff) + ldsw + _i * 8192), 16, 0, 0); } \
        else { PG8_STAGE(bufoff, (const char*)(base) + (h) * hstep, voffA); } } while (0)
#define PG8_VA_DIRECT(row0) do { _Pragma("unroll") for (int h = 0; h < 2; ++h) _Pragma("unroll") for (int i = 0; i < 2; ++i) { int R, C; stage_rc(tid * 16 + i * 8192, R, C); \
        vA[h][i] = (unsigned)((row0) + h * HALF + R) * (unsigned)K + (unsigned)C * 2u; } } while (0)
#define PG8_VA_FROM(tab) do { _Pragma("unroll") for (int h = 0; h < 2; ++h) _Pragma("unroll") for (int i = 0; i < 2; ++i) { int R, C; stage_rc(tid * 16 + i * 8192, R, C); \
        const unsigned tk = (tab)[h * HALF + R] & 0xffffu; vA[h][i] = tk * (unsigned)K + (unsigned)C * 2u; } } while (0)
#define PG8_LD2(p) __builtin_bit_cast(v8i_t, __builtin_shufflevector(*(const LAS bf16x8*)(p), *(const LAS bf16x8*)((p) + 1024), 0, 1, 2, 3, 4, 5, 6, 7, 8, 9, 10, 11, 12, 13, 14, 15))
#define PG8_LDA(dst, b, h) do { _Pragma("unroll") for (int m = 0; m < 4; ++m) dst[m] = PG8_LD2(lds + PG8_SA(b, h) + aoff + m * 2048); } while (0)
#define PG8_LDB(dst, b, h) do { _Pragma("unroll") for (int n = 0; n < 2; ++n) dst[n] = PG8_LD2(lds + PG8_SB(b, h) + boff + n * 2048); } while (0)
#define PG8_HALF(v, k) __builtin_bit_cast(bf16x8, __builtin_shufflevector(v, v, 4 * (k), 4 * (k) + 1, 4 * (k) + 2, 4 * (k) + 3))
#define PG8_MMA(ai, bj, At, Bt) do { __builtin_amdgcn_s_setprio(1); _Pragma("unroll") for (int m = 0; m < 4; ++m) _Pragma("unroll") for (int n = 0; n < 2; ++n) { \
        if constexpr (FP8) { acc[ai][bj][m][n] = __builtin_amdgcn_mfma_scale_f32_16x16x128_f8f6f4(Bt[n], At[m], acc[ai][bj][m][n], 0, 0, 0, g.sb, 0, g.sa); } \
        else { acc[ai][bj][m][n] = __builtin_amdgcn_mfma_f32_16x16x32_bf16(PG8_HALF(Bt[n], 0), PG8_HALF(At[m], 0), acc[ai][bj][m][n], 0, 0, 0); \
               acc[ai][bj][m][n] = __builtin_amdgcn_mfma_f32_16x16x32_bf16(PG8_HALF(Bt[n], 1), PG8_HALF(At[m], 1), acc[ai][bj][m][n], 0, 0, 0); } } \
        __builtin_amdgcn_s_setprio(0); } while (0)
#define PG8_WAIT_V(n) asm volatile("s_waitcnt vmcnt(" #n ")" ::: "memory")
#define PG8_WAIT_L(n) asm volatile("s_waitcnt lgkmcnt(" #n ")" ::: "memory")
#define PG8_BAR __builtin_amdgcn_s_barrier()
#define PG8_SCHED __builtin_amdgcn_sched_barrier(0)
    Unit cur, nxt; int ui = 0;
    if (!S.next(0, cur)) return;
    f32x4 acc[2][2][4][2];
#pragma unroll
    for (int a = 0; a < 2; ++a)
#pragma unroll
        for (int b = 0; b < 2; ++b)
#pragma unroll
            for (int m = 0; m < 4; ++m)
#pragma unroll
                for (int n = 0; n < 2; ++n) acc[a][b][m][n] = (f32x4){0.f, 0.f, 0.f, 0.f};
    v8i_t At[4], B0[2], B1[2];
    unsigned vA[2][2];
    if constexpr (AM == 1) { PG8_VA_FROM(g.list + cur.arow); } else if constexpr (AM == 2) { PG8_VA_DIRECT(cur.arow); }
    else {
#pragma unroll
        for (int h = 0; h < 2; ++h)
#pragma unroll
            for (int i = 0; i < 2; ++i) vA[h][i] = 0u;
    }
    const char* cA = GATHER ? (const char*)g.A : (const char*)((Sched::DUAL && cur.e) ? g.A2 : g.A) + (size_t)cur.arow * K;
    const char* cB = (const char*)((Sched::DUAL && cur.e) ? g.Bt2 : g.Bt) + (size_t)cur.brow * K;
    PG8_STAGE(PG8_SB(0, 0), cB, voffB); PG8_STAGE(PG8_SB(0, 1), cB + hstep, voffB); PG8_STAGE_A(PG8_SA(0, 0), cA, 0); PG8_STAGE_A(PG8_SA(0, 1), cA, 1);
    if (wr == 1) PG8_BAR;
    PG8_WAIT_V(2); PG8_BAR;
    PG8_STAGE(PG8_SB(1, 0), cB + kstep, voffB); PG8_STAGE_A(PG8_SA(1, 0), cA + kstep, 0); PG8_STAGE(PG8_SB(1, 1), cB + hstep + kstep, voffB);
    PG8_WAIT_V(6); PG8_BAR;
    for (;;) {
        const bool has_next = S.next(ui + 1, nxt);
        const char* nA = GATHER ? (const char*)g.A : (has_next ? (const char*)((Sched::DUAL && nxt.e) ? g.A2 : g.A) + (size_t)nxt.arow * K : cA);
        const char* nB = has_next ? (const char*)((Sched::DUAL && nxt.e) ? g.Bt2 : g.Bt) + (size_t)nxt.brow * K : cB;
        if constexpr (AM == 1) {
            if (has_next && wid < 4)
                __builtin_amdgcn_global_load_lds((const unsigned*)(g.list + nxt.arow + wid * 64 + lane), (LAS unsigned*)(toktab + ((ui + 1) & 1) * 256 + wid * 64), 4, 0, 0);
        }
#pragma clang loop unroll(disable)
        for (int t = 0; t < nt; t += 2) {
            const bool last = (t == nt - 2);
            const char* a1 = cA + (size_t)(t + 1) * kstep;
            const char* a2 = last ? nA : cA + (size_t)(t + 2) * kstep; const char* b2 = last ? nB : cB + (size_t)(t + 2) * kstep;
            const char* a3 = a2 + kstep; const char* b3 = b2 + kstep;
            PG8_LDB(B0, 0, 0); PG8_LDB(B1, 0, 1); PG8_SCHED; PG8_LDA(At, 0, 0); PG8_STAGE_A(PG8_SA(1, 1), a1, 1);
            if constexpr (AM == 1) { if (last && has_next) { PG8_VA_FROM(toktab + ((ui + 1) & 1) * 256); } } else if constexpr (AM == 2) { if (last && has_next) { PG8_VA_DIRECT(nxt.arow); } }
            PG8_WAIT_V(8); PG8_WAIT_L(0); PG8_BAR; PG8_MMA(0, 0, At, B0); PG8_MMA(0, 1, At, B1); PG8_BAR; PG8_SCHED;
            PG8_LDA(At, 0, 1); PG8_STAGE(PG8_SB(0, 0), b2, voffB); PG8_STAGE(PG8_SB(0, 1), b2 + hstep, voffB); PG8_STAGE_A(PG8_SA(0, 0), a2, 0);
            PG8_WAIT_V(8); PG8_WAIT_L(0); PG8_BAR; PG8_MMA(1, 0, At, B0); PG8_MMA(1, 1, At, B1); PG8_BAR; PG8_SCHED;
            PG8_LDB(B0, 1, 0); PG8_LDB(B1, 1, 1); PG8_SCHED; PG8_LDA(At, 1, 0); PG8_STAGE_A(PG8_SA(0, 1), a2, 1);
            PG8_WAIT_V(8); PG8_WAIT_L(0); PG8_BAR; PG8_MMA(0, 0, At, B0); PG8_MMA(0, 1, At, B1); PG8_BAR; PG8_SCHED;
            PG8_LDA(At, 1, 1); PG8_STAGE(PG8_SB(1, 0), b3, voffB); PG8_STAGE(PG8_SB(1, 1), b3 + hstep, voffB); PG8_STAGE_A(PG8_SA(1, 0), a3, 0);
            PG8_WAIT_V(8); PG8_WAIT_L(0); PG8_BAR; PG8_MMA(1, 0, At, B0); PG8_MMA(1, 1, At, B1); PG8_BAR; PG8_SCHED;
        }
        if (wr == 0) PG8_BAR;
        E(acc, cur, wr, wc, fr, fq);
        if (!has_next) break;
#pragma unroll
        for (int a = 0; a < 2; ++a)
#pragma unroll
            for (int b = 0; b < 2; ++b)
#pragma unroll
                for (int m = 0; m < 4; ++m)
#pragma unroll
                    for (int n = 0; n < 2; ++n) acc[a][b][m][n] = (f32x4){0.f, 0.f, 0.f, 0.f};
        cur = nxt; cA = nA; cB = nB; ++ui;
        if (wr == 1) PG8_BAR;
    }
    PG8_WAIT_V(0);
    PG8_BAR;
#undef PG8_SA
#undef PG8_SB
#undef PG8_STAGE
#undef PG8_STAGE_A
#undef PG8_VA_FROM
#undef PG8_VA_DIRECT
#undef PG8_LDA
#undef PG8_LD2
#undef PG8_HALF
#undef PG8_LDB
#undef PG8_MMA
#undef PG8_WAIT_V
#undef PG8_WAIT_L
#undef PG8_BAR
#undef PG8_SCHED
}
}

struct Ctx {
    LAS unsigned char* lds;
    int tid, lane, wave, G, bx;
    unsigned* ctl;
    unsigned char* ws;
    float* out;
};
DI const float* inp(const Ctx& F, int i) {
    const LAS unsigned* p = (const LAS unsigned*)(F.lds + PTAB_OFF) + 2 * i;
    const unsigned lo = (unsigned)__builtin_amdgcn_readfirstlane((int)p[0]), hi = (unsigned)__builtin_amdgcn_readfirstlane((int)p[1]);
    return (const float*)(const GAS float*)(((unsigned long long)hi << 32) | lo);
}
DI void launder(Ctx& F) { int t = F.wave * 64 + shfl_lane(); asm volatile("" : "+v"(t)); F.tid = t; F.lane = t & 63;
    const unsigned long long w = (unsigned long long)F.ws; int wl = __builtin_amdgcn_readfirstlane((int)(unsigned)w), wh = __builtin_amdgcn_readfirstlane((int)(unsigned)(w >> 32));
    asm volatile("" : "+s"(wl), "+s"(wh)); F.ws = (unsigned char*)(GAS unsigned char*)(((unsigned long long)(unsigned)wh << 32) | (unsigned)wl); F.ctl = (unsigned*)(F.ws + WS_CTL);
    int ll = __builtin_amdgcn_readfirstlane((int)(unsigned)(size_t)F.lds); asm volatile("" : "+s"(ll)); F.lds = (LAS unsigned char*)(size_t)(unsigned)ll;
    int gg = __builtin_amdgcn_readfirstlane(F.G), bb = __builtin_amdgcn_readfirstlane(F.bx); asm volatile("" : "+s"(gg), "+s"(bb)); F.G = gg; F.bx = bb; }
enum { I_X = 0, I_MEM, I_RELB, I_AWIN, I_ACONVW, I_ACONVB, I_AWR, I_ABR, I_AWI, I_ABI, I_ALAM, I_BWIN, I_BKVG, I_BWUK, I_BWUV, I_BIDXG, I_BIDXB,
       I_WMEMKV, I_WOUT, I_LN1G, I_LN1B, I_ROUTW, I_ROUTB, I_W1, I_B1, I_W2, I_B2, I_LN2G, I_LN2B };

DI void tr_item(const float* W, int sstride, bf16_t* dst, int dstride, int k0, int nvalid, LAS float* scr, int lane, bf16_t* dst_lo) {
    float v[32];
#pragma unroll
    for (int i = 0; i < 32; ++i) { const int kk = 2 * i + (lane >> 5), nn = lane & 31; const float x = W[(size_t)(k0 + kk) * sstride + (nn < nvalid ? nn : 0)]; v[i] = (nn < nvalid) ? x : 0.f; }
#pragma unroll
    for (int i = 0; i < 32; ++i) { const int kk = 2 * i + (lane >> 5); scr[kk * 33 + (lane & 31)] = v[i]; }
    LDS_WAIT();
    const int c = lane & 7;
#pragma unroll
    for (int j = 0; j < 4; ++j) { const int n = (lane >> 3) + 8 * j; const LAS float* s = scr + (8 * c) * 33 + n;
        float f[8];
#pragma unroll
        for (int q = 0; q < 8; ++q) f[q] = s[q * 33];
        u32x4 o; o.x = cvt_pk_bf16(f[0], f[1]); o.y = cvt_pk_bf16(f[2], f[3]); o.z = cvt_pk_bf16(f[4], f[5]); o.w = cvt_pk_bf16(f[6], f[7]);
        if (n < nvalid) *(u32x4*)(dst + (size_t)n * dstride + k0 + 8 * c) = o;
        if (dst_lo) {
            float r[8];
            r[0] = f[0] - bflo(o.x); r[1] = f[1] - bfhi(o.x); r[2] = f[2] - bflo(o.y); r[3] = f[3] - bfhi(o.y);
            r[4] = f[4] - bflo(o.z); r[5] = f[5] - bfhi(o.z); r[6] = f[6] - bflo(o.w); r[7] = f[7] - bfhi(o.w);
            u32x4 l; l.x = cvt_pk_bf16(r[0], r[1]); l.y = cvt_pk_bf16(r[2], r[3]); l.z = cvt_pk_bf16(r[4], r[5]); l.w = cvt_pk_bf16(r[6], r[7]);
            if (n < nvalid) *(u32x4*)(dst_lo + (size_t)n * dstride + k0 + 8 * c) = l;
        }
    }
    LDS_WAIT();
}

DI void tr8_load(const float* W, int sstride, int k0, int lane, float (&v)[32]) {
#pragma unroll
    for (int i = 0; i < 32; ++i) { const int kk = 2 * i + (lane >> 5), nn = lane & 31; v[i] = W[(size_t)(k0 + kk) * sstride + nn]; }
}
DI void tr8_store(const float (&v)[32], unsigned char* dst, int dstride, int k0, float scale, LAS float* scr, int lane) {
#pragma unroll
    for (int i = 0; i < 32; ++i) { const int kk = 2 * i + (lane >> 5); scr[kk * 33 + (lane & 31)] = v[i] * scale; }
    LDS_WAIT();
    const int c = lane & 3;
#pragma unroll
    for (int j = 0; j < 2; ++j) { const int n = (lane >> 2) + 16 * j; const LAS float* sp = scr + (16 * c) * 33 + n;
        float f[16];
#pragma unroll
        for (int q = 0; q < 16; ++q) f[q] = sp[q * 33];
        u32x4 o; o.x = pk4_fp8(f[0], f[1], f[2], f[3]); o.y = pk4_fp8(f[4], f[5], f[6], f[7]); o.z = pk4_fp8(f[8], f[9], f[10], f[11]); o.w = pk4_fp8(f[12], f[13], f[14], f[15]);
        *(u32x4*)(dst + (size_t)n * dstride + k0 + 16 * c) = o; }
    LDS_WAIT();
}
DI void tr8_item(const float* W, int sstride, unsigned char* dst, int dstride, int k0, int nvalid, float scale, LAS float* scr, int lane) {
    float v[32];
#pragma unroll
    for (int i = 0; i < 32; ++i) { const int kk = 2 * i + (lane >> 5), nn = lane & 31; const float x = W[(size_t)(k0 + kk) * sstride + (nn < nvalid ? nn : 0)]; v[i] = (nn < nvalid) ? x : 0.f; }
#pragma unroll
    for (int i = 0; i < 32; ++i) { const int kk = 2 * i + (lane >> 5); scr[kk * 33 + (lane & 31)] = v[i] * scale; }
    LDS_WAIT();
    const int c = lane & 3;
#pragma unroll
    for (int j = 0; j < 2; ++j) { const int n = (lane >> 2) + 16 * j; const LAS float* sp = scr + (16 * c) * 33 + n;
        float f[16];
#pragma unroll
        for (int q = 0; q < 16; ++q) f[q] = sp[q * 33];
        u32x4 o; o.x = pk4_fp8(f[0], f[1], f[2], f[3]); o.y = pk4_fp8(f[4], f[5], f[6], f[7]); o.z = pk4_fp8(f[8], f[9], f[10], f[11]); o.w = pk4_fp8(f[12], f[13], f[14], f[15]);
        if (n < nvalid) *(u32x4*)(dst + (size_t)n * dstride + k0 + 16 * c) = o; }
    LDS_WAIT();
}
struct Tr8Item { const float* W; int sstride; unsigned char* dst; int k0; float scale; };
DI Tr8Item tr8_decode(const Ctx& F, int it) {
    constexpr int I1 = 16 * 64, I2 = 16 * 32;
    const int le = it / (I1 + I2); int r = it % (I1 + I2); Tr8Item t;
    if (r < I1) { const int kb = r / 64, nb = r % 64; const int n0 = nb * 32;
        const int drow = (n0 < 1024) ? (256 * (n0 / 128) + (n0 % 128)) : (256 * ((n0 - 1024) / 128) + 128 + ((n0 - 1024) % 128));
        t.W = inp(F, I_W1) + (size_t)le * 1024 * 2048 + n0; t.sstride = 2048; t.dst = F.ws + WS_W1 + ((size_t)le * 2048 + drow) * 1024; t.k0 = kb * 64; t.scale = 32.0f;
    } else { r -= I1; const int kb = r / 32, nb = r % 32; const int n0 = nb * 32;
        t.W = inp(F, I_W2) + (size_t)le * 1024 * 1024 + n0; t.sstride = 1024; t.dst = F.ws + WS_W2 + ((size_t)le * 1024 + n0) * 1024; t.k0 = kb * 64; t.scale = 64.0f; }
    return t;
}

DI void p0_prologue(Ctx& F) {
    LAS float* scr = (LAS float*)(F.lds + F.wave * 16384);
    const int gw = F.bx * 8 + F.wave, NGW = F.G * 8, lane = F.lane;
    unsigned char* ws = F.ws;
    {
        constexpr int NIT = 64 * (16 * 64 + 16 * 32);
        float v[32];
        Tr8Item cur = tr8_decode(F, gw < NIT ? gw : 0);
        if (gw < NIT) tr8_load(cur.W, cur.sstride, cur.k0, lane, v);
        for (int it = gw; it < NIT; it += NGW) {
            float vn[32]; Tr8Item nx = cur;
            const bool more = it + NGW < NIT;
            if (more) { nx = tr8_decode(F, it + NGW); tr8_load(nx.W, nx.sstride, nx.k0, lane, vn); }
            __builtin_amdgcn_sched_barrier(0);
            tr8_store(v, cur.dst, 1024, cur.k0, cur.scale, scr, lane);
            if (more) {
#pragma unroll
                for (int i = 0; i < 32; ++i) v[i] = vn[i];
            }
            cur = nx;
        }
    }
    {
        constexpr int IA = 16 * 56;
        constexpr int IB = 16 * 47;
        constexpr int IKV = 2 * 16 * 16;
        constexpr int IO = 2 * 16 * 32;
        constexpr int IR = 12 * 2 * 2;
        constexpr int IUV = 12 * 2 * 2;
        constexpr int IRT = 2 * 16;
        constexpr int NIT = IA + IB + IKV + IO + IR + IUV + IRT;
        for (int it = gw; it < NIT; it += NGW) {
            int r = it;
            if (r < IA) { const int kb = r / 56, nb = r % 56; tr8_item(inp(F, I_AWIN) + nb * 32, WINA, ws + WS_WINA + (size_t)(nb * 32) * 1024, 1024, kb * 64, 32, 32.0f, scr, lane); continue; } r -= IA;
            if (r < IB) { const int kb = r / 47, nb = r % 47;
                const int scol = (nb < 38) ? nb * 32 : (nb == 38) ? 1216 : 1220 + (nb - 39) * 32, drow = (nb < 38) ? nb * 32 : (nb == 38) ? B_IW : B_MQ + (nb - 39) * 32, nv = (nb == 38) ? 4 : 32;
                tr8_item(inp(F, I_BWIN) + scol, WINB, ws + WS_WINB + (size_t)drow * 1024, 1024, kb * 64, nv, 32.0f, scr, lane); continue; } r -= IB;
            if (r < IKV) { const int l = r / 256, q = r % 256, kb = q / 16, nb = q % 16; tr_item(inp(F, I_WMEMKV) + (size_t)l * 1024 * 512 + nb * 32, 512, (bf16_t*)(ws + WS_WKV) + (size_t)(l * 512 + nb * 32) * 1024, 1024, kb * 64, 32, scr, lane, nullptr); continue; } r -= IKV;
            if (r < IO) { const int l = r / 512, q = r % 512, kb = q / 32, nb = q % 32;
                if (l == 0) tr_item(inp(F, I_WOUT) + nb * 32, 1024, (bf16_t*)(ws + WS_WOUT) + (size_t)(nb * 32) * 1024, 1024, kb * 64, 32, scr, lane, nullptr);
                else tr8_item(inp(F, I_WOUT) + (size_t)1024 * 1024 + nb * 32, 1024, ws + WS_WOUT + (size_t)1024 * 1024 * 2 + (size_t)(nb * 32) * 1024, 1024, kb * 64, 32, 32.0f, scr, lane);
                continue; } r -= IO;
            if (r < IR) { const int n = r / 4, g = (r >> 1) & 1, nb = r & 1; const float* src = (g ? inp(F, I_AWI) : inp(F, I_AWR)) + (size_t)n * 4096 + nb * 32;
                tr_item(src, 64, (bf16_t*)(ws + WS_WRT) + ((size_t)(n * 2 + g) * 64 + nb * 32) * 64, 64, 0, 32, scr, lane, nullptr); continue; } r -= IR;
            if (r < IUV) { const int h = r / 4, kb = (r >> 1) & 1, nb = r & 1; tr_item(inp(F, I_BWUV) + h * 64 + nb * 32, 768, (bf16_t*)(ws + WS_WUVT) + ((size_t)h * 64 + nb * 32) * 128, 128, kb * 64, 32, scr, lane, nullptr); continue; } r -= IUV;
            { const int l = r / 16, kb = r % 16; bf16_t* hi = (bf16_t*)(ws + WS_ROUT) + (size_t)(l * 2) * 32 * 1024; tr_item(inp(F, I_ROUTW) + (size_t)l * 1024 * 32, 32, hi, 1024, kb * 64, 32, scr, lane, hi + 32 * 1024); }
        }
    }
    {
        const size_t gt = (size_t)F.bx * 512 + F.tid, NT = (size_t)F.G * 512;
        const f32x4* x4 = (const f32x4*)inp(F, I_X); unsigned* xb = (unsigned*)(ws + WS_XB8);
        for (size_t i = gt; i < (size_t)T * D / 4; i += NT) { const f32x4 v = x4[i]; xb[i] = pk4_fp8(v[0] * 4.0f, v[1] * 4.0f, v[2] * 4.0f, v[3] * 4.0f); }
        const f32x4* m4 = (const f32x4*)inp(F, I_MEM); u32x2* mb = (u32x2*)(ws + WS_MEMBF);
        for (size_t i = gt; i < (size_t)NB * MEML * D / 4; i += NT) { const f32x4 v = m4[i]; u32x2 o; o.x = cvt_pk_bf16(v[0], v[1]); o.y = cvt_pk_bf16(v[2], v[3]); mb[i] = o; }
        bf16_t* wuk = (bf16_t*)(ws + WS_WUK);
        for (size_t i = gt; i < (size_t)128 * 12 * 64; i += NT) { const int d = (int)(i & 63), h = (int)((i >> 6) % 12), rr = (int)(i / 768); wuk[((size_t)h * 128 + rr) * 64 + d] = f2bf(inp(F, I_BWUK)[i]); }
        unsigned* pad = (unsigned*)(ws + WS_WINB + (size_t)WINB * 1024);
        for (size_t i = gt; i < (size_t)(WINBP - WINB) * 1024 / 4; i += NT) pad[i] = 0u;
    }
}

constexpr int LC = 128, NCHUNK = SEQ / LC;
template <int PASS> DI void lru_phase(Ctx& F) {
    LAS unsigned char* lds = F.lds;
    LAS bf16_t* XC = (LAS bf16_t*)lds;
    LAS float* AA = (LAS float*)(lds + 18432);
    LAS float* UU = (LAS float*)(lds + 51200);
    LAS float* SEG = (LAS float*)(lds + 83968);
    LAS float* CSEG = (LAS float*)(lds + 88832);
    LAS float* PARA = (LAS float*)(lds + 92928);
    LAS float* CW = (LAS float*)(lds + 92928 + 9216);
    const int tid = F.tid, lane = F.lane, w = F.wave, fr = lane & 15, fq = lane >> 4;
    const bf16_t* PROJ = (const bf16_t*)(F.ws + WS_PROJ);
    const bf16_t* WRT = (const bf16_t*)(F.ws + WS_WRT);
    float* LSUM = (float*)(F.ws + WS_LSUM);
    bf16_t* MIX = (bf16_t*)(F.ws + WS_MIX);
    __syncthreads();
    for (int i = tid; i < TOKW; i += 512) { PARA[i] = inp(F, I_ABR)[i]; PARA[TOKW + i] = inp(F, I_ABI)[i]; PARA[2 * TOKW + i] = 8.0f * log1pf(__expf(-inp(F, I_ALAM)[i])); CW[4 * TOKW + i] = inp(F, I_ACONVB)[i]; }
    for (int i = tid; i < 4 * TOKW; i += 512) CW[i] = inp(F, I_ACONVW)[i];
    u32x4 xin[2][4];
#define LRU_LOAD_X(uu) do { const int n_ = (uu) % 12, k_ = ((uu) / 12) % NCHUNK, b_ = (uu) / (12 * NCHUNK); const size_t r0_ = (size_t)b_ * SEQ + (size_t)k_ * LC; \
        _Pragma("unroll") for (int it = 0; it < 2; ++it) { const int item = tid + 512 * it, t = item >> 3, c8 = item & 7, ch = n_ * 64 + c8 * 8; \
            _Pragma("unroll") for (int j = 0; j < 4; ++j) { const int sp = k_ * LC + t - 3 + j; xin[it][j] = (sp >= 0) ? *(const u32x4*)(PROJ + (r0_ + t - 3 + j) * WINA + ch) : (u32x4){0u, 0u, 0u, 0u}; } } } while (0)
    if (F.bx < NB * NCHUNK * 12) LRU_LOAD_X(F.bx);
    for (int u = F.bx; u < NB * NCHUNK * 12; u += F.G) {
        const int n = u % 12, k = (u / 12) % NCHUNK, b = u / (12 * NCHUNK);
        const size_t row0 = (size_t)b * SEQ + (size_t)k * LC;
        __syncthreads();
        const LAS float* PAR = PARA + n * 64;
        if (PASS == 1) {
            const int d = tid & 63, seg = tid >> 6; float A = 1.f, H = 0.f; f32x2 sv[8];
#pragma unroll
            for (int q = 0; q < 8; ++q) { const int kk = seg * 8 + q; sv[q] = (kk < k) ? *(const f32x2*)(LSUM + (((size_t)b * NCHUNK + kk) * TOKW + n * 64 + d) * 2) : (f32x2){1.f, 0.f}; }
#pragma unroll
            for (int q = 0; q < 8; ++q) { H = sv[q].x * H + sv[q].y; A *= sv[q].x; }
            CSEG[(seg * 64 + d) * 2] = A; CSEG[(seg * 64 + d) * 2 + 1] = H;
        }
#pragma unroll
        for (int it = 0; it < 2; ++it) {
            const int item = tid + 512 * it, t = item >> 3, c8 = item & 7, ch = n * 64 + c8 * 8;
            float accv[8];
            { const f32x4 b0 = *(const LAS f32x4*)(CW + 4 * TOKW + ch), b1 = *(const LAS f32x4*)(CW + 4 * TOKW + ch + 4);
#pragma unroll
              for (int q = 0; q < 4; ++q) { accv[q] = b0[q]; accv[4 + q] = b1[q]; } }
#pragma unroll
            for (int j = 0; j < 4; ++j) {
                const u32x4 xv = xin[it][j];
                const f32x4 w0 = *(const LAS f32x4*)(CW + j * TOKW + ch), w1 = *(const LAS f32x4*)(CW + j * TOKW + ch + 4);
                accv[0] += w0[0] * bflo(xv.x); accv[1] += w0[1] * bfhi(xv.x); accv[2] += w0[2] * bflo(xv.y); accv[3] += w0[3] * bfhi(xv.y);
                accv[4] += w1[0] * bflo(xv.z); accv[5] += w1[1] * bfhi(xv.z); accv[6] += w1[2] * bflo(xv.w); accv[7] += w1[3] * bfhi(xv.w);
            }
            u32x4 o; o.x = cvt_pk_bf16(accv[0], accv[1]); o.y = cvt_pk_bf16(accv[2], accv[3]); o.z = cvt_pk_bf16(accv[4], accv[5]); o.w = cvt_pk_bf16(accv[6], accv[7]);
            *(LAS u32x4*)(XC + t * 72 + c8 * 8) = o;
        }
        if (u + F.G < NB * NCHUNK * 12) LRU_LOAD_X(u + F.G);
        unsigned short gbv[16];
        if (PASS == 1) { const bf16_t* gbp = PROJ + (row0 + (tid >> 6) * 16) * WINA + TOKW + n * 64 + (tid & 63);
#pragma unroll
            for (int q = 0; q < 16; ++q) gbv[q] = gbp[(size_t)q * WINA]; }
        __syncthreads();
        {
            bf16x8 xb[2];
#pragma unroll
            for (int ks = 0; ks < 2; ++ks) xb[ks] = *(const LAS bf16x8*)(XC + (16 * w + fr) * 72 + ks * 32 + fq * 8);
            f32x4 acc[2][4];
#pragma unroll
            for (int g = 0; g < 2; ++g)
#pragma unroll
                for (int j = 0; j < 4; ++j) { acc[g][j] = (f32x4){0.f, 0.f, 0.f, 0.f};
#pragma unroll
                    for (int ks = 0; ks < 2; ++ks) { const bf16x8 wf = *(const bf16x8*)(WRT + ((size_t)(n * 2 + g) * 64 + 16 * j + fr) * 64 + ks * 32 + fq * 8); acc[g][j] = MFMA16(wf, xb[ks], acc[g][j]); } }
            const int t = 16 * w + fr;
#pragma unroll
            for (int j = 0; j < 4; ++j) {
                const int d0 = 16 * j + 4 * fq;
                const f32x4 br = *(const LAS f32x4*)(PAR + d0), bi = *(const LAS f32x4*)(PAR + TOKW + d0), sp = *(const LAS f32x4*)(PAR + 2 * TOKW + d0);
                const u32x2 xw = *(const LAS u32x2*)(XC + t * 72 + d0);
                const float xcv[4] = {bflo(xw.x), bfhi(xw.x), bflo(xw.y), bfhi(xw.y)};
                f32x4 av, uv;
#pragma unroll
                for (int q = 0; q < 4; ++q) {
                    const float rg = sigmoidf_(acc[0][j][q] + br[q]), ig = sigmoidf_(acc[1][j][q] + bi[q]);
                    const float la = -sp[q] * rg; const float a = __expf(la); const float x2 = 2.0f * la;
                    const float om = (x2 > -0.1f) ? (-x2 * (1.0f + x2 * (0.5f + x2 * (0.16666667f + x2 * 0.041666667f)))) : (1.0f - a * a);
                    av[q] = a; uv[q] = sqrtf(om) * ig * xcv[q];
                }
                *(LAS f32x4*)(AA + t * 64 + d0) = av; *(LAS f32x4*)(UU + t * 64 + d0) = uv;
            }
        }
        __syncthreads();
        const int d = tid & 63, seg = tid >> 6;
        {
            float A = 1.f, H = 0.f;
#pragma unroll
            for (int q = 0; q < 16; ++q) { const int t = seg * 16 + q; const float a = AA[t * 64 + d], uu = UU[t * 64 + d]; H = a * H + uu; A *= a; }
            SEG[(seg * 64 + d) * 2] = A; SEG[(seg * 64 + d) * 2 + 1] = H;
        }
        __syncthreads();
        if (PASS == 0) {
            if (tid < 64) { float A = 1.f, H = 0.f;
#pragma unroll
                for (int s = 0; s < 8; ++s) { const float As = SEG[(s * 64 + tid) * 2], Hs = SEG[(s * 64 + tid) * 2 + 1]; H = As * H + Hs; A *= As; }
                *(f32x2*)(LSUM + (((size_t)b * NCHUNK + k) * TOKW + n * 64 + tid) * 2) = (f32x2){A, H}; }
        } else {
            float h = 0.f;
#pragma unroll
            for (int s = 0; s < 8; ++s) h = CSEG[(s * 64 + d) * 2] * h + CSEG[(s * 64 + d) * 2 + 1];
#pragma unroll
            for (int s = 0; s < 8; ++s) if (s < seg) h = SEG[(s * 64 + d) * 2] * h + SEG[(s * 64 + d) * 2 + 1];
            bf16_t* op = MIX + (row0 + seg * 16) * D + n * 64 + d;
#pragma unroll
            for (int q = 0; q < 16; ++q) { const int t = seg * 16 + q; h = AA[t * 64 + d] * h + UU[t * 64 + d];
                const float g = bf2f(gbv[q]); const float y = 0.7978845608f * (g + 0.044715f * g * g * g); const float th = 1.0f - 2.0f * __builtin_amdgcn_rcpf(__expf(2.0f * y) + 1.0f);
                op[(size_t)q * D] = f2bf(h * 0.5f * g * (1.0f + th)); }
        }
    }
    __syncthreads();
#undef LRU_LOAD_X
}

DI void memattn_phase(Ctx& F, int layer, int ldp, int mqcol) {
    LAS unsigned char* lds = F.lds;
    LAS bf16_t* Kt = (LAS bf16_t*)lds;
    LAS bf16_t* Vt = (LAS bf16_t*)(lds + 36864);
    const int tid = F.tid, lane = F.lane, w = F.wave, fr = lane & 15, fq = lane >> 4;
    const bf16_t* PROJ = (const bf16_t*)(F.ws + WS_PROJ);
    const bf16_t* KV = (const bf16_t*)(F.ws + WS_KV);
    bf16_t* MIX = (bf16_t*)(F.ws + WS_MIX);
    for (int u = F.bx; u < NB * 4 * 8; u += F.G) {
        const int qc = u & 7, h = (u >> 3) & 3, b = u >> 5;
        __syncthreads();
#pragma unroll
        for (int it = 0; it < 4; ++it) { const int p = tid + 512 * it, key = p >> 3, c8 = p & 7;
            *(LAS u32x4*)(Kt + key * 72 + c8 * 8) = *(const u32x4*)(KV + (size_t)(b * MEML + key) * 1024 + layer * 512 + h * 64 + c8 * 8); }
        { const int key = tid & 255, dh = tid >> 8;
#pragma unroll
          for (int c = 0; c < 4; ++c) { const u32x4 v = *(const u32x4*)(KV + (size_t)(b * MEML + key) * 1024 + layer * 512 + 256 + h * 64 + dh * 32 + c * 8);
              const unsigned wv[4] = {v.x, v.y, v.z, v.w};
#pragma unroll
              for (int q = 0; q < 4; ++q) { const int dd = dh * 32 + c * 8 + 2 * q; Vt[dd * 264 + key] = (bf16_t)(wv[q] & 0xffffu); Vt[(dd + 1) * 264 + key] = (bf16_t)(wv[q] >> 16); } } }
        __syncthreads();
        for (int it = 0; it < 8; ++it) {
            const size_t q0 = (size_t)b * SEQ + qc * 1024 + it * 128 + w * 16;
            bf16x8 qf[2];
#pragma unroll
            for (int ks = 0; ks < 2; ++ks) qf[ks] = *(const bf16x8*)(PROJ + (q0 + fr) * ldp + mqcol + h * 64 + ks * 32 + fq * 8);
            f32x4 s[16];
#pragma unroll
            for (int jg = 0; jg < 4; ++jg) { bf16x8 kf[4][2];
#pragma unroll
                for (int jj = 0; jj < 4; ++jj)
#pragma unroll
                    for (int ks = 0; ks < 2; ++ks) kf[jj][ks] = *(const LAS bf16x8*)(Kt + (16 * (4 * jg + jj) + fr) * 72 + ks * 32 + fq * 8);
#pragma unroll
                for (int jj = 0; jj < 4; ++jj) { const int j = 4 * jg + jj; s[j] = (f32x4){0.f, 0.f, 0.f, 0.f};
#pragma unroll
                    for (int ks = 0; ks < 2; ++ks) s[j] = MFMA16(kf[jj][ks], qf[ks], s[j]); }
                asm volatile("" ::: "memory"); }
            float mx = -3.0e38f;
#pragma unroll
            for (int j = 0; j < 16; ++j) mx = fmaxf(mx, fmaxf(fmaxf(s[j][0], s[j][1]), fmaxf(s[j][2], s[j][3])));
            mx = rows4_max(mx);
            float l = 0.f; bf16x8 pf[8];
#pragma unroll
            for (int ks = 0; ks < 8; ++ks) { float p[8];
#pragma unroll
                for (int q = 0; q < 4; ++q) { p[q] = __expf((s[2 * ks][q] - mx) * 0.125f); p[4 + q] = __expf((s[2 * ks + 1][q] - mx) * 0.125f); }
#pragma unroll
                for (int q = 0; q < 8; ++q) l += p[q];
                u32x4 pw; pw.x = cvt_pk_bf16(p[0], p[1]); pw.y = cvt_pk_bf16(p[2], p[3]); pw.z = cvt_pk_bf16(p[4], p[5]); pw.w = cvt_pk_bf16(p[6], p[7]);
                pf[ks] = __builtin_bit_cast(bf16x8, pw); }
            l = rows4_sum(l);
            const float inv = 1.0f / l;
            f32x4 o[4];
#pragma unroll
            for (int dt = 0; dt < 4; ++dt) o[dt] = (f32x4){0.f, 0.f, 0.f, 0.f};
#pragma unroll
            for (int ks = 0; ks < 8; ++ks) { bf16x8 vf[4];
#pragma unroll
                for (int dt = 0; dt < 4; ++dt) { const LAS bf16_t* vp = Vt + (16 * dt + fr) * 264 + 32 * ks + 4 * fq;
                    const s16x4 lo = *(const LAS s16x4*)vp, hi = *(const LAS s16x4*)(vp + 16); vf[dt] = __builtin_shufflevector(lo, hi, 0, 1, 2, 3, 4, 5, 6, 7); }
#pragma unroll
                for (int dt = 0; dt < 4; ++dt) o[dt] = MFMA16(vf[dt], pf[ks], o[dt]); }
#pragma unroll
            for (int dt = 0; dt < 4; ++dt) { u32x2 ow; ow.x = cvt_pk_bf16(o[dt][0] * inv, o[dt][1] * inv); ow.y = cvt_pk_bf16(o[dt][2] * inv, o[dt][3] * inv);
                if (layer == 0) *(u32x2*)(MIX + (q0 + fr) * D + TOKW + h * 64 + 16 * dt + 4 * fq) = ow;
                else *(unsigned*)((unsigned char*)MIX + (q0 + fr) * D + TOKW + h * 64 + 16 * dt + 4 * fq) = pk4_fp8(o[dt][0] * inv * 16.0f, o[dt][1] * inv * 16.0f, o[dt][2] * inv * 16.0f, o[dt][3] * inv * 16.0f); }
            asm volatile("" ::: "memory");
        }
    }
    __syncthreads();
}

DI void build_mtab(Ctx& F, int layer) {
    LAS int* mtab = (LAS int*)(F.lds + MTAB_OFF);
    __syncthreads();
    if (F.tid < 64) {
        const int l = F.tid; unsigned c = 0u;
        if (l < 32) c = __hip_atomic_load(F.ctl + CW_CNT + (layer * 32 + l) * 16, __ATOMIC_RELAXED, __HIP_MEMORY_SCOPE_AGENT);
        const int nt = (int)((c + 255u) >> 8); int incl = nt;
#pragma unroll
        for (int o = 1; o < 32; o <<= 1) { const int u = shup_i(incl, o); if (l >= o) incl += u; }
        if (l < 32) mtab[l] = incl - nt;
        if (l == 31) mtab[32] = incl; }
    __syncthreads();
    LAS unsigned* gmtab = (LAS unsigned*)(F.lds + GMTAB_OFF);
    for (int gm = F.tid; gm < mtab[32] && gm < 1056; gm += 512) { int e = 0;
        for (int q = 1; q < 32; ++q) e += (gm >= mtab[q]) ? 1 : 0;
        gmtab[gm] = ((unsigned)e << 16) | (unsigned)(gm - mtab[e]); }
    __syncthreads();
}

DI unsigned wave_max_u(unsigned v);
DI void ln_router_phase(Ctx& F, int layer) {
    LAS float* WR = (LAS float*)F.lds;
    LAS unsigned* lcnt = (LAS unsigned*)(F.lds + 147456);
    LAS unsigned* lbase = (LAS unsigned*)(F.lds + 147456 + 128);
    LAS unsigned* stash = (LAS unsigned*)(F.lds + 147456 + 256);
    constexpr int ROWS_IT = 16;
    LAS float* stg = (LAS float*)(stash + 8 * ROWS_IT * 4);
    const int tid = F.tid, lane = F.lane, w = F.wave;
    const bf16_t* Z = (const bf16_t*)(F.ws + WS_Z);
    float* XA = (float*)(F.ws + WS_XA);
    bf16_t* XBF = (bf16_t*)(F.ws + WS_XBF); unsigned char* XB8 = F.ws + WS_XB8;
    const float* gam = inp(F, I_LN1G) + layer * D; const float* bet = inp(F, I_LN1B) + layer * D;
    const float* rw = inp(F, I_ROUTW) + (size_t)layer * 1024 * 32; const float* rb = inp(F, I_ROUTB) + layer * 32;
    unsigned* LIST = (unsigned*)(F.ws + WS_LIST); unsigned* TOKSLOT = (unsigned*)(F.ws + WS_TOKSLOT); float* TOKGATE = (float*)(F.ws + WS_TOKGATE);
    __syncthreads();
    for (int p = tid; p < 1024 * 8; p += 512) { const int c = p >> 3, k = p & 7; *(LAS f32x4*)(WR + ((c & 3) * 256 + (c >> 2)) * 36 + 4 * k) = *(const f32x4*)(rw + (size_t)c * 32 + 4 * k); }
    f32x4 g4[4], b4[4];
#pragma unroll
    for (int j = 0; j < 4; ++j) { g4[j] = *(const f32x4*)(gam + 4 * lane + 256 * j); b4[j] = *(const f32x4*)(bet + 4 * lane + 256 * j); }
    const int myexp = (((lane >> 5) & 1) << 4) | (((lane >> 4) & 1) << 3) | (((lane >> 3) & 1) << 2) | (((lane >> 2) & 1) << 1) | ((lane >> 1) & 1);
    const float mybias = rb[myexp];
    const int rows_blk = 8 * ROWS_IT;
    for (int it = 0; (it * F.G + F.bx) * rows_blk < T; ++it) {
        const int row0 = (it * F.G + F.bx) * rows_blk + w * ROWS_IT;
        __syncthreads();
        if (tid < 32) lcnt[tid] = 0u;
        __syncthreads();
        u32x2 vnx[4]; f32x4 rfx[4]; u32x2 rbx[4];
        const float* xres = inp(F, I_X);
#pragma unroll
        for (int j = 0; j < 4; ++j) { vnx[j] = *(const u32x2*)(Z + (size_t)row0 * D + 4 * lane + 256 * j);
            if (layer == 0) rfx[j] = *(const f32x4*)(xres + (size_t)row0 * D + 4 * lane + 256 * j); else rbx[j] = *(const u32x2*)(XBF + (size_t)row0 * D + 4 * lane + 256 * j); }
        for (int rr2 = 0; rr2 < (DBL(5) ? 2 * ROWS_IT : ROWS_IT); ++rr2) {
            const int r = rr2 % ROWS_IT; const bool publish = !DBL(5) || rr2 >= ROWS_IT;
            const size_t row = (size_t)row0 + r;
            f32x4 v[4];
#pragma unroll
            for (int j = 0; j < 4; ++j) { const f32x4 res = (layer == 0) ? rfx[j] : (f32x4){bflo(rbx[j].x), bfhi(rbx[j].x), bflo(rbx[j].y), bfhi(rbx[j].y)};
                v[j] = res * DN_ALPHA + (f32x4){bflo(vnx[j].x), bfhi(vnx[j].x), bflo(vnx[j].y), bfhi(vnx[j].y)}; }
            { const size_t rown = (size_t)row0 + ((rr2 + 1) % ROWS_IT);
#pragma unroll
              for (int j = 0; j < 4; ++j) { vnx[j] = *(const u32x2*)(Z + rown * D + 4 * lane + 256 * j);
                  if (layer == 0) rfx[j] = *(const f32x4*)(xres + rown * D + 4 * lane + 256 * j); else rbx[j] = *(const u32x2*)(XBF + rown * D + 4 * lane + 256 * j); } }
            __builtin_amdgcn_sched_barrier(0);
            float s = 0.f;
#pragma unroll
            for (int j = 0; j < 4; ++j) s += (v[j][0] + v[j][1]) + (v[j][2] + v[j][3]);
            const float mean = wave_sum_fast(s) * (1.0f / D); float s2 = 0.f;
#pragma unroll
            for (int j = 0; j < 4; ++j) { v[j] = v[j] - mean; s2 += (v[j][0] * v[j][0] + v[j][1] * v[j][1]) + (v[j][2] * v[j][2] + v[j][3] * v[j][3]); }
            const float rstd = 1.0f / sqrtf(wave_sum_fast(s2) * (1.0f / D) + LN_EPS);
#pragma unroll
            for (int j = 0; j < 4; ++j) { v[j] = v[j] * rstd * g4[j] + b4[j];
                u32x2 o; o.x = cvt_pk_bf16(v[j][0], v[j][1]); o.y = cvt_pk_bf16(v[j][2], v[j][3]); *(u32x2*)(XBF + row * D + 4 * lane + 256 * j) = o;
                *(unsigned*)(XB8 + row * D + 4 * lane + 256 * j) = pk4_fp8(v[j][0] * 4.0f, v[j][1] * 4.0f, v[j][2] * 4.0f, v[j][3] * 4.0f); }
            f32x4 accv[8], wq[2][8];
#pragma unroll
            for (int k = 0; k < 8; ++k) { accv[k] = (f32x4){0.f, 0.f, 0.f, 0.f}; wq[0][k] = *(const LAS f32x4*)(WR + lane * 36 + 4 * k); }
#pragma unroll
            for (int ci = 0; ci < 16; ++ci) { const int j = ci >> 2, i = ci & 3;
                if (ci + 1 < 16) { const int jn = (ci + 1) >> 2, in = (ci + 1) & 3; const LAS float* wp = WR + (in * 256 + lane + 64 * jn) * 36;
#pragma unroll
                    for (int k = 0; k < 8; ++k) wq[(ci + 1) & 1][k] = *(const LAS f32x4*)(wp + 4 * k); }
                __builtin_amdgcn_sched_barrier(0);
                const float xv = v[j][i];
#pragma unroll
                for (int k = 0; k < 8; ++k) accv[k] += wq[ci & 1][k] * xv;
                __builtin_amdgcn_sched_barrier(0);
            }
            float acc[32];
#pragma unroll
            for (int e = 0; e < 32; ++e) acc[e] = accv[e >> 2][e & 3];
#define RED_LEVEL(o, n) { const bool up = (lane & (o)) != 0; _Pragma("unroll") for (int q = 0; q < (n); ++q) { const float send = up ? acc[q] : acc[q + (n)]; const float keep = up ? acc[q + (n)] : acc[q]; acc[q] = keep + shx(send, (o)); } }
#pragma unroll
            for (int q = 0; q < 16; ++q) { const auto pr = __builtin_amdgcn_permlane32_swap(__float_as_uint(acc[q]), __float_as_uint(acc[q + 16]), false, false); acc[q] = __uint_as_float(pr[0]) + __uint_as_float(pr[1]); }
#pragma unroll
            for (int q = 0; q < 8; ++q) { const auto pr = __builtin_amdgcn_permlane16_swap(__float_as_uint(acc[q]), __float_as_uint(acc[q + 8]), false, false); acc[q] = __uint_as_float(pr[0]) + __uint_as_float(pr[1]); }
            RED_LEVEL(8, 4) RED_LEVEL(4, 2) RED_LEVEL(2, 1)
#undef RED_LEVEL
            float lg = acc[0] + shx(acc[0], 1) + mybias;
            float tv[4]; int te[4];
#pragma unroll
            for (int k = 0; k < 4; ++k) {
                unsigned ub = __float_as_uint(lg); ub ^= (ub >> 31) ? 0xffffffffu : 0x80000000u;
                const unsigned mxk = wave_max_u(ub);
                const unsigned cand = (ub == mxk) ? (unsigned)(32 - myexp) : 0u;
                const int ewin = 32 - (int)wave_max_u(cand);
                unsigned mb = mxk; mb ^= (mb >> 31) ? 0x80000000u : 0xffffffffu;
                tv[k] = __uint_as_float(mb); te[k] = ewin;
                if (myexp == ewin) lg = -3.0e38f;
            }
            float gsum = 0.f, gk[4];
#pragma unroll
            for (int k = 0; k < 4; ++k) { gk[k] = __expf(tv[k] - tv[0]); gsum += gk[k]; }
            const float ginv = 1.0f / gsum;
            if (lane < 4 && publish) { int e = te[0]; float g = gk[0];
#pragma unroll
                for (int k = 1; k < 4; ++k) if (lane == k) { e = te[k]; g = gk[k]; }
                const unsigned pos = __hip_atomic_fetch_add(lcnt + e, 1u, __ATOMIC_RELAXED, __HIP_MEMORY_SCOPE_WORKGROUP);
                stash[(w * ROWS_IT + r) * 4 + lane] = ((unsigned)e << 24) | pos; stg[(w * ROWS_IT + r) * 4 + lane] = g * ginv; }
        }
        __syncthreads();
        if (tid < 32) lbase[tid] = __hip_atomic_fetch_add(F.ctl + CW_CNT + (layer * 32 + tid) * 16, lcnt[tid], __ATOMIC_RELAXED, __HIP_MEMORY_SCOPE_AGENT);
        __syncthreads();
        { const int rr = lane >> 2, k = lane & 3;
          const unsigned sv = stash[(w * ROWS_IT + rr) * 4 + k]; const int e = (int)(sv >> 24); const unsigned slot = lbase[e] + (sv & 0xffffffu);
          const size_t row = (size_t)row0 + rr;
          LIST[(size_t)e * 65536 + slot] = (unsigned)row; TOKSLOT[row * 4 + k] = ((unsigned)e << 20) | slot; TOKGATE[row * 4 + k] = stg[(w * ROWS_IT + rr) * 4 + k]; }
    }
    __syncthreads();
}

DI void combine_ln_phase(Ctx& F, int layer, float* outf) {
    build_mtab(F, layer);
    const LAS int* mtab = (const LAS int*)(F.lds + MTAB_OFF);
    const int lane = F.lane;
    const float* XA = (const float*)(F.ws + WS_XA);
    const unsigned char* Y = F.ws + WS_Y;
    bf16_t* XBF = (bf16_t*)(F.ws + WS_XBF);
    const unsigned* TOKSLOT = (const unsigned*)(F.ws + WS_TOKSLOT); const float* TOKGATE = (const float*)(F.ws + WS_TOKGATE);
    const float* gam = inp(F, I_LN2G) + layer * D; const float* bet = inp(F, I_LN2B) + layer * D;
    const int gw = F.bx * 8 + F.wave, NGW = F.G * 8;
    const bool perr = (PROBE_CHECK || PROBE_DSA) && layer == 1 && __hip_atomic_load(F.ctl + CW_ERR, __ATOMIC_RELAXED, __HIP_MEMORY_SCOPE_AGENT) != 0u;
    f32x4 g4[4], b4[4];
#pragma unroll
    for (int j = 0; j < 4; ++j) { g4[j] = *(const f32x4*)(gam + 4 * lane + 256 * j); b4[j] = *(const f32x4*)(bet + 4 * lane + 256 * j); }
#define CMB_ISSUE(xw_, yw_, ts_, r_) do { const unsigned tsv_[4] = {ts_.x, ts_.y, ts_.z, ts_.w}; \
        _Pragma("unroll") for (int j = 0; j < 4; ++j) xw_[j] = *(const u32x2*)(XBF + (size_t)(r_) * D + 4 * lane + 256 * j); \
        _Pragma("unroll") for (int k = 0; k < 4; ++k) { const int e_ = (int)(tsv_[k] >> 20), slot_ = (int)(tsv_[k] & 0xfffffu); const size_t yrow_ = (size_t)mtab[e_] * 256 + slot_; \
            _Pragma("unroll") for (int j = 0; j < 4; ++j) yw_[k][j] = *(const unsigned*)(Y + yrow_ * D + 4 * lane + 256 * j); } } while (0)
    u32x2 xwc[4]; unsigned ywc[4][4]; f32x4 tgc;
    u32x4 tsn; f32x4 tgn;
    { const int r0 = gw < T ? gw : 0; const u32x4 ts0 = *(const u32x4*)(TOKSLOT + (size_t)r0 * 4); tgc = *(const f32x4*)(TOKGATE + (size_t)r0 * 4);
      const int r1 = (gw + NGW < T) ? gw + NGW : r0; tsn = *(const u32x4*)(TOKSLOT + (size_t)r1 * 4); tgn = *(const f32x4*)(TOKGATE + (size_t)r1 * 4);
      CMB_ISSUE(xwc, ywc, ts0, r0); }
    for (int row = gw; row < T; row += NGW) {
        u32x2 xwn[4]; unsigned ywn[4][4]; const f32x4 tgn1 = tgn;
        { const int r1 = (row + NGW < T) ? row + NGW : row; CMB_ISSUE(xwn, ywn, tsn, r1);
          const int r2 = (row + 2 * NGW < T) ? row + 2 * NGW : row; tsn = *(const u32x4*)(TOKSLOT + (size_t)r2 * 4); tgn = *(const f32x4*)(TOKGATE + (size_t)r2 * 4); }
        __builtin_amdgcn_sched_barrier(0);
        f32x4 v[4];
#pragma unroll
        for (int j = 0; j < 4; ++j) v[j] = (f32x4){bflo(xwc[j].x), bfhi(xwc[j].x), bflo(xwc[j].y), bfhi(xwc[j].y)} * DN_ALPHA;
#pragma unroll
        for (int k = 0; k < 4; ++k) { const float g = tgc[k] * 0.0625f;
#pragma unroll
            for (int j = 0; j < 4; ++j) { const unsigned yw = ywc[k][j]; const f32x2 ya = __builtin_amdgcn_cvt_pk_f32_fp8((int)yw, false), yb = __builtin_amdgcn_cvt_pk_f32_fp8((int)yw, true);
                v[j][0] += g * ya[0]; v[j][1] += g * ya[1]; v[j][2] += g * yb[0]; v[j][3] += g * yb[1]; } }
        float s = 0.f;
#pragma unroll
        for (int j = 0; j < 4; ++j) s += (v[j][0] + v[j][1]) + (v[j][2] + v[j][3]);
        const float mean = wave_sum_fast(s) * (1.0f / D); float s2 = 0.f;
#pragma unroll
        for (int j = 0; j < 4; ++j) { v[j] = v[j] - mean; s2 += (v[j][0] * v[j][0] + v[j][1] * v[j][1]) + (v[j][2] * v[j][2] + v[j][3] * v[j][3]); }
        const float rstd = 1.0f / sqrtf(wave_sum_fast(s2) * (1.0f / D) + LN_EPS);
#pragma unroll
        for (int j = 0; j < 4; ++j) { const int c = 4 * lane + 256 * j; f32x4 y = v[j] * rstd * g4[j] + b4[j];
            if ((PROBE_CHECK || PROBE_DSA) && perr) y = (f32x4){__builtin_nanf(""), __builtin_nanf(""), __builtin_nanf(""), __builtin_nanf("")};
            if (layer == 1) *(f32x4*)(outf + (size_t)row * D + c) = y;
            if (layer == 0) { u32x2 o; o.x = cvt_pk_bf16(y[0], y[1]); o.y = cvt_pk_bf16(y[2], y[3]); *(u32x2*)(XBF + (size_t)row * D + c) = o; }
            if (layer == 0) *(unsigned*)(F.ws + WS_XB8 + (size_t)row * D + c) = pk4_fp8(y[0] * 4.0f, y[1] * 4.0f, y[2] * 4.0f, y[3] * 4.0f); }
        tgc = tgn1;
#pragma unroll
        for (int j = 0; j < 4; ++j) { xwc[j] = xwn[j];
#pragma unroll
            for (int k = 0; k < 4; ++k) ywc[k][j] = ywn[k][j]; }
    }
#undef CMB_ISSUE
}

DI void dsa_prep_phase(Ctx& F) {
    const bf16_t* PROJ = (const bf16_t*)(F.ws + WS_PROJ);
    bf16_t* CN = (bf16_t*)(F.ws + WS_CN); bf16_t* IKN = (bf16_t*)(F.ws + WS_IKN);
    const int sub = F.lane & 15, tq = F.lane >> 4;
    const int gw = F.bx * 8 + F.wave, NGW = F.G * 8;
    for (int t4 = gw; t4 < T / 4; t4 += NGW) {
        const size_t row = (size_t)t4 * 4 + tq;
        const u32x4 cv = *(const u32x4*)(PROJ + row * WINBP + B_C + sub * 8);
        const u32x2 kv = *(const u32x2*)(PROJ + row * WINBP + B_IK + sub * 4);
        float c[8] = {bflo(cv.x), bfhi(cv.x), bflo(cv.y), bfhi(cv.y), bflo(cv.z), bfhi(cv.z), bflo(cv.w), bfhi(cv.w)};
        float k[4] = {bflo(kv.x), bfhi(kv.x), bflo(kv.y), bfhi(kv.y)};
        float ss = 0.f, s1 = 0.f;
#pragma unroll
        for (int q = 0; q < 8; ++q) ss += c[q] * c[q];
#pragma unroll
        for (int q = 0; q < 4; ++q) s1 += k[q];
#pragma unroll
        for (int o = 1; o < 16; o <<= 1) { ss += shx(ss, o); s1 += shx(s1, o); }
        const float rr = 1.0f / sqrtf(ss * (1.0f / 128.0f) + 1e-6f); const float mean = s1 * (1.0f / 64.0f);
        float s2 = 0.f;
#pragma unroll
        for (int q = 0; q < 4; ++q) { k[q] -= mean; s2 += k[q] * k[q]; }
#pragma unroll
        for (int o = 1; o < 16; o <<= 1) s2 += shx(s2, o);
        const float rs = 1.0f / sqrtf(s2 * (1.0f / 64.0f) + LN_EPS);
        const float* g = inp(F, I_BKVG) + sub * 8; const float* ig = inp(F, I_BIDXG) + sub * 4; const float* ib = inp(F, I_BIDXB) + sub * 4;
        u32x4 co; co.x = cvt_pk_bf16(c[0] * rr * g[0], c[1] * rr * g[1]); co.y = cvt_pk_bf16(c[2] * rr * g[2], c[3] * rr * g[3]);
        co.z = cvt_pk_bf16(c[4] * rr * g[4], c[5] * rr * g[5]); co.w = cvt_pk_bf16(c[6] * rr * g[6], c[7] * rr * g[7]);
        *(u32x4*)(CN + row * 128 + sub * 8) = co;
        u32x2 ko; ko.x = cvt_pk_bf16(k[0] * rs * ig[0] + ib[0], k[1] * rs * ig[1] + ib[1]); ko.y = cvt_pk_bf16(k[2] * rs * ig[2] + ib[2], k[3] * rs * ig[3] + ib[3]);
        *(u32x2*)(IKN + row * 64 + sub * 4) = ko;
    }
}

DI int row_suffix_incl(int v) {
    v += __builtin_amdgcn_update_dpp(0, v, 0x101, 0xf, 0xf, true);
    v += __builtin_amdgcn_update_dpp(0, v, 0x102, 0xf, 0xf, true);
    v += __builtin_amdgcn_update_dpp(0, v, 0x104, 0xf, 0xf, true);
    v += __builtin_amdgcn_update_dpp(0, v, 0x108, 0xf, 0xf, true);
    return v;
}
DI unsigned wave_max_u(unsigned v) {
    int x = (int)v;
#define WMX_STEP(ctrl) { const unsigned o = (unsigned)__builtin_amdgcn_update_dpp(0, x, ctrl, 0xf, 0xf, true); x = (int)(((unsigned)x > o) ? (unsigned)x : o); }
    WMX_STEP(0x101) WMX_STEP(0x102) WMX_STEP(0x104) WMX_STEP(0x108)
#undef WMX_STEP
    const unsigned a = (unsigned)__builtin_amdgcn_readlane(x, 0), b = (unsigned)__builtin_amdgcn_readlane(x, 16), c = (unsigned)__builtin_amdgcn_readlane(x, 32), d = (unsigned)__builtin_amdgcn_readlane(x, 48);
    const unsigned ab = a > b ? a : b, cd = c > d ? c : d; return ab > cd ? ab : cd;
}
DI unsigned lowmask(int k) { return k >= 32 ? 0xffffffffu : ((1u << k) - 1u); }
DI void select_top256_x2(LAS unsigned* cand0, LAS unsigned* cand1, LAS unsigned* cnt0, LAS unsigned* cnt1, LAS unsigned* thr0, LAS unsigned* thr1, bool two, LAS unsigned* hist, int lane) {
    LAS unsigned* cand[2] = {cand0, cand1};
    int n[2]; n[0] = (int)*cnt0; n[1] = two ? (int)*cnt1 : 0;
    unsigned x[2][8];
#pragma unroll
    for (int q = 0; q < 2; ++q)
#pragma unroll
        for (int i = 0; i < 8; ++i) x[q][i] = (lane + 64 * i < n[q]) ? cand[q][lane + 64 * i] : 0u;
    unsigned prefix[2]; int fl[2], need[2] = {256, 256};
#pragma unroll
    for (int q = 0; q < 2; ++q) { unsigned m1 = 0u, m2 = 0u;
#pragma unroll
        for (int i = 0; i < 8; ++i) { m1 = x[q][i] > m1 ? x[q][i] : m1; const unsigned c = x[q][i] ? ~x[q][i] : 0u; m2 = c > m2 ? c : m2; }
        const unsigned mx = wave_max_u(m1), mn = ~wave_max_u(m2);
        const unsigned diff = (mx ^ mn) | 1u; fl[q] = 32 - __builtin_clz(diff); prefix[q] = mx & ~lowmask(fl[q]); }
    const int row = lane >> 4;
    for (int guard = 0; guard < 5 && (fl[0] > 0 || fl[1] > 0); ++guard) {
        int sh[2]; unsigned dm[2], pm[2];
#pragma unroll
        for (int q = 0; q < 2; ++q) { sh[q] = fl[q] > 8 ? fl[q] - 8 : 0; dm[q] = (1u << (fl[q] - sh[q])) - 1u; pm[q] = ~lowmask(fl[q]); }
        { const u32x4 z4 = zero4_local();
#pragma unroll
        for (int q = 0; q < 2; ++q) *(LAS u32x4*)(hist + q * 256 + 4 * lane) = z4; }
        LDS_WAIT();
#pragma unroll
        for (int q = 0; q < 2; ++q)
#pragma unroll
            for (int i = 0; i < 8; ++i) if (x[q][i] != 0u && (x[q][i] & pm[q]) == prefix[q]) __hip_atomic_fetch_add(hist + q * 256 + ((x[q][i] >> sh[q]) & dm[q]), 1u, __ATOMIC_RELAXED, __HIP_MEMORY_SCOPE_WORKGROUP);
        LDS_WAIT();
        u32x4 h4[2]; int sl[2], incl[2];
#pragma unroll
        for (int q = 0; q < 2; ++q) h4[q] = *(const LAS u32x4*)(hist + q * 256 + 4 * lane);
#pragma unroll
        for (int q = 0; q < 2; ++q) { sl[q] = (int)(h4[q].x + h4[q].y + h4[q].z + h4[q].w); const int v = row_suffix_incl(sl[q]);
            const int t1 = __builtin_amdgcn_readlane(v, 16), t2 = __builtin_amdgcn_readlane(v, 32), t3 = __builtin_amdgcn_readlane(v, 48);
            incl[q] = v + (row == 0 ? t1 + t2 + t3 : row == 1 ? t2 + t3 : row == 2 ? t3 : 0); }
#pragma unroll
        for (int q = 0; q < 2; ++q) {
            const unsigned long long bal = __ballot(incl[q] >= need[q]);
            const int L = bal ? 63 - __builtin_clzll(bal) : 0;
            int above = __builtin_amdgcn_readlane(incl[q], L) - __builtin_amdgcn_readlane(sl[q], L);
            const int c3 = __builtin_amdgcn_readlane((int)h4[q].w, L), c2 = __builtin_amdgcn_readlane((int)h4[q].z, L), c1 = __builtin_amdgcn_readlane((int)h4[q].y, L);
            int b = 3;
            if (above + c3 < need[q]) { above += c3; b = 2; if (above + c2 < need[q]) { above += c2; b = 1; if (above + c1 < need[q]) { above += c1; b = 0; } } }
            if (fl[q] > 0) { need[q] -= above; prefix[q] |= (unsigned)(4 * L + b) << sh[q]; fl[q] = sh[q]; }
        }
    }
    const unsigned long long lt = (1ull << lane) - 1ull;
#pragma unroll
    for (int q = 0; q < 2; ++q) {
        if (q == 1 && !two) break;
        int base = 0;
#pragma unroll
        for (int i = 0; i < 8; ++i) { const bool keep = x[q][i] >= prefix[q]; const unsigned long long m = __ballot(keep);
            if (keep) cand[q][base + __builtin_popcountll(m & lt)] = x[q][i];
            base += __builtin_popcountll(m); }
    }
    if (lane == 0) { *cnt0 = 256u; *thr0 = prefix[0]; if (two) { *cnt1 = 256u; *thr1 = prefix[1]; } }
}

DI int idx_bin(float sv) { const unsigned bits = __float_as_uint(sv); const int lin = (int)((bits >> 18) & 0x1fffu);
    if (bits >> 31) { int t = lin - (127 - 13) * 32; t = t < 0 ? 0 : (t > 511 ? 511 : t); return 511 - t; }
    int t = lin - (127 - 9) * 32; t = t < 0 ? 0 : (t > 511 ? 511 : t); return 512 + t; }
DI unsigned idx_bin_lowkey(int tb) {
    if (tb >= 512) { const unsigned lin = (unsigned)(tb - 512 + (127 - 9) * 32); return tb == 512 ? 0x80000000u : (0x80000000u | (lin << 18)); }
    const unsigned lin = (unsigned)((511 - tb) + (127 - 13) * 32);
    const unsigned bits_hi = 0x80000000u | (lin << 18) | 0x3ffffu;
    return (~bits_hi) & 0xffffe000u; }
template <int MODE>
DI void idx_pass(LAS unsigned* BUF, LAS unsigned* CNT, LAS unsigned* ZH, const bf16_t* IKN, size_t rowb, const bf16x8 (&qf)[4][2], const float (&iw)[4], int nsteps, int half, int qloc, int qpos, unsigned thr, int fr, int fq, int sstride = 1) {
    asm volatile("" : "+v"(fr), "+v"(fq), "+v"(qloc), "+v"(qpos));
    const bf16_t* kp = IKN + (rowb + half * 64 + fr) * 64 + fq * 8;
    bf16x8 kf[2][2];
#pragma unroll
    for (int tl = 0; tl < 2; ++tl)
#pragma unroll
        for (int ks = 0; ks < 2; ++ks) kf[tl][ks] = *(const bf16x8*)(kp + (16 * tl) * 64 + ks * 32);
    const int nh = 2 * nsteps;
#pragma clang loop unroll(disable)
    for (int hs = 0; hs < nh; hs += sstride) {
        const int kb = (hs >> 1) * 128 + half * 64 + (hs & 1) * 32;
        bf16x8 kn[2][2];
        { const int hn = (hs + sstride < nh) ? hs + sstride : hs; const int kbn = (hn >> 1) * 128 + (hn & 1) * 32;
#pragma unroll
          for (int tl = 0; tl < 2; ++tl)
#pragma unroll
            for (int ks = 0; ks < 2; ++ks) kn[tl][ks] = *(const bf16x8*)(kp + (size_t)(kbn + 16 * tl) * 64 + ks * 32); }
        __builtin_amdgcn_sched_barrier(0);
        unsigned ckv[8]; int nacc = 0;
#pragma unroll
        for (int tl = 0; tl < 2; ++tl) {
            f32x4 sc = (f32x4){0.f, 0.f, 0.f, 0.f};
#pragma unroll
            for (int h = 0; h < 4; ++h) { f32x4 a = (f32x4){0.f, 0.f, 0.f, 0.f}; a = MFMA16(kf[tl][0], qf[h][0], a); a = MFMA16(kf[tl][1], qf[h][1], a);
#pragma unroll
                for (int i = 0; i < 4; ++i) sc[i] += __builtin_amdgcn_fmed3f(a[i], 0.f, 3.0e38f) * iw[h]; }
#pragma unroll
            for (int i = 0; i < 4; ++i) {
                const int key = kb + 16 * tl + 4 * fq + i;
                const float sv = sc[i] + 0.0f;
                unsigned ub = __float_as_uint(sv); ub ^= (ub >> 31) ? 0xffffffffu : 0x80000000u;
                if (MODE == 1 || (MODE == 4 && (i & 1) == 0)) {
                    const int bin = idx_bin(sv);
                    if (key <= qpos) { __hip_atomic_fetch_add(BUF + qloc * 512 + (bin >> 1), 1u << ((bin & 1) << 4), __ATOMIC_RELAXED, __HIP_MEMORY_SCOPE_WORKGROUP);
                        if (sv == 0.0f) __hip_atomic_fetch_add(ZH + qloc * 32 + (key >> 8), 1u << (((key >> 7) & 1) << 4), __ATOMIC_RELAXED, __HIP_MEMORY_SCOPE_WORKGROUP); }
                } else if (MODE == 3) {
                    nacc += idx_bin(sv) + (int)(ub >> 20);
                } else {
                    const unsigned ck = (ub & 0xffffe000u) | (unsigned)(8191 - key);
                    const bool acc = (key <= qpos) && (ck > thr);
                    ckv[tl * 4 + i] = acc ? ck : 0u; nacc += acc ? 1 : 0;
                }
            }
        }
        if (MODE == 3) asm volatile("" :: "v"(nacc));
        if (MODE == 2) {
            if (__ballot(nacc > 0)) {
                unsigned pos = __hip_atomic_fetch_add(CNT + qloc, (unsigned)nacc, __ATOMIC_RELAXED, __HIP_MEMORY_SCOPE_WORKGROUP);
#pragma unroll
                for (int j = 0; j < 8; ++j) if (ckv[j] != 0u) { if (pos < 512u) BUF[qloc * 512 + pos] = ckv[j]; ++pos; }
            }
        }
#pragma unroll
        for (int tl = 0; tl < 2; ++tl)
#pragma unroll
            for (int ks = 0; ks < 2; ++ks) kf[tl][ks] = kn[tl][ks];
    }
}
DI unsigned idx_threshold(const LAS unsigned* hist, const LAS unsigned* zh, int lane, int& n_ge, const int rank = 256) {
    const u32x4 wa = *(const LAS u32x4*)(hist + 8 * lane), wb = *(const LAS u32x4*)(hist + 8 * lane + 4);
    const unsigned wd[8] = {wa.x, wa.y, wa.z, wa.w, wb.x, wb.y, wb.z, wb.w};
    int sl = 0;
#pragma unroll
    for (int q = 0; q < 8; ++q) sl += (int)(wd[q] & 0xffffu) + (int)(wd[q] >> 16);
    const int v = row_suffix_incl(sl);
    const int t1 = __builtin_amdgcn_readlane(v, 16), t2 = __builtin_amdgcn_readlane(v, 32), t3 = __builtin_amdgcn_readlane(v, 48);
    const int row = lane >> 4;
    const int incl = v + (row == 0 ? t1 + t2 + t3 : row == 1 ? t2 + t3 : row == 2 ? t3 : 0);
    const unsigned long long bal = __ballot(incl >= rank);
    if (bal == 0ull) { n_ge = __builtin_amdgcn_readlane(incl, 0); return 0u; }
    const int L = 63 - __builtin_clzll(bal);
    int above = __builtin_amdgcn_readlane(incl, L) - __builtin_amdgcn_readlane(sl, L);
    int tb = 16 * L; int cnt_tb = 0; bool found = false;
#pragma unroll
    for (int q = 7; q >= 0; --q) {
        const unsigned wq = (unsigned)__builtin_amdgcn_readlane((int)wd[q], L);
        const int chi = (int)(wq >> 16), clo = (int)(wq & 0xffffu);
        if (!found) { if (above + chi >= rank) { tb = 16 * L + 2 * q + 1; cnt_tb = chi; found = true; } else above += chi; }
        if (!found) { if (above + clo >= rank) { tb = 16 * L + 2 * q; cnt_tb = clo; found = true; } else above += clo; }
    }
    n_ge = above + cnt_tb;
    if (tb == 512 && n_ge > rank + rank / 12) {
        const unsigned zw = (lane < 32) ? zh[lane] : 0u; const int z0 = (int)(zw & 0xffffu), z1 = (int)(zw >> 16);
        int incl2 = z0 + z1;
#pragma unroll
        for (int o = 1; o < 32; o <<= 1) { const int u = shup_i(incl2, o); if (lane >= o) incl2 += u; }
        const int needz = rank - above;
        const unsigned long long b2 = __ballot(lane < 32 && incl2 >= needz);
        int cut = 8192;
        if (b2) { const int L2 = __builtin_ctzll(b2); const int before = __builtin_amdgcn_readlane(incl2, L2) - __builtin_amdgcn_readlane(z0 + z1, L2);
            const int zz0 = __builtin_amdgcn_readlane(z0, L2); cut = (before + zz0 >= needz) ? 128 * (2 * L2 + 1) : 128 * (2 * L2 + 2); }
        const int totz = __builtin_amdgcn_readlane(incl2, 31);
        n_ge = above + (cnt_tb - totz) + ((needz + 127 < totz) ? needz + 127 : totz);
        return cut >= 8192 ? 0x7fffffffu : (0x80000000u | (unsigned)(8191 - cut));
    }
    return tb > 0 ? idx_bin_lowkey(tb) - 1u : 0u;
}
DI unsigned ref_threshold(const LAS unsigned* cand, int n, int lane) {
    unsigned x[8];
#pragma unroll
    for (int i = 0; i < 8; ++i) x[i] = (lane + 64 * i < n) ? cand[lane + 64 * i] : 0u;
    unsigned prefix = 0u;
    for (int bit = 31; bit >= 0; --bit) { const unsigned c = prefix | (1u << bit); int tot = 0;
#pragma unroll
        for (int i = 0; i < 8; ++i) tot += __builtin_popcountll(__ballot(x[i] >= c));
        if (tot >= 256) prefix = c; }
    return prefix;
}
template <int IMODE> DI void indexer_phase(Ctx& F) {
    LAS unsigned* CAND = (LAS unsigned*)F.lds;
    LAS unsigned* CNT = (LAS unsigned*)(F.lds + 131072);
    LAS unsigned* THR = (LAS unsigned*)(F.lds + 131072 + 256);
    LAS unsigned* WL = (LAS unsigned*)(F.lds + 131072 + 512 + 16384);
    LAS unsigned* WLN = WL + 64; LAS unsigned* WLH = WL + 65;
    const int tid = F.tid, lane = F.lane, w = F.wave, fr = lane & 15, fq = lane >> 4;
    const bf16_t* PROJ = (const bf16_t*)(F.ws + WS_PROJ);
    const bf16_t* IKN = (const bf16_t*)(F.ws + WS_IKN);
    unsigned short* IDX = (unsigned short*)(F.ws + WS_IDX);
    const int qg = w & 3, half = w >> 2;
    LAS unsigned* UQ = WL + 68;
    for (;;) {
        __syncthreads();
        if (tid == 0) { unsigned res = 0xffffffffu;
#pragma clang loop unroll(disable)
            for (int k = 0; k < 8; ++k) { const unsigned q = (unsigned)(F.bx + k) & 7u; const unsigned v = __hip_atomic_fetch_add(F.ctl + CW_IQ + (IMODE * 8 + (int)q) * 16, 1u, __ATOMIC_RELAXED, __HIP_MEMORY_SCOPE_AGENT); if (v < 128u) { res = q * 128u + v; break; } }
            *UQ = res; }
        __syncthreads();
        const unsigned uq = *UQ;
        if (uq == 0xffffffffu) break;
        const int b = __builtin_amdgcn_readfirstlane((int)(uq >> 7)), qb = 127 - __builtin_amdgcn_readfirstlane((int)(uq & 127u));
        const int q0 = qb * 64;
        const size_t rowb = (size_t)b * SEQ;
        constexpr int pm = IMODE;
        unsigned short* IDXO = pm ? IDX : (unsigned short*)(F.ws + WS_QLAT);
        __syncthreads();
        if (tid < 64) { CNT[tid] = 0u; THR[tid] = 0u; }
        const int qloc = 16 * qg + fr, qpos = q0 + qloc;
        bf16x8 qf[4][2]; float iw[4];
#pragma unroll
        for (int h = 0; h < 4; ++h) {
#pragma unroll
            for (int ks = 0; ks < 2; ++ks) qf[h][ks] = *(const bf16x8*)(PROJ + (rowb + qpos) * WINBP + B_IQ + h * 64 + ks * 32 + fq * 8);
            iw[h] = bf2f(PROJ[(rowb + qpos) * WINBP + B_IW + h]) * 0.0625f;
        }
        __syncthreads();
        const int nsteps = (q0 + 64 + 127) / 128;
        LAS unsigned* FLG = WL + 66;
        LAS unsigned* ZH = WL + 256;
        bool fast = false;
        if (nsteps >= 6 && pm == 1) {
            { const u32x4 z4 = zero4_local(); for (int u = tid; u < 64 * 512 / 4; u += 512) *(LAS u32x4*)(CAND + 4 * u) = z4; *(LAS u32x4*)(ZH + 4 * tid) = z4; }
            if (tid == 0) *FLG = 0u;
            __syncthreads();
            const bool sampled = nsteps >= 16;
            if (sampled) idx_pass<4>(CAND, CNT, ZH, IKN, rowb, qf, iw, nsteps, half, qloc, qpos, 0u, fr, fq); else idx_pass<1>(CAND, CNT, ZH, IKN, rowb, qf, iw, nsteps, half, qloc, qpos, 0u, fr, fq);
#if PROBE_PASS3
            idx_pass<3>(CAND, CNT, ZH, IKN, rowb, qf, iw, nsteps, half, qloc, qpos, 0u, fr, fq); idx_pass<3>(CAND, CNT, ZH, IKN, rowb, qf, iw, nsteps, half, qloc, qpos, 0u, fr, fq);
#endif
            __syncthreads();
#pragma clang loop unroll(disable)
            for (int qq = 0; qq < 8; ++qq) { int nge; const unsigned t = sampled ? idx_threshold(CAND + (w * 8 + qq) * 512, ZH + (w * 8 + qq) * 32, lane, nge, 184) : idx_threshold(CAND + (w * 8 + qq) * 512, ZH + (w * 8 + qq) * 32, lane, nge, 256);
                if (!sampled && nge > 512 && lane == 0) *FLG = 1u;
                if (lane == 0) { THR[w * 8 + qq] = t; CNT[w * 8 + qq] = 0u; } }
            __syncthreads();
            fast = (*FLG == 0u);
            if (fast) {
                if (tid == 0) { *WLN = 0u; *WLH = 0u; }
                __syncthreads();
                idx_pass<2>(CAND, CNT, ZH, IKN, rowb, qf, iw, nsteps, half, qloc, qpos, THR[qloc], fr, fq);
                __syncthreads();
                LAS unsigned* RTY = WL + 67;
                LAS unsigned* THR2 = WL + 128;
                if (tid == 0) *RTY = 0u;
                if (tid < 64) THR2[tid] = 0xffffffffu;
                __syncthreads();
                if (sampled && lane < 8) { const int ql = w * 8 + lane; const unsigned n = CNT[ql];
                    if (n < 256u) *FLG = 1u;
                    else if (n > 512u && PROBE_NORETRY) *FLG = 1u;
                    else if (n > 512u) { *RTY = 1u; CNT[ql] = 512u; THR2[ql] = 0xfffffffeu; const unsigned p = __hip_atomic_fetch_add(WLN, 1u, __ATOMIC_RELAXED, __HIP_MEMORY_SCOPE_WORKGROUP); if (p < 64u) WL[p] = (unsigned)ql; } }
                __syncthreads();
                if (*FLG == 0u && *RTY != 0u) {
                    const int totr = (int)*WLN;
                    LAS unsigned* hist = (LAS unsigned*)(F.lds + 131072 + 512) + w * 512;
                    for (int guard = 0; guard < 40; ++guard) {
                        int idx = 0; if (lane == 0) idx = (int)__hip_atomic_fetch_add(WLH, 2u, __ATOMIC_RELAXED, __HIP_MEMORY_SCOPE_WORKGROUP);
                        idx = __builtin_amdgcn_readfirstlane(idx);
                        if ((unsigned)idx >= (unsigned)totr) break;
                        const bool two = idx + 1 < totr; const int qla = (int)WL[idx], qlb = two ? (int)WL[idx + 1] : qla;
                        select_top256_x2(CAND + qla * 512, CAND + qlb * 512, CNT + qla, CNT + qlb, THR + qla, THR + qlb, two, hist, lane);
                        LDS_WAIT();
                        if (lane == 0) { THR2[qla] = THR[qla]; CNT[qla] = 0u; if (two) { THR2[qlb] = THR[qlb]; CNT[qlb] = 0u; } }
                    }
                    __syncthreads();
                    if (__ballot(THR2[qloc] != 0xffffffffu) != 0ull)
                        idx_pass<2>(CAND, CNT, ZH, IKN, rowb, qf, iw, nsteps, half, qloc, qpos, THR2[qloc], fr, fq);
                    __syncthreads();
                    if (lane < 8) { const int ql = w * 8 + lane; const unsigned n = CNT[ql]; if (n < 256u || n > 512u || THR2[ql] == 0xfffffffeu) *FLG = 1u; }
                }
                __syncthreads();
                if (tid == 0) { *WLN = 0u; *WLH = 0u; }
                __syncthreads();
                fast = (*FLG == 0u);
                if (lane < 8 && fast) { const int ql = w * 8 + lane; if (CNT[ql] > 256u) { const unsigned p = __hip_atomic_fetch_add(WLN, 1u, __ATOMIC_RELAXED, __HIP_MEMORY_SCOPE_WORKGROUP); WL[p] = (unsigned)ql; } }
                __syncthreads();
                const int total = (int)*WLN;
                LAS unsigned* hist = (LAS unsigned*)(F.lds + 131072 + 512) + w * 512;
                for (int guard = 0; guard < 40; ++guard) {
                    int idx = 0; if (lane == 0) idx = (int)__hip_atomic_fetch_add(WLH, 2u, __ATOMIC_RELAXED, __HIP_MEMORY_SCOPE_WORKGROUP);
                    idx = __builtin_amdgcn_readfirstlane(idx);
                    if ((unsigned)idx >= (unsigned)total) break;
                    const bool two = idx + 1 < total; const int qla = (int)WL[idx], qlb = two ? (int)WL[idx + 1] : qla;
                    select_top256_x2(CAND + qla * 512, CAND + qlb * 512, CNT + qla, CNT + qlb, THR + qla, THR + qlb, two, hist, lane);
                    LDS_WAIT();
                }
                __syncthreads();
            }
        }
        if (!fast) { __syncthreads(); if (tid < 64) { CNT[tid] = 0u; THR[tid] = 0u; } __syncthreads(); }
        int lane_s = lane; asm volatile("" : "+v"(lane_s));
        { const int fr = lane_s & 15, fq = lane_s >> 4, qloc = 16 * qg + fr, qpos = q0 + qloc;
        bf16x8 kf[4][2];
#pragma unroll
        for (int tl = 0; tl < 4; ++tl)
#pragma unroll
            for (int ks = 0; ks < 2; ++ks) kf[tl][ks] = *(const bf16x8*)(IKN + (rowb + half * 64 + 16 * tl + fr) * 64 + ks * 32 + fq * 8);
#pragma clang loop unroll(disable)
        for (int st = 0; st < (fast ? 0 : nsteps); ++st) {
            const int kb = st * 128 + half * 64;
            const unsigned thr = THR[qloc];
            if (tid == 0) { *WLN = 0u; *WLH = 0u; }
            bf16x8 kn[4][2];
            { const int kbn = (st + 1 < nsteps) ? kb + 128 : kb;
#pragma unroll
              for (int tl = 0; tl < 4; ++tl)
#pragma unroll
                for (int ks = 0; ks < 2; ++ks) kn[tl][ks] = *(const bf16x8*)(IKN + (rowb + kbn + 16 * tl + fr) * 64 + ks * 32 + fq * 8); }
            unsigned ckv[16]; int nacc = 0;
#pragma unroll
            for (int tl = 0; tl < 4; ++tl) {
                f32x4 sc = (f32x4){0.f, 0.f, 0.f, 0.f};
#pragma unroll
                for (int h = 0; h < 4; ++h) { f32x4 a = (f32x4){0.f, 0.f, 0.f, 0.f}; a = MFMA16(kf[tl][0], qf[h][0], a); a = MFMA16(kf[tl][1], qf[h][1], a);
#pragma unroll
                    for (int i = 0; i < 4; ++i) sc[i] += __builtin_amdgcn_fmed3f(a[i], 0.f, 3.0e38f) * iw[h]; }
#pragma unroll
                for (int i = 0; i < 4; ++i) {
                    const int key = kb + 16 * tl + 4 * fq + i;
                    const float sv = sc[i] + 0.0f;
                    unsigned ub = __float_as_uint(sv); ub ^= (ub >> 31) ? 0xffffffffu : 0x80000000u;
                    const unsigned ck = (ub & 0xffffe000u) | (unsigned)(8191 - key);
                    const bool acc = (key <= qpos) && (ck > thr);
                    ckv[tl * 4 + i] = acc ? ck : 0u; nacc += acc ? 1 : 0;
                }
            }
            if (__ballot(nacc > 0)) {
                unsigned pos = __hip_atomic_fetch_add(CNT + qloc, (unsigned)nacc, __ATOMIC_RELAXED, __HIP_MEMORY_SCOPE_WORKGROUP);
#pragma unroll
                for (int j = 0; j < 16; ++j) if (ckv[j] != 0u) { if (pos < 512u) CAND[qloc * 512 + pos] = ckv[j]; ++pos; }
            }
#pragma unroll
            for (int tl = 0; tl < 4; ++tl)
#pragma unroll
                for (int ks = 0; ks < 2; ++ks) kf[tl][ks] = kn[tl][ks];
            __syncthreads();
            const bool lastst = (st == nsteps - 1);
            {
                if (lane < 8) { const int ql = w * 8 + lane; const unsigned n = CNT[ql];
                    if (n >= 384u || (lastst && n > 256u)) { const unsigned p = __hip_atomic_fetch_add(WLN, 1u, __ATOMIC_RELAXED, __HIP_MEMORY_SCOPE_WORKGROUP); WL[p] = (unsigned)ql; } }
                __syncthreads();
                const int total = (int)*WLN;
                LAS unsigned* hist = (LAS unsigned*)(F.lds + 131072 + 512) + w * 512;
                for (int guard = 0; guard < 40; ++guard) {
                    int idx = 0; if (lane == 0) idx = (int)__hip_atomic_fetch_add(WLH, 2u, __ATOMIC_RELAXED, __HIP_MEMORY_SCOPE_WORKGROUP);
                    idx = __builtin_amdgcn_readfirstlane(idx);
                    if ((unsigned)idx >= (unsigned)total) break;
                    const bool two = idx + 1 < total; const int qla = (int)WL[idx], qlb = two ? (int)WL[idx + 1] : qla;
#if PROBE_SEL
                    const unsigned ra = ref_threshold(CAND + qla * 512, (int)CNT[qla], lane), rb = ref_threshold(CAND + qlb * 512, (int)CNT[qlb], lane);
#endif
                    select_top256_x2(CAND + qla * 512, CAND + qlb * 512, CNT + qla, CNT + qlb, THR + qla, THR + qlb, two, hist, lane);
                    LDS_WAIT();
#if PROBE_SEL
                    if (THR[qla] != ra || (two && THR[qlb] != rb) || CNT[qla] != 256u) { if (lane == 0) __hip_atomic_store(F.ctl + CW_ERR, 1u, __ATOMIC_RELAXED, __HIP_MEMORY_SCOPE_AGENT); }
#endif
                }
            }
            __syncthreads();
        }
        }
        LAS unsigned* bm = (LAS unsigned*)(F.lds + 131072 + 512) + w * 512;
#pragma clang loop unroll(disable)
        for (int qq = 0; qq < 8; ++qq) { const int ql = w * 8 + qq; const int n = (int)CNT[ql];
            unsigned short* dst = IDXO + (rowb + q0 + ql) * 256;
#pragma unroll
            for (int i = 0; i < 4; ++i) bm[lane + 64 * i] = 0u;
#pragma unroll
            for (int i = 0; i < 4; ++i) { const int p = lane + 64 * i; if (p < n) { const unsigned key = 8191u - (CAND[ql * 512 + p] & 0x1fffu); __hip_atomic_fetch_or(bm + (key >> 5), 1u << (key & 31u), __ATOMIC_RELAXED, __HIP_MEMORY_SCOPE_WORKGROUP); } }
            LDS_WAIT();
            const u32x4 wv = *(const LAS u32x4*)(bm + 4 * lane);
            unsigned wd[4] = {wv.x, wv.y, wv.z, wv.w};
            const int cmine = __builtin_popcount(wd[0]) + __builtin_popcount(wd[1]) + __builtin_popcount(wd[2]) + __builtin_popcount(wd[3]);
            int incl = cmine;
#pragma unroll
            for (int o = 1; o < 64; o <<= 1) { const int v = shup_i(incl, o); if (lane >= o) incl += v; }
            int pos = incl - cmine;
#pragma unroll
            for (int jw = 0; jw < 4; ++jw) { unsigned word = wd[jw]; while (word) { const int bpos = __builtin_ctz(word); dst[pos++] = (unsigned short)((4 * lane + jw) * 32 + bpos); word &= word - 1u; } }
#pragma unroll
            for (int i = 0; i < 4; ++i) { const int p = lane + 64 * i; if (p >= n) dst[p] = (unsigned short)0xffffu; }
            LDS_WAIT();
        }
    }
    __syncthreads();
}
DI void idx_compare(Ctx& F) {
    const unsigned* a = (const unsigned*)(F.ws + WS_IDX); const unsigned* b = (const unsigned*)(F.ws + WS_QLAT); bool bad = false;
    for (size_t i = (size_t)F.bx * 512 + F.tid; i < (size_t)T * 128; i += (size_t)F.G * 512) bad |= a[i] != b[i];
    if (__ballot(bad)) { if (F.lane == 0) __hip_atomic_store(F.ctl + CW_ERR, 1u, __ATOMIC_RELAXED, __HIP_MEMORY_SCOPE_AGENT); }
}

DI int rotl4(int k) { return ((k << 1) & 15) | ((k >> 3) & 1); }
DI void dsa_attn_phase(Ctx& F) {
    const int tid = F.tid, lane = F.lane, w = F.wave, fr = lane & 15, fq = lane >> 4;
    LAS unsigned char* wl = F.lds + w * 17408;
    LAS unsigned short* IDL = (LAS unsigned short*)(wl + 16384);
    LAS unsigned char* BKL = wl + 16384 + 512;
    LAS float* RB = (LAS float*)(F.lds + 8 * 17408);
    LAS unsigned char* TBL = (LAS unsigned char*)(F.lds + 8 * 17408 + 1600);
    const bf16_t* PROJ = (const bf16_t*)(F.ws + WS_PROJ);
    const bf16_t* CN = (const bf16_t*)(F.ws + WS_CN);
    const unsigned short* IDX = (const unsigned short*)(F.ws + WS_IDX);
    const bf16_t* WUK = (const bf16_t*)(F.ws + WS_WUK); const bf16_t* WUVT = (const bf16_t*)(F.ws + WS_WUVT);
    bf16_t* QLAT = (bf16_t*)(F.ws + WS_QLAT); bf16_t* OLAT = (bf16_t*)(F.ws + WS_OLAT); bf16_t* MIX = (bf16_t*)(F.ws + WS_MIX);
    __syncthreads();
    if (tid < 384) RB[tid] = inp(F, I_RELB)[tid]; else if (tid < 396) RB[tid] = -1.0e30f;
    if (tid < 128) { int bk = tid; if (tid >= 16) { bk = 16 + (int)(logf((float)tid * (1.0f / 16.0f)) / logf(8.0f) * 16.0f); bk = bk > 31 ? 31 : bk; } TBL[tid] = (unsigned char)bk; }
    __syncthreads();
    for (int it = 0; (it + 1) * ((F.G >> 3) * 8) <= SEQ / 16; ++it) {
        const int tb = (F.bx & 7) * (SEQ / 16) + it * ((F.G >> 3) * 8) + (F.bx >> 3) * 8 + w;
        const size_t t0 = (size_t)tb * 16;
        const int b = (int)(t0 / SEQ);
        for (int h = 0; h < 12; ++h) {
            bf16x8 qf[2];
#pragma unroll
            for (int ks = 0; ks < 2; ++ks) qf[ks] = *(const bf16x8*)(PROJ + (t0 + fr) * WINBP + h * 64 + ks * 32 + fq * 8);
#pragma unroll
            for (int rt = 0; rt < 8; ++rt) { f32x4 a = (f32x4){0.f, 0.f, 0.f, 0.f};
#pragma unroll
                for (int ks = 0; ks < 2; ++ks) { const bf16x8 wf = *(const bf16x8*)(WUK + ((size_t)h * 128 + 16 * rt + fr) * 64 + ks * 32 + fq * 8); a = MFMA16(wf, qf[ks], a); }
                u32x2 o; o.x = cvt_pk_bf16(a[0] * 0.125f, a[1] * 0.125f); o.y = cvt_pk_bf16(a[2] * 0.125f, a[3] * 0.125f);
                *(u32x2*)(QLAT + ((t0 + fr) * 12 + h) * 128 + 16 * rt + 4 * fq) = o; }
        }
        VM_WAIT();
        for (int qi = 0; qi < 16; ++qi) {
            const size_t t = t0 + qi; const int pos = (int)(t % SEQ);
            LDS_WAIT();
            { const u32x2 iw2 = *(const u32x2*)(IDX + t * 256 + 4 * lane);
              const unsigned idv[4] = {iw2.x & 0xffffu, iw2.x >> 16, iw2.y & 0xffffu, iw2.y >> 16}; unsigned pk = 0u;
#pragma unroll
              for (int i = 0; i < 4; ++i) IDL[32 * (lane >> 3) + 8 * i + (lane & 7)] = (unsigned short)idv[i];
#pragma unroll
              for (int i = 0; i < 4; ++i) { const int rel = pos - (int)idv[i]; const bool ok = (idv[i] != 0xffffu) && rel >= 0; const int ti = rel < 0 ? 0 : (rel > 127 ? 127 : rel);
                  const unsigned tb = TBL[ti]; const unsigned bk = !ok ? 32u : (rel > 127 ? 31u : tb); pk |= bk << (8 * i); }
              *(LAS unsigned*)(BKL + 4 * lane) = pk; }
            bf16x8 ql[4];
#pragma unroll
            for (int ks = 0; ks < 4; ++ks) { u32x4 v = (u32x4){0u, 0u, 0u, 0u}; if (fr < 12) v = *(const u32x4*)(QLAT + (t * 12 + fr) * 128 + ks * 32 + fq * 8); ql[ks] = __builtin_bit_cast(bf16x8, v); }
            VM_WAIT(); LDS_WAIT();
            const bf16_t* cb = CN + (size_t)b * SEQ * 128;
#define DSA_ISSUE(c_) do { LAS unsigned char* buf_ = wl + ((c_) & 1) * 8192; const u32x4 iv_ = *(const LAS u32x4*)(IDL + 32 * (c_) + 8 * (lane >> 4)); const unsigned ivw_[4] = {iv_.x, iv_.y, iv_.z, iv_.w}; \
            _Pragma("unroll") for (int i_ = 0; i_ < 8; ++i_) { const int kk_ = 4 * i_ + (lane >> 4); \
                const int id_ = (int)((ivw_[i_ >> 1] >> (16 * (i_ & 1))) & 0x1fffu); const int p_ = (lane & 15) ^ rotl4(kk_ & 15); \
                __builtin_amdgcn_global_load_lds((const unsigned*)(cb + (size_t)id_ * 128 + p_ * 8), (LAS unsigned*)(buf_ + i_ * 1024), 16, 0, 0); } } while (0)
            f32x4 oacc[8];
#pragma unroll
            for (int rt = 0; rt < 8; ++rt) oacc[rt] = (f32x4){0.f, 0.f, 0.f, 0.f};
            float mrun = -INFINITY, lrun = 0.f;
            DSA_ISSUE(0);
            for (int c = 0; c < 8; ++c) {
                if (c < 7) { DSA_ISSUE(c + 1); asm volatile("s_waitcnt vmcnt(8)" ::: "memory"); } else { asm volatile("s_waitcnt vmcnt(0)" ::: "memory"); }
                const LAS unsigned char* buf = wl + (c & 1) * 8192;
                f32x4 sacc[2]; float lg[8];
#pragma unroll
                for (int jt = 0; jt < 2; ++jt) { sacc[jt] = (f32x4){0.f, 0.f, 0.f, 0.f};
#pragma unroll
                    for (int ks = 0; ks < 4; ++ks) { const bf16x8 cf = *(const LAS bf16x8*)(buf + (16 * jt + fr) * 256 + (((ks * 4 + fq) ^ rotl4(fr)) * 16)); sacc[jt] = MFMA16(cf, ql[ks], sacc[jt]); } }
                float mloc = -INFINITY;
                {
                    const unsigned bw0 = *(const LAS unsigned*)(BKL + 32 * c + 4 * fq), bw1 = *(const LAS unsigned*)(BKL + 32 * c + 16 + 4 * fq);
                    const int hh = fr < 12 ? fr : 0;
                    float bv[8]; unsigned bb[8];
#pragma unroll
                    for (int i = 0; i < 4; ++i) { bb[i] = (bw0 >> (8 * i)) & 0xffu; bb[4 + i] = (bw1 >> (8 * i)) & 0xffu; }
#pragma unroll
                    for (int i = 0; i < 8; ++i) bv[i] = RB[bb[i] * 12 + hh];
#pragma unroll
                    for (int i = 0; i < 8; ++i) { const float v = sacc[i >> 2][i & 3] + bv[i]; lg[i] = v; mloc = fmaxf(mloc, v); }
                }
                mloc = rows4_max(mloc);
                const float mnew = fmaxf(mrun, mloc);
                const float scl = __expf(mrun - mnew);
                float p[8], ps = 0.f;
#pragma unroll
                for (int i = 0; i < 8; ++i) { p[i] = __expf(lg[i] - mnew); ps += p[i]; }
                lrun = lrun * scl + ps; mrun = mnew;
                u32x4 pw; pw.x = cvt_pk_bf16(p[0], p[1]); pw.y = cvt_pk_bf16(p[2], p[3]); pw.z = cvt_pk_bf16(p[4], p[5]); pw.w = cvt_pk_bf16(p[6], p[7]);
                const bf16x8 pf = __builtin_bit_cast(bf16x8, pw);
                const int i16 = lane & 15, qr = i16 >> 2, pp = i16 & 3, kk0 = 4 * fq + qr;
                unsigned ta[8];
#pragma unroll
                for (int rt = 0; rt < 8; ++rt) ta[rt] = (unsigned)(size_t)buf + (unsigned)(kk0 * 256 + (((2 * rt + (pp >> 1)) ^ rotl4(kk0)) * 16) + 8 * (pp & 1));
                s16x4 tlo[8], thi[8];
                asm volatile("ds_read_b64_tr_b16 %0, %16\n\tds_read_b64_tr_b16 %8, %16 offset:4096\n\t"
                             "ds_read_b64_tr_b16 %1, %17\n\tds_read_b64_tr_b16 %9, %17 offset:4096\n\t"
                             "ds_read_b64_tr_b16 %2, %18\n\tds_read_b64_tr_b16 %10, %18 offset:4096\n\t"
                             "ds_read_b64_tr_b16 %3, %19\n\tds_read_b64_tr_b16 %11, %19 offset:4096\n\t"
                             "ds_read_b64_tr_b16 %4, %20\n\tds_read_b64_tr_b16 %12, %20 offset:4096\n\t"
                             "ds_read_b64_tr_b16 %5, %21\n\tds_read_b64_tr_b16 %13, %21 offset:4096\n\t"
                             "ds_read_b64_tr_b16 %6, %22\n\tds_read_b64_tr_b16 %14, %22 offset:4096\n\t"
                             "ds_read_b64_tr_b16 %7, %23\n\tds_read_b64_tr_b16 %15, %23 offset:4096\n\t"
                             "s_waitcnt lgkmcnt(0)"
                             : "=&v"(tlo[0]), "=&v"(tlo[1]), "=&v"(tlo[2]), "=&v"(tlo[3]), "=&v"(tlo[4]), "=&v"(tlo[5]), "=&v"(tlo[6]), "=&v"(tlo[7]),
                               "=&v"(thi[0]), "=&v"(thi[1]), "=&v"(thi[2]), "=&v"(thi[3]), "=&v"(thi[4]), "=&v"(thi[5]), "=&v"(thi[6]), "=&v"(thi[7])
                             : "v"(ta[0]), "v"(ta[1]), "v"(ta[2]), "v"(ta[3]), "v"(ta[4]), "v"(ta[5]), "v"(ta[6]), "v"(ta[7]) : "memory");
#pragma unroll
                for (int rt = 0; rt < 8; ++rt) {
                    const bf16x8 cf = __builtin_shufflevector(tlo[rt], thi[rt], 0, 1, 2, 3, 4, 5, 6, 7);
                    oacc[rt] = oacc[rt] * scl; oacc[rt] = MFMA16(cf, pf, oacc[rt]);
                }
                LDS_WAIT();
            }
            lrun = rows4_sum(lrun);
            const float inv = 1.0f / lrun;
            if (fr < 12) {
#pragma unroll
                for (int rt = 0; rt < 8; ++rt) { u32x2 o; o.x = cvt_pk_bf16(oacc[rt][0] * inv, oacc[rt][1] * inv); o.y = cvt_pk_bf16(oacc[rt][2] * inv, oacc[rt][3] * inv);
                    *(u32x2*)(OLAT + (t * 12 + fr) * 128 + 16 * rt + 4 * fq) = o; }
            }
        }
        VM_WAIT();
        for (int h = 0; h < 12; ++h) {
            bf16x8 of[4];
#pragma unroll
            for (int ks = 0; ks < 4; ++ks) of[ks] = *(const bf16x8*)(((DIAG_WUVQ == 1) ? QLAT : OLAT) + ((t0 + fr) * 12 + h) * 128 + ks * 32 + fq * 8);
#pragma unroll
            for (int dt = 0; dt < 4; ++dt) { f32x4 a = (f32x4){0.f, 0.f, 0.f, 0.f};
#pragma unroll
                for (int ks = 0; ks < 4; ++ks) { const bf16x8 wf = *(const bf16x8*)(WUVT + ((size_t)h * 64 + 16 * dt + fr) * 128 + ks * 32 + fq * 8); a = MFMA16(wf, of[ks], a); }
                u32x2 o; o.x = cvt_pk_bf16(a[0], a[1]); o.y = cvt_pk_bf16(a[2], a[3]);
                if (DIAG_WUVQ == 2) { o.x = 0x3f803f80u; o.y = 0x3f803f80u; }
                (void)o; *(unsigned*)((unsigned char*)MIX + (t0 + fr) * D + h * 64 + 16 * dt + 4 * fq) = pk4_fp8(a[0] * 16.0f, a[1] * 16.0f, a[2] * 16.0f, a[3] * 16.0f); }
        }
    }
    __syncthreads();
}

#define WSP(off) (F.ws + (off))
DI void site_proj0(Ctx F) {
    launder(F);
    pg8::DenseOrderT<T / 256, WINA / 256, 0> S; S.init(F.G, F.bx);
    pg8::EpiBf16<true> E{(bf16_t*)WSP(WS_PROJ), WINA, (bf16_t*)WSP(WS_KV), 1024};
    pg8::Gemm g{WSP(WS_XB8), WSP(WS_WINA), 1024, nullptr, nullptr, nullptr, 0x7d7d7d7d, 0x7a7a7a7a};
    pg8::gemm_phase<pg8::EpiBf16<true>, pg8::DenseOrderT<T / 256, WINA / 256, 0>, 2, true>(F.lds, g, S, E, F.tid);
}
DI void site_kv(Ctx F) {
    launder(F);
    pg8::DenseOrderT<0, 4, 32> S; S.init(F.G, F.bx);
    pg8::EpiBf16<true> E{(bf16_t*)WSP(WS_PROJ), WINA, (bf16_t*)WSP(WS_KV), 1024};
    pg8::Gemm g{WSP(WS_MEMBF), WSP(WS_WKV), 2048, nullptr, WSP(WS_MEMBF), WSP(WS_WKV), 0, 0};
    pg8::gemm_phase<pg8::EpiBf16<true>, pg8::DenseOrderT<0, 4, 32>, 0>(F.lds, g, S, E, F.tid);
}
DI void site_proj1(Ctx F) {
    launder(F);
    pg8::DenseOrderT<T / 256, WINBP / 256, 0> S; S.init(F.G, F.bx);
    pg8::EpiBf16<true> E{(bf16_t*)WSP(WS_PROJ), WINBP, (bf16_t*)WSP(WS_KV), 1024};
    pg8::Gemm g{WSP(WS_XB8), WSP(WS_WINB), 1024, nullptr, nullptr, nullptr, 0x7d7d7d7d, 0x7a7a7a7a};
    pg8::gemm_phase<pg8::EpiBf16<true>, pg8::DenseOrderT<T / 256, WINBP / 256, 0>, 2, true>(F.lds, g, S, E, F.tid);
}
DI void site_out0(Ctx F) {
    launder(F);
    pg8::Gemm g{WSP(WS_MIX), WSP(WS_WOUT), 2048, nullptr, nullptr, nullptr, 0, 0};
    pg8::DenseOrderT<T / 256, 4, 0> S; S.init(F.G, F.bx);
    pg8::EpiBf16<false> E{(bf16_t*)WSP(WS_Z), 1024, nullptr, 0};
    pg8::gemm_phase<pg8::EpiBf16<false>, pg8::DenseOrderT<T / 256, 4, 0>, 0>(F.lds, g, S, E, F.tid);
}
DI void site_out1(Ctx F) {
    launder(F);
    pg8::Gemm g{WSP(WS_MIX), WSP(WS_WOUT) + (size_t)1024 * 1024 * 2, 1024, nullptr, nullptr, nullptr, 0x7b7b7b7b, 0x7a7a7a7a};
    pg8::DenseOrderT<T / 256, 4, 0> S; S.init(F.G, F.bx);
    pg8::EpiBf16<false> E{(bf16_t*)WSP(WS_Z), 1024, nullptr, 0};
    pg8::gemm_phase<pg8::EpiBf16<false>, pg8::DenseOrderT<T / 256, 4, 0>, 2, true>(F.lds, g, S, E, F.tid);
}
DI void site_g1(Ctx F, int layer) {
    launder(F);
    build_mtab(F, layer);
    pg8::Gemm g{WSP(WS_XB8), WSP(WS_W1) + (size_t)layer * 32 * 2048 * 1024, 1024, (const unsigned*)WSP(WS_LIST), nullptr, nullptr, 0x7d7d7d7d, 0x7a7a7a7a};
    pg8::MoeOrder<8, true> S{(const LAS int*)(F.lds + MTAB_OFF), (const LAS unsigned*)(F.lds + GMTAB_OFF), F.G, F.bx, 2048};
    pg8::EpiSwiglu E{(unsigned char*)WSP(WS_ACT), inp(F, I_B1) + (size_t)layer * 32 * 2048};
    pg8::gemm_phase<pg8::EpiSwiglu, pg8::MoeOrder<8, true>, 1, true>(F.lds, g, S, E, F.tid);
}
DI void site_g2(Ctx F, int layer) {
    launder(F);
    build_mtab(F, layer);
    pg8::Gemm g{WSP(WS_ACT), WSP(WS_W2) + (size_t)layer * 32 * 1024 * 1024, 1024, nullptr, nullptr, nullptr, 0x7d7d7d7d, 0x79797979};
    pg8::MoeOrder<4, false> S{(const LAS int*)(F.lds + MTAB_OFF), (const LAS unsigned*)(F.lds + GMTAB_OFF), F.G, F.bx, 1024};
    pg8::EpiFp8Bias E{(unsigned char*)WSP(WS_Y), 1024, inp(F, I_B2) + (size_t)layer * 32 * 1024};
    pg8::gemm_phase<pg8::EpiFp8Bias, pg8::MoeOrder<4, false>, 2, true>(F.lds, g, S, E, F.tid);
}
#undef WSP

DI void dsa_check_phase(Ctx& F) {
    if (F.wave != 0) return;
    const int lane = F.lane;
    LAS float* SC = (LAS float*)F.lds;
    LAS float* IQF = (LAS float*)(F.lds + 32768);
    LAS unsigned* BM = (LAS unsigned*)(F.lds + 33792);
    LAS float* QL = (LAS float*)(F.lds + 34816);
    LAS float* OL = (LAS float*)(F.lds + 40960);
    LAS float* PP = (LAS float*)(F.lds + 47104);
    LAS unsigned short* SEL = (LAS unsigned short*)(F.lds + 59392);
    const bf16_t* PROJ = (const bf16_t*)(F.ws + WS_PROJ); const bf16_t* IKN = (const bf16_t*)(F.ws + WS_IKN); const bf16_t* CN = (const bf16_t*)(F.ws + WS_CN);
    const unsigned short* IDX = (const unsigned short*)(F.ws + WS_IDX); const bf16_t* MIX = (const bf16_t*)(F.ws + WS_MIX);
    const bf16_t* WUK = (const bf16_t*)(F.ws + WS_WUK); const bf16_t* WUVT = (const bf16_t*)(F.ws + WS_WUVT);
    const int ptab[8] = {3, 100, 255, 256, 300, 1500, 5000, 8191};
    int pos = 0;
#pragma unroll
    for (int q = 0; q < 8; ++q) if ((F.bx & 7) == q) pos = ptab[q];
    pos = (pos + (F.bx >> 3) * 211) & 8191; const int b = (F.bx >> 3) & 7;
    const size_t rowb = (size_t)b * SEQ, t = rowb + pos;
    unsigned err = 0u;
    for (int i = lane; i < 256; i += 64) IQF[i] = bf2f(PROJ[t * WINBP + B_IQ + i]);
    float iwv[4];
#pragma unroll
    for (int h = 0; h < 4; ++h) iwv[h] = bf2f(PROJ[t * WINBP + B_IW + h]) * 0.0625f;
    LDS_WAIT();
    for (int k = lane; k <= pos; k += 64) {
        float a[4] = {0.f, 0.f, 0.f, 0.f};
        for (int d = 0; d < 64; ++d) { const float kv = bf2f(IKN[(rowb + k) * 64 + d]);
#pragma unroll
            for (int h = 0; h < 4; ++h) a[h] += kv * IQF[h * 64 + d]; }
        float sc = 0.f;
#pragma unroll
        for (int h = 0; h < 4; ++h) sc += fmaxf(a[h], 0.f) * iwv[h];
        SC[k] = sc + 0.0f;
    }
    for (int i = lane; i < 256; i += 64) { BM[i] = 0u; SEL[i] = IDX[t * 256 + i]; }
    LDS_WAIT();
    int nsel = 0;
    for (int i = lane; i < 256; i += 64) { const unsigned id = SEL[i]; if (id != 0xffffu) { ++nsel; __hip_atomic_fetch_or(BM + (id >> 5), 1u << (id & 31u), __ATOMIC_RELAXED, __HIP_MEMORY_SCOPE_WORKGROUP); if ((int)id > pos) err |= 1u; } }
    nsel = (int)wave_sum_fast((float)nsel);
    LDS_WAIT();
    const int want = (pos + 1 < 256) ? pos + 1 : 256;
    if (nsel != want) err |= 2u;
    if (pos + 1 > 256) {
        unsigned prefix = 0u;
        for (int bit = 31; bit >= 0; --bit) { const unsigned c = prefix | (1u << bit); int cnt = 0;
            for (int k = lane; k <= pos; k += 64) { unsigned ub = __float_as_uint(SC[k]); ub ^= (ub >> 31) ? 0xffffffffu : 0x80000000u; cnt += (ub >= c) ? 1 : 0; }
            cnt = (int)wave_sum_fast((float)cnt); if (cnt >= 256) prefix = c; }
        int mism = 0, nge = 0;
        for (int k = lane; k <= pos; k += 64) { unsigned ub = __float_as_uint(SC[k]); ub ^= (ub >> 31) ? 0xffffffffu : 0x80000000u; const bool inr = ub >= prefix; const bool ins = (BM[k >> 5] >> (k & 31)) & 1u; mism += (inr != ins) ? 1 : 0; nge += inr ? 1 : 0; }
        mism = (int)wave_sum_fast((float)mism); nge = (int)wave_sum_fast((float)nge);
        if (mism > 8 + 2 * (nge - 256)) err |= 4u;
    }
    for (int i = lane; i < 12 * 128; i += 64) { const int h = i >> 7, r = i & 127; float a = 0.f;
        for (int d = 0; d < 64; ++d) a += bf2f(PROJ[t * WINBP + h * 64 + d]) * bf2f(WUK[((size_t)h * 128 + r) * 64 + d]);
        QL[i] = bf2f(f2bf(a * 0.125f)); }
    LDS_WAIT();
    for (int j = lane; j < 256; j += 64) { const unsigned id = SEL[j];
        for (int h = 0; h < 12; ++h) { float a = -INFINITY;
            if (id != 0xffffu) { a = 0.f; for (int r = 0; r < 128; ++r) a += QL[h * 128 + r] * bf2f(CN[(rowb + id) * 128 + r]);
                const int rel = pos - (int)id; int bk = rel; if (rel >= 16) { bk = 16 + (int)(logf((float)rel * (1.0f / 16.0f)) / logf(8.0f) * 16.0f); bk = bk > 31 ? 31 : bk; }
                a += inp(F, I_RELB)[bk * 12 + h]; }
            PP[h * 256 + j] = a; } }
    LDS_WAIT();
    for (int h = 0; h < 12; ++h) { float m = -INFINITY; for (int j = lane; j < 256; j += 64) m = fmaxf(m, PP[h * 256 + j]);
#pragma unroll
        for (int o = 1; o < 64; o <<= 1) m = fmaxf(m, shx(m, o));
        float sm = 0.f; for (int j = lane; j < 256; j += 64) { const float v = PP[h * 256 + j]; const float p = (v == -INFINITY) ? 0.f : __expf(v - m); PP[h * 256 + j] = p; sm += p; }
        sm = wave_sum_fast(sm); const float inv = 1.0f / sm; for (int j = lane; j < 256; j += 64) PP[h * 256 + j] *= inv; }
    LDS_WAIT();
    for (int i = lane; i < 12 * 128; i += 64) { const int h = i >> 7, r = i & 127; float a = 0.f;
        for (int j = 0; j < 256; ++j) { const unsigned id = SEL[j]; if (id != 0xffffu) a += PP[h * 256 + j] * bf2f(CN[(rowb + id) * 128 + r]); }
        OL[i] = a; }
    LDS_WAIT();
    float e2 = 0.f, r2 = 0.f;
    for (int i = lane; i < 768; i += 64) { const int h = i >> 6, d = i & 63; float a = 0.f;
        for (int r = 0; r < 128; ++r) a += OL[h * 128 + r] * bf2f(WUVT[((size_t)h * 64 + d) * 128 + r]);
        const float got = bf2f(MIX[t * D + i]); e2 += (a - got) * (a - got); r2 += a * a; }
    e2 = wave_sum_fast(e2); r2 = wave_sum_fast(r2);
    if (!(e2 <= 0.0025f * r2)) err |= 8u;
    if (err && lane == 0) __hip_atomic_fetch_or(F.ctl + CW_ERR, err, __ATOMIC_RELAXED, __HIP_MEMORY_SCOPE_AGENT);
}
DI void ph_dsacheck(Ctx F) { launder(F); dsa_check_phase(F); }
DI void memattn_check_phase(Ctx& F, int layer, int ldp, int mqcol) {
    if (F.wave != 1) return;
    const int lane = F.lane;
    LAS float* PM = (LAS float*)(F.lds + 65536);
    const bf16_t* PROJ = (const bf16_t*)(F.ws + WS_PROJ); const bf16_t* KV = (const bf16_t*)(F.ws + WS_KV); const bf16_t* MIX = (const bf16_t*)(F.ws + WS_MIX);
    const int pos = (F.bx * 131 + 17) & 8191, b = (F.bx >> 2) & 7; const size_t t = (size_t)b * SEQ + pos;
    float e2 = 0.f, r2 = 0.f;
    for (int h = 0; h < 4; ++h) {
        float lg[4];
#pragma unroll
        for (int i = 0; i < 4; ++i) { const int m = lane + 64 * i; float a = 0.f;
            for (int d = 0; d < 64; ++d) a += bf2f(PROJ[t * ldp + mqcol + h * 64 + d]) * bf2f(KV[(size_t)(b * MEML + m) * 1024 + layer * 512 + h * 64 + d]);
            lg[i] = a * 0.125f; }
        float mx = fmaxf(fmaxf(lg[0], lg[1]), fmaxf(lg[2], lg[3]));
#pragma unroll
        for (int o = 1; o < 64; o <<= 1) mx = fmaxf(mx, shx(mx, o));
        float sm = 0.f;
#pragma unroll
        for (int i = 0; i < 4; ++i) { lg[i] = __expf(lg[i] - mx); sm += lg[i]; }
        sm = wave_sum_fast(sm);
#pragma unroll
        for (int i = 0; i < 4; ++i) PM[lane + 64 * i] = lg[i] / sm;
        LDS_WAIT();
        float a = 0.f;
        for (int m = 0; m < 256; ++m) a += PM[m] * bf2f(KV[(size_t)(b * MEML + m) * 1024 + layer * 512 + 256 + h * 64 + lane]);
        const float got = bf2f(MIX[t * D + TOKW + h * 64 + lane]); e2 += (a - got) * (a - got); r2 += a * a;
        LDS_WAIT();
    }
    e2 = wave_sum_fast(e2); r2 = wave_sum_fast(r2);
    if (!(e2 <= 0.0025f * r2) && lane == 0) __hip_atomic_fetch_or(F.ctl + CW_ERR, 16u << layer, __ATOMIC_RELAXED, __HIP_MEMORY_SCOPE_AGENT);
}
DI void ph_memcheck(Ctx F, int layer) { launder(F); if (layer == 0) memattn_check_phase(F, 0, WINA, 2 * TOKW); else memattn_check_phase(F, 1, WINBP, B_MQ); }


DI void ph_prologue(Ctx F) { launder(F); p0_prologue(F); }
DI void ph_lru0(Ctx F) { launder(F); lru_phase<0>(F); }
DI void ph_lru1(Ctx F) { launder(F); lru_phase<1>(F); launder(F); memattn_phase(F, 0, WINA, 2 * TOKW); }
DI void ph_prep(Ctx F) { launder(F); dsa_prep_phase(F); }
template <int IMODE> DI void ph_indexer(Ctx F) { launder(F); indexer_phase<IMODE>(F); }
DI void ph_idxcmp(Ctx F) { launder(F); idx_compare(F); }
DI void ph_attn(Ctx F) { launder(F); dsa_attn_phase(F); launder(F); if (!DIAG_SKIPMEM) memattn_phase(F, 1, WINBP, B_MQ); }
DI void ph_lnr(Ctx F, int layer) { launder(F); ln_router_phase(F, layer); }
DI void ph_combine(Ctx F, int layer) { launder(F); combine_ln_phase(F, layer, F.out); }

constexpr int NPHASE = 18;
struct Args { const float* in[29]; float* out; unsigned char* ws; int ph_lo, ph_hi; };

__global__ void __launch_bounds__(512, 2) mk_fwd(Args args) {
    extern __shared__ __attribute__((aligned(16))) unsigned char lds_raw[];
    Ctx F;
    F.lds = (LAS unsigned char*)lds_raw;
    F.tid = threadIdx.x; F.lane = F.tid & 63; F.wave = __builtin_amdgcn_readfirstlane(F.tid >> 6);
    F.G = gridDim.x; F.bx = blockIdx.x;
    F.ws = args.ws; F.ctl = (unsigned*)(args.ws + WS_CTL); F.out = args.out;
    volatile LAS unsigned* MISC = (volatile LAS unsigned*)(F.lds + MISC_OFF);
#if DIAG_INIT
    for (int u = F.tid; u < MISC_OFF / 4; u += 512) ((LAS unsigned*)F.lds)[u] = 0u;
#endif
    for (int u = F.tid; u < (PTAB_OFF - MISC_OFF) / 4; u += 512) ((LAS unsigned*)(F.lds + MISC_OFF))[u] = 0u;
    if (F.tid == 0) {
#pragma unroll
        for (int i = 0; i < 29; ++i) *(LAS unsigned long long*)(F.lds + PTAB_OFF + 8 * i) = (unsigned long long)args.in[i];
    }
    __syncthreads();
    const int lo = args.ph_lo, hi = args.ph_hi;
    XcdBarrier bar; bar.bar = F.ctl + CW_BAR; bar.x = 0; bar.st = nullptr;
    if (hi - lo > 1) bar = xcd_barrier_post(F.ctl + CW_BAR, MISC + 8);
#ifndef PHASE_MASK
#define PHASE_MASK 0xffff
#endif
#define IN(k) (lo <= (k) && (k) < hi)
#define ON(site) ((((unsigned)PHASE_MASK) >> (site)) & 1u)
#define SEAM(k) do { if (ON(15) && IN(k) && IN((k) + 1)) { XcdBarrier b2_ = bar; { const unsigned long long p_ = (unsigned long long)b2_.bar; int pl_ = __builtin_amdgcn_readfirstlane((int)(unsigned)p_), ph_ = __builtin_amdgcn_readfirstlane((int)(unsigned)(p_ >> 32)); \
        asm volatile("" : "+s"(pl_), "+s"(ph_)); b2_.bar = (unsigned*)(GAS unsigned*)(((unsigned long long)(unsigned)ph_ << 32) | (unsigned)pl_); } \
        xcd_barrier(b2_); if (DBL(15)) { xcd_barrier(b2_); xcd_barrier(b2_); xcd_barrier(b2_); xcd_barrier(b2_); } } } while (0)
#define RUN(site, k, body) do { if (ON(site) && IN(k)) { body; } if (DBL(site) && IN(k)) { body; } } while (0)
    RUN(0, 0, ph_prologue(F));
    SEAM(0);
    for (int layer = 0; layer < 2; ++layer) {
        const int pb = layer ? 9 : 1;
        if (layer == 0) { RUN(1, pb, site_proj0(F)); RUN(1, pb, site_kv(F)); } else { RUN(1, pb, site_proj1(F)); }
        SEAM(pb);
        int po;
        if (layer == 0) {
            RUN(2, 2, ph_lru0(F));
            SEAM(2);
            RUN(3, 3, ph_lru1(F));
#if PROBE_DSA
            SEAM(3);
            if (ON(3) && IN(3)) { ph_memcheck(F, 0); }
#endif
            SEAM(3);
            po = 4;
        } else {
            RUN(10, 10, ph_prep(F));
            SEAM(10);
#if PROBE_CHECK
            if (ON(11) && IN(11)) { ph_indexer<0>(F); }
            SEAM(11);
#endif
            RUN(11, 11, ph_indexer<1>(F));
#if PROBE_CHECK
            SEAM(11);
            if (ON(11) && IN(11)) { ph_idxcmp(F); }
#endif
            SEAM(11);
            RUN(12, 12, ph_attn(F));
#if PROBE_DSA
            SEAM(12);
            if (ON(12) && IN(12)) { ph_dsacheck(F); ph_memcheck(F, 1); }
#endif
            SEAM(12);
            po = 13;
        }
        if (layer == 0) { RUN(4, po, site_out0(F)); } else { RUN(4, po, site_out1(F)); }
        SEAM(po);
        if (ON(5) && IN(po + 1)) { ph_lnr(F, layer); }
        SEAM(po + 1);
        RUN(6, po + 2, site_g1(F, layer));
        SEAM(po + 2);
        RUN(7, po + 3, site_g2(F, layer));
        SEAM(po + 3);
        RUN(8, po + 4, ph_combine(F, layer));
        if (layer == 0) SEAM(po + 4);
    }
#undef RUN
#undef IN
#undef SEAM
#if DIAG_DUMP
    if (lo == 100) {
        const size_t gt = (size_t)F.bx * 512 + F.tid, NT = (size_t)F.G * 512;
        for (size_t i = gt; i < (size_t)T * D; i += NT) {
            float v;
            if (DIAG_DUMP == 1) v = bf2f(((const bf16_t*)(args.ws + WS_MIX))[i]);
            else if (DIAG_DUMP == 2) v = bf2f(((const bf16_t*)(args.ws + WS_Z))[i]);
            else if (DIAG_DUMP == 3) v = ((const float*)(args.ws + WS_XA))[i];
            else if (DIAG_DUMP == 4) v = bf2f(((const bf16_t*)(args.ws + WS_PROJ))[i]);
            else if (DIAG_DUMP == 8) v = ((i & 1023) < 768) ? bf2f(((const bf16_t*)(args.ws + WS_MIX))[i]) : 0.f;
            else if (DIAG_DUMP == 9) v = ((i & 1023) >= 768) ? bf2f(((const bf16_t*)(args.ws + WS_MIX))[i]) : 0.f;
            else if (DIAG_DUMP == 10) v = bf2f(((const bf16_t*)(args.ws + WS_OLAT))[i + 33554432]);
            else if (DIAG_DUMP == 11) v = bf2f(((const bf16_t*)(args.ws + WS_QLAT))[i + 33554432]);
            else if (DIAG_DUMP == 12) v = bf2f(((const bf16_t*)(args.ws + WS_WUVT))[i % 98304]);
            else if (DIAG_DUMP == 6) v = bf2f(((const bf16_t*)(args.ws + WS_QLAT))[i]);
            else if (DIAG_DUMP == 7) v = bf2f(((const bf16_t*)(args.ws + WS_OLAT))[i]);
            else v = (float)((const unsigned short*)(args.ws + WS_IDX))[i % ((size_t)T * 256)];
            if (!(v - v == 0.f)) v = 12345.0f;
            F.out[i] = v; }
    }
#endif
}

extern "C" void kernel_launch(void* const* d_in, const int* in_sizes, int n_in, void* d_out, int out_size, void* d_ws, size_t ws_size, hipStream_t stream) {
    static int grid = 0;
    if (grid == 0) {
        if (n_in != 29 || out_size != T * D || ws_size < WS_END) { fprintf(stderr, "kernel_launch: unexpected shapes (n_in %d, out %d, ws %zu)\n", n_in, out_size, ws_size); grid = -1; return; }
        int dev = 0, cus = 0, per_cu = 0;
        if (hipGetDevice(&dev) != hipSuccess || hipDeviceGetAttribute(&cus, hipDeviceAttributeMultiprocessorCount, dev) != hipSuccess) { grid = -1; return; }
        if (hipFuncSetAttribute((const void*)mk_fwd, hipFuncAttributeMaxDynamicSharedMemorySize, LDS_BYTES) != hipSuccess) { fprintf(stderr, "kernel_launch: hipFuncSetAttribute failed\n"); grid = -1; return; }
        if (hipOccupancyMaxActiveBlocksPerMultiprocessor(&per_cu, (const void*)mk_fwd, 512, LDS_BYTES) != hipSuccess || per_cu < 1) { fprintf(stderr, "kernel_launch: occupancy query says %d\n", per_cu); (void)hipGetLastError(); grid = -1; return; }
        grid = cus;
    }
    if (grid < 0) return;
    if (hipMemsetAsync((char*)d_ws + WS_CTL, 0, CTL_BYTES, stream) != hipSuccess) return;
#if DIAG_INIT
    (void)hipMemsetAsync((char*)d_ws + CTL_BYTES, 0, WS_END - CTL_BYTES, stream);
    (void)hipMemsetAsync(d_out, 0, (size_t)T * D * 4, stream);
#endif
    Args a{};
    for (int i = 0; i < 29; ++i) a.in[i] = (const float*)d_in[i];
    a.out = (float*)d_out; a.ws = (unsigned char*)d_ws;
#if MK_SPLIT
    for (int p = 0; p <= DIAG_LAST && p < NPHASE; ++p) { a.ph_lo = p; a.ph_hi = p + 1; hipLaunchKernelGGL(mk_fwd, dim3(grid), dim3(512), LDS_BYTES, stream, a); }
#if DIAG_DUMP
    a.ph_lo = 100; a.ph_hi = 101; hipLaunchKernelGGL(mk_fwd, dim3(grid), dim3(512), LDS_BYTES, stream, a);
#endif
#elif defined(REPEAT_PHASE)
    a.ph_lo = 0; a.ph_hi = REPEAT_PHASE + 1; hipLaunchKernelGGL(mk_fwd, dim3(grid), dim3(512), LDS_BYTES, stream, a);
    (void)hipMemsetAsync((char*)d_ws + WS_CTL + CW_IQ * 4, 0, 4096, stream);
    a.ph_lo = REPEAT_PHASE; a.ph_hi = REPEAT_PHASE + 1; hipLaunchKernelGGL(mk_fwd, dim3(grid), dim3(512), LDS_BYTES, stream, a);
    if (REPEAT_PHASE + 1 < NPHASE) {
        (void)hipMemsetAsync((char*)d_ws + WS_CTL + CW_BAR * 4, 0, XCD_BAR_WORDS * 4, stream);
        a.ph_lo = REPEAT_PHASE + 1; a.ph_hi = NPHASE; hipLaunchKernelGGL(mk_fwd, dim3(grid), dim3(512), LDS_BYTES, stream, a);
    }
#else
    a.ph_lo = 0; a.ph_hi = NPHASE; hipLaunchKernelGGL(mk_fwd, dim3(grid), dim3(512), LDS_BYTES, stream, a);
#endif
}
```

```cpp
#include <hip/hip_runtime.h>
#include <cstdio>
#include <cstdint>

#ifndef DIAG_INIT
#define DIAG_INIT 0
#endif
#ifndef DIAG_LAST
#define DIAG_LAST 17
#endif
#ifndef DIAG_DUMP
#define DIAG_DUMP 0
#define DIAG_SKIPMEM 0
#define DIAG_WUVQ 0
#endif
#ifndef PROBE_CHECK
#define PROBE_CHECK 0
#endif
#ifndef PROBE_SEL
#define PROBE_SEL 0
#endif
#ifndef PROBE_PASS3
#define PROBE_PASS3 0
#endif
#ifndef PROBE_NOFB
#define PROBE_NOFB 0
#endif
#ifndef PROBE_NORETRY
#define PROBE_NORETRY 0
#endif
#ifndef PROBE_DSA
#define PROBE_DSA 0
#endif
#ifndef PROBE_SEL2
#define PROBE_SEL2 0
#endif
#ifndef MK_SPLIT
#define MK_SPLIT 0
#endif

#ifndef DBL_MASK
#define DBL_MASK 0
#endif
#define DBL(site) ((((unsigned)DBL_MASK) >> (site)) & 1u)

#define LAS __attribute__((address_space(3)))
#define GAS __attribute__((address_space(1)))
typedef unsigned short bf16_t;
typedef short bf16x8 __attribute__((ext_vector_type(8)));
typedef short s16x4 __attribute__((ext_vector_type(4)));
typedef float f32x4 __attribute__((ext_vector_type(4)));
typedef float f32x2 __attribute__((ext_vector_type(2)));
typedef unsigned u32x4 __attribute__((ext_vector_type(4)));
typedef unsigned u32x2 __attribute__((ext_vector_type(2)));
#define DI __device__ __forceinline__
#define MFMA16(a, b, c) __builtin_amdgcn_mfma_f32_16x16x32_bf16((a), (b), (c), 0, 0, 0)

constexpr int D = 1024, NB = 8, SEQ = 8192, T = NB * SEQ;
constexpr int TOKW = 768, MEMW = 256, MEML = 256;
constexpr int WINA = 1792, WINB = 1476, WINBP = 1536;
constexpr int NEXP = 32, DEXP = 1024;
constexpr float LN_EPS = 1e-5f;
constexpr float DN_ALPHA = 1.41421356237309515f;
constexpr int PMAX = 270336;
constexpr int B_C = 768, B_IQ = 896, B_IK = 1152, B_MQ = 1216, B_IW = 1472;

constexpr size_t MiB = 1u << 20;
constexpr size_t WS_CTL = 0, CTL_BYTES = 1 * MiB;
constexpr size_t WS_WINA = 1 * MiB;
constexpr size_t WS_WINB = 5 * MiB;
constexpr size_t WS_WKV = 8 * MiB;
constexpr size_t WS_WOUT = 10 * MiB;
constexpr size_t WS_WRT = 14 * MiB;
constexpr size_t WS_WUK = 14 * MiB + 256 * 1024;
constexpr size_t WS_WUVT = 14 * MiB + 512 * 1024;
constexpr size_t WS_ROUT = 15 * MiB;
constexpr size_t WS_MEMBF = 16 * MiB;
constexpr size_t WS_KV = 20 * MiB;
constexpr size_t WS_LSUM = 24 * MiB;
constexpr size_t WS_LIST = 32 * MiB;
constexpr size_t WS_TOKSLOT = 40 * MiB;
constexpr size_t WS_TOKGATE = 41 * MiB;
constexpr size_t WS_CN = 48 * MiB;
constexpr size_t WS_IKN = 64 * MiB;
constexpr size_t WS_IDX = 72 * MiB;
constexpr size_t WS_W1 = 112 * MiB;
constexpr size_t WS_W2 = 368 * MiB;
constexpr size_t WS_XB8 = 240 * MiB;
constexpr size_t WS_XA = 496 * MiB;
constexpr size_t WS_XBF = 752 * MiB;
constexpr size_t WS_ACT = 880 * MiB;
constexpr size_t WS_QLAT = WS_ACT, WS_OLAT = WS_ACT + 192 * MiB;
constexpr size_t WS_PROJ = 1408 * MiB;
constexpr size_t WS_MIX = 1632 * MiB;
constexpr size_t WS_Z = 1760 * MiB;
constexpr size_t WS_Y = 1408 * MiB;
constexpr size_t WS_END = 2016 * MiB;
constexpr int CW_BAR = 4096;
constexpr int CW_ERR = 8192;
constexpr int CW_CNT = 16384;
constexpr int CW_IQ = 20480;

constexpr int STAGE_BYTES = 131072;
constexpr int TOKTAB_OFF = STAGE_BYTES;
constexpr int LDS_BYTES = 163840;
constexpr int GMTAB_OFF = STAGE_BYTES + 2048;
constexpr int MISC_OFF = LDS_BYTES - 2048;
constexpr int MTAB_OFF = MISC_OFF + 512;
constexpr int PTAB_OFF = MISC_OFF + 1024;

typedef __bf16 bf16x2_t __attribute__((ext_vector_type(2)));
DI unsigned cvt_pk_bf16(float lo, float hi) { const f32x2 v = {lo, hi}; const bf16x2_t r = __builtin_convertvector(v, bf16x2_t); return __builtin_bit_cast(unsigned, r); }
DI unsigned pk4_fp8(float a, float b, float c, float d) { unsigned w = 0u; w = (unsigned)__builtin_amdgcn_cvt_pk_fp8_f32(a, b, (int)w, false); w = (unsigned)__builtin_amdgcn_cvt_pk_fp8_f32(c, d, (int)w, true); return w; }
DI float bf2f(unsigned short b) { return __uint_as_float(((unsigned)b) << 16); }
DI float bflo(unsigned w) { return __uint_as_float(w << 16); }
DI float bfhi(unsigned w) { return __uint_as_float(w & 0xffff0000u); }
DI unsigned short f2bf(float f) { return (unsigned short)(cvt_pk_bf16(f, 0.f) & 0xffffu); }
DI float sigmoidf_(float x) { return __builtin_amdgcn_rcpf(1.0f + __expf(-x)); }
DI int shfl_lane() { unsigned m = 0xffffffffu; asm volatile("" : "+v"(m)); return (int)__builtin_amdgcn_mbcnt_hi(m, __builtin_amdgcn_mbcnt_lo(m, 0u)); }
DI float shx(float v, int o) { return __int_as_float(__builtin_amdgcn_ds_bpermute((shfl_lane() ^ o) << 2, __float_as_int(v))); }
DI int shup_i(int v, int o) { return __builtin_amdgcn_ds_bpermute((shfl_lane() - o) << 2, v); }
DI float rows4_max(float x) { unsigned u = __float_as_uint(x);
    auto a = __builtin_amdgcn_permlane16_swap(u, u, false, false); float m = fmaxf(__uint_as_float(a[0]), __uint_as_float(a[1])); u = __float_as_uint(m);
    auto b = __builtin_amdgcn_permlane32_swap(u, u, false, false); return fmaxf(__uint_as_float(b[0]), __uint_as_float(b[1])); }
DI float rows4_sum(float x) { unsigned u = __float_as_uint(x);
    auto a = __builtin_amdgcn_permlane16_swap(u, u, false, false); float m = __uint_as_float(a[0]) + __uint_as_float(a[1]); u = __float_as_uint(m);
    auto b = __builtin_amdgcn_permlane32_swap(u, u, false, false); return __uint_as_float(b[0]) + __uint_as_float(b[1]); }
DI float wave_sum(float v) {
#pragma unroll
    for (int o = 1; o < 64; o <<= 1) v += shx(v, o);
    return v;
}
DI u32x4 zero4_local() { unsigned z = 0u; asm volatile("" : "+v"(z)); return (u32x4){z, z, z, z}; }
DI float wave_sum_fast(float v) {
    int x = __float_as_int(v);
#define WSF_STEP(ctrl) x = __float_as_int(__int_as_float(x) + __int_as_float(__builtin_amdgcn_update_dpp(0, x, ctrl, 0xf, 0xf, true)));
    WSF_STEP(0x101) WSF_STEP(0x102) WSF_STEP(0x104) WSF_STEP(0x108)
#undef WSF_STEP
    return (__int_as_float(__builtin_amdgcn_readlane(x, 0)) + __int_as_float(__builtin_amdgcn_readlane(x, 16))) + (__int_as_float(__builtin_amdgcn_readlane(x, 32)) + __int_as_float(__builtin_amdgcn_readlane(x, 48)));
}
#define LDS_WAIT() asm volatile("s_waitcnt lgkmcnt(0)" ::: "memory")
#define VM_WAIT() asm volatile("s_waitcnt vmcnt(0)" ::: "memory")

#define XB_TMO      128
#define XB_XCNT(j)  (256  + 64 * (j))
#define XB_XSUB(j)  (1280 + 64 * (j))
#define XB_XGEN(j)  (2304 + 64 * (j))
#define XB_TOP      3328
#define XB_TOPGEN   3392
#define XCD_BAR_WORDS 3456
#define XB_SPIN_CAP (1u << 22)

DI unsigned xb_ld(unsigned* p)              { return __hip_atomic_load(p, __ATOMIC_RELAXED, __HIP_MEMORY_SCOPE_AGENT); }
DI unsigned xb_add(unsigned* p, unsigned v) { return __hip_atomic_fetch_add(p, v, __ATOMIC_RELAXED, __HIP_MEMORY_SCOPE_AGENT); }
DI unsigned xb_xcc_id() { return (unsigned)__builtin_amdgcn_s_getreg((3 << 11) | 20) & 0xFu; }
#define XB_SPIN(cond, bar) do { unsigned _sp = 0; while (cond) { __builtin_amdgcn_s_sleep(1); \
    if ((++_sp & 255u) == 0u) { if (xb_ld(&(bar)[XB_TMO])) break; if (_sp > XB_SPIN_CAP) { atomicAdd(&(bar)[XB_TMO], 1u); break; } } } } while (0)

struct XcdBarrier { unsigned* bar; unsigned x; volatile LAS unsigned* st; };

DI XcdBarrier xcd_barrier_post(unsigned* bar, volatile LAS unsigned* st) {
    XcdBarrier b; b.bar = bar; b.x = xb_xcc_id(); b.st = st;
    if (threadIdx.x == 0) (void)xb_add(&bar[XB_XCNT(b.x)], 1u);
    return b;
}
DI void xcd_barrier_complete(unsigned* bar, unsigned x, unsigned& nloc, unsigned& nx) {
    const unsigned G = gridDim.x * gridDim.y * gridDim.z;
    unsigned sum, cnt, mine, sp = 0u;
    for (;;) {
        sum = 0u; cnt = 0u; mine = 0u;
#pragma unroll
        for (unsigned j = 0; j < 16; ++j) { const unsigned c = xb_ld(&bar[XB_XCNT(j)]); sum += c; cnt += (c > 0u) ? 1u : 0u; mine = (j == x) ? c : mine; }
        if (sum == G) break;
        __builtin_amdgcn_s_sleep(1);
        if ((++sp & 255u) == 0u) { if (xb_ld(&bar[XB_TMO])) break; if (sp > XB_SPIN_CAP) { atomicAdd(&bar[XB_TMO], 1u); break; } }
    }
    nloc = mine > 0u ? mine : 1u; nx = cnt > 0u ? cnt : 1u;
}
DI void xcd_barrier(const XcdBarrier& b) {
    asm volatile("s_waitcnt vmcnt(0)" ::: "memory");
    __syncthreads();
    if (threadIdx.x == 0) {
        unsigned* bar = b.bar;
        __builtin_amdgcn_s_waitcnt(0);
        unsigned nloc = b.st[0], nx = b.st[1];
        if (nloc == 0u) { xcd_barrier_complete(bar, b.x, nloc, nx); b.st[0] = nloc; b.st[1] = nx; }
        const unsigned old = xb_add(&bar[XB_XSUB(b.x)], 1u);
        const unsigned gen = old / nloc;
        if (old + 1u == (gen + 1u) * nloc) {
            __builtin_amdgcn_fence(__ATOMIC_RELEASE, "agent");
            asm volatile("s_waitcnt vmcnt(0)" ::: "memory");
            const unsigned og = xb_add(&bar[XB_TOP], 1u);
            const unsigned tg = og / nx;
            if (og + 1u == (tg + 1u) * nx) xb_add(&bar[XB_TOPGEN], 1u);
            else XB_SPIN(xb_ld(&bar[XB_TOPGEN]) == tg, bar);
            __builtin_amdgcn_fence(__ATOMIC_ACQUIRE, "agent");
            xb_add(&bar[XB_XGEN(b.x)], 1u);
            asm volatile("s_waitcnt vmcnt(0)" ::: "memory");
        } else {
            XB_SPIN(xb_ld(&bar[XB_XGEN(b.x)]) == gen, bar);
            __builtin_amdgcn_fence(__ATOMIC_ACQUIRE, "agent");
            asm volatile("s_waitcnt vmcnt(0)" ::: "memory");
        }
    }
    __syncthreads();
}

namespace pg8 {
constexpr int BM = 256, BK = 64, HALF = 128, HTB = HALF * BK * 2;
DI int lds_byte(int r, int c) { const int st = (r >> 4) * 2 + (c >> 5), rr = r & 15, cc = c & 31, ob = rr * 64 + cc * 2; return st * 1024 + (ob ^ (((ob >> 9) & 1) << 5)); }
DI void stage_rc(int b, int& R, int& C) { const int st = b / 1024, sb = b % 1024, swz = sb ^ (((sb >> 9) & 1) << 5); R = (st >> 1) * 16 + swz / 64; C = (st & 1) * 32 + (swz % 64) / 2; }
DI int perm32(int rho) { const int n = rho >> 4, i = rho & 15; return 8 * (i >> 2) + 4 * n + (i & 3); }

struct Unit { int arow, brow, orow, ocol, e; };
struct Gemm { const void* A; const void* Bt; int K; const unsigned* list; const void* A2; const void* Bt2; int sa, sb; };

template <int nM, int nN, int nx2> struct DenseOrderT {
    static constexpr bool DUAL = true;
    static constexpr int nwg = nM * nN;
    int G, c;
    DI void init(int G_, int c_) { G = G_; c = c_; }
    DI bool next(int i, Unit& u) const {
        const int L = i * G + c; if (L >= nwg + nx2) return false;
        if (L >= nwg) { const int q = L - nwg; u.arow = (q >> 2) * BM; u.brow = (q & 3) * BM; u.orow = u.arow; u.ocol = u.brow; u.e = 1; return true; }
        int wgid = L; { constexpr int q = nwg / 8, r = nwg % 8; const int xcd = wgid % 8, off = wgid / 8; wgid = (xcd < r ? xcd * (q + 1) : r * (q + 1) + (xcd - r) * q) + off; }
        constexpr int nig = 8 * nN; const int gid = wgid / nig, fm = gid * 8, gsz = (nM - fm) < 8 ? (nM - fm) : 8;
        const int rem = wgid % nig; const int pm = fm + (gsz == 8 ? (rem & 7) : (rem % gsz)), pn = gsz == 8 ? (rem >> 3) : (rem / gsz);
        u.arow = pm * BM; u.brow = pn * BM; u.orow = pm * BM; u.ocol = pn * BM; u.e = 0; return true;
    }
};
template <int NN, bool GATHER> struct MoeOrder {
    static constexpr bool DUAL = false;
    const LAS int* mtab; const LAS unsigned* gmtab; int G, c, nrowsB;
    DI bool next(int i, Unit& u) const {
        constexpr int MG = 32 / NN;
        const int x = c & 7, j = c >> 3;
        const int per = G >> 3;
        const int TM = __builtin_amdgcn_readfirstlane(mtab[32]);
        const int slot = i * per + j;
        const int grp = (slot / 32) * 8 + x, within = slot % 32;
        const int gm = grp * MG + within / NN, pn = within % NN;
        if (gm >= TM) return false;
        const unsigned pk = (unsigned)__builtin_amdgcn_readfirstlane((int)gmtab[gm]);
        const int e = (int)(pk >> 16), mt = (int)(pk & 0xffffu);
        u.e = e; u.arow = GATHER ? (e * 65536 + mt * 256) : gm * 256; u.brow = e * nrowsB + pn * 256; u.orow = gm * 256; u.ocol = pn * 256; return true;
    }
};

template <bool DUALOUT> struct EpiBf16 {
    static constexpr bool PERM = true;
    bf16_t* O; int ldc; bf16_t* O2; int ldc2;
    DI void operator()(const f32x4 (&acc)[2][2][4][2], const Unit& u, int wr, int wc, int fr, int fq) const {
        const int row0 = u.orow + wr * 64 + fr, col0 = u.ocol + wc * 32 + 8 * fq;
        bf16_t* Ob = O; int ld = ldc; if (DUALOUT && u.e != 0) { Ob = O2; ld = ldc2; }
#pragma unroll
        for (int ai = 0; ai < 2; ++ai)
#pragma unroll
            for (int m = 0; m < 4; ++m) { bf16_t* rowp = Ob + (size_t)(row0 + ai * HALF + m * 16) * ld + col0;
#pragma unroll
                for (int bj = 0; bj < 2; ++bj) { const f32x4 v0 = acc[ai][bj][m][0], v1 = acc[ai][bj][m][1];
                    u32x4 w; w.x = cvt_pk_bf16(v0[0], v0[1]); w.y = cvt_pk_bf16(v0[2], v0[3]); w.z = cvt_pk_bf16(v1[0], v1[1]); w.w = cvt_pk_bf16(v1[2], v1[3]);
                    *(u32x4*)(rowp + bj * HALF) = w; } }
    }
};
struct EpiBf16Bias {
    static constexpr bool PERM = true;
    bf16_t* O; int ldc; const float* bias;
    DI void operator()(const f32x4 (&acc)[2][2][4][2], const Unit& u, int wr, int wc, int fr, int fq) const {
        const int row0 = u.orow + wr * 64 + fr, col0 = u.ocol + wc * 32 + 8 * fq;
        f32x4 bv[2][2];
#pragma unroll
        for (int bj = 0; bj < 2; ++bj) { bv[bj][0] = *(const f32x4*)(bias + u.e * 1024 + col0 + bj * HALF); bv[bj][1] = *(const f32x4*)(bias + u.e * 1024 + col0 + bj * HALF + 4); }
#pragma unroll
        for (int ai = 0; ai < 2; ++ai)
#pragma unroll
            for (int m = 0; m < 4; ++m) { bf16_t* rowp = O + (size_t)(row0 + ai * HALF + m * 16) * ldc + col0;
#pragma unroll
                for (int bj = 0; bj < 2; ++bj) { const f32x4 v0 = acc[ai][bj][m][0] + bv[bj][0], v1 = acc[ai][bj][m][1] + bv[bj][1];
                    u32x4 w; w.x = cvt_pk_bf16(v0[0], v0[1]); w.y = cvt_pk_bf16(v0[2], v0[3]); w.z = cvt_pk_bf16(v1[0], v1[1]); w.w = cvt_pk_bf16(v1[2], v1[3]);
                    *(u32x4*)(rowp + bj * HALF) = w; } }
    }
};
struct EpiFp8Bias {
    static constexpr bool PERM = true;
    unsigned char* O; int ldc; const float* bias;
    DI void operator()(const f32x4 (&acc)[2][2][4][2], const Unit& u, int wr, int wc, int fr, int fq) const {
        const int row0 = u.orow + wr * 64 + fr, col0 = u.ocol + wc * 32 + 8 * fq;
        f32x4 bv[2][2];
#pragma unroll
        for (int bj = 0; bj < 2; ++bj) { bv[bj][0] = *(const f32x4*)(bias + u.e * 1024 + col0 + bj * HALF); bv[bj][1] = *(const f32x4*)(bias + u.e * 1024 + col0 + bj * HALF + 4); }
#pragma unroll
        for (int ai = 0; ai < 2; ++ai)
#pragma unroll
            for (int m = 0; m < 4; ++m) { unsigned char* rowp = O + (size_t)(row0 + ai * HALF + m * 16) * ldc + col0;
#pragma unroll
                for (int bj = 0; bj < 2; ++bj) { const f32x4 v0 = (acc[ai][bj][m][0] + bv[bj][0]) * 16.0f, v1 = (acc[ai][bj][m][1] + bv[bj][1]) * 16.0f;
                    u32x2 w; w.x = pk4_fp8(v0[0], v0[1], v0[2], v0[3]); w.y = pk4_fp8(v1[0], v1[1], v1[2], v1[3]);
                    *(u32x2*)(rowp + bj * HALF) = w; } }
    }
};
struct EpiResF32 {
    static constexpr bool PERM = false;
    float* Z; const float* res; float alpha; const bf16_t* resb;
    DI void operator()(const f32x4 (&acc)[2][2][4][2], const Unit& u, int wr, int wc, int fr, int fq) const {
        const int row0 = u.orow + wr * 64 + fr, col0 = u.ocol + wc * 32 + 4 * fq;
#pragma unroll
        for (int ai = 0; ai < 2; ++ai)
#pragma unroll
            for (int m = 0; m < 4; ++m) { const size_t off = (size_t)(row0 + ai * HALF + m * 16) * D + col0;
#pragma unroll
                for (int bj = 0; bj < 2; ++bj)
#pragma unroll
                    for (int n = 0; n < 2; ++n) { f32x4 r;
                        if (resb) { const u32x2 rw = *(const u32x2*)(resb + off + bj * HALF + n * 16); r = (f32x4){bflo(rw.x), bfhi(rw.x), bflo(rw.y), bfhi(rw.y)}; }
                        else r = *(const f32x4*)(res + off + bj * HALF + n * 16);
                        *(f32x4*)(Z + off + bj * HALF + n * 16) = r * alpha + acc[ai][bj][m][n]; }
                asm volatile("" ::: "memory"); }
    }
};
struct EpiResBf16 {
    static constexpr bool PERM = true;
    bf16_t* Z; const float* res; float alpha; const bf16_t* resb;
    DI void operator()(const f32x4 (&acc)[2][2][4][2], const Unit& u, int wr, int wc, int fr, int fq) const {
        const int row0 = u.orow + wr * 64 + fr, col0 = u.ocol + wc * 32 + 8 * fq;
#pragma unroll
        for (int ai = 0; ai < 2; ++ai)
#pragma unroll
            for (int m = 0; m < 4; ++m) { const size_t off = (size_t)(row0 + ai * HALF + m * 16) * D + col0;
#pragma unroll
                for (int bj = 0; bj < 2; ++bj) { f32x4 r0, r1;
                    if (resb) { const u32x4 rw = *(const u32x4*)(resb + off + bj * HALF); r0 = (f32x4){bflo(rw.x), bfhi(rw.x), bflo(rw.y), bfhi(rw.y)}; r1 = (f32x4){bflo(rw.z), bfhi(rw.z), bflo(rw.w), bfhi(rw.w)}; }
                    else { r0 = *(const f32x4*)(res + off + bj * HALF); r1 = *(const f32x4*)(res + off + bj * HALF + 4); }
                    const f32x4 v0 = r0 * alpha + acc[ai][bj][m][0], v1 = r1 * alpha + acc[ai][bj][m][1];
                    u32x4 w; w.x = cvt_pk_bf16(v0[0], v0[1]); w.y = cvt_pk_bf16(v0[2], v0[3]); w.z = cvt_pk_bf16(v1[0], v1[1]); w.w = cvt_pk_bf16(v1[2], v1[3]);
                    *(u32x4*)(Z + off + bj * HALF) = w; }
                asm volatile("" ::: "memory"); }
    }
};
struct EpiSwiglu {
    static constexpr bool PERM = true;
    unsigned char* O; const float* b1;
    DI void operator()(const f32x4 (&acc)[2][2][4][2], const Unit& u, int wr, int wc, int fr, int fq) const {
        const int row0 = u.orow + wr * 64 + fr, g0 = (u.ocol >> 1) + wc * 32 + 8 * fq;
        f32x4 bg[2], bu[2];
#pragma unroll
        for (int n = 0; n < 2; ++n) { bg[n] = *(const f32x4*)(b1 + (size_t)u.e * 2048 + g0 + 4 * n); bu[n] = *(const f32x4*)(b1 + (size_t)u.e * 2048 + 1024 + g0 + 4 * n); }
#pragma unroll
        for (int ai = 0; ai < 2; ++ai)
#pragma unroll
            for (int m = 0; m < 4; ++m) { unsigned char* rowp = O + (size_t)(row0 + ai * HALF + m * 16) * DEXP + g0;
                float o[8];
#pragma unroll
                for (int n = 0; n < 2; ++n)
#pragma unroll
                    for (int q = 0; q < 4; q += 2) {
                        f32x2 gt = (f32x2){acc[ai][0][m][n][q], acc[ai][0][m][n][q + 1]} + (f32x2){bg[n][q], bg[n][q + 1]};
                        f32x2 up = (f32x2){acc[ai][1][m][n][q], acc[ai][1][m][n][q + 1]} + (f32x2){bu[n][q], bu[n][q + 1]};
                        gt.x = fminf(gt.x, 7.0f); gt.y = fminf(gt.y, 7.0f);
                        up.x = __builtin_amdgcn_fmed3f(up.x, -7.0f, 7.0f); up.y = __builtin_amdgcn_fmed3f(up.y, -7.0f, 7.0f);
                        const f32x2 x = gt * (-2.45546696f);
                        f32x2 e; e.x = __builtin_amdgcn_exp2f(x.x); e.y = __builtin_amdgcn_exp2f(x.y);
                        const f32x2 d = e + 1.0f;
                        f32x2 sg; sg.x = __builtin_amdgcn_rcpf(d.x); sg.y = __builtin_amdgcn_rcpf(d.y);
                        const f32x2 u4 = up * 4.0f + 4.0f;
                        const f32x2 r = u4 * (gt * sg);
                        o[n * 4 + q] = r.x; o[n * 4 + q + 1] = r.y;
                    }
                u32x2 w; w.x = pk4_fp8(o[0], o[1], o[2], o[3]); w.y = pk4_fp8(o[4], o[5], o[6], o[7]);
                *(u32x2*)rowp = w; }
    }
};

typedef int v8i_t __attribute__((ext_vector_type(8)));
template <class Epi, class Sched, int AM, bool FP8 = false>
DI void gemm_phase(LAS unsigned char* lds, const Gemm g, const Sched& S, const Epi& E, const int tid) {
    constexpr bool GATHER = (AM != 0);
    const int wid = __builtin_amdgcn_readfirstlane(tid >> 6), lane = tid & 63, wr = wid >> 2, wc = wid & 3, fr = lane & 15, fq = lane >> 4;
    const int K = g.K, nt = K / (BK * 2);
    unsigned voffA[2], voffB[2];
#pragma unroll
    for (int i = 0; i < 2; ++i) { int R, C; stage_rc(tid * 16 + i * 8192, R, C); const int Rb = Epi::PERM ? ((R & ~31) + perm32(R & 31)) : R;
        voffA[i] = (unsigned)(R * K + C * 2); voffB[i] = (unsigned)(Rb * K + C * 2); }
    const size_t kstep = (size_t)(BK * 2);
    const size_t hstep = (size_t)HALF * K;
    const unsigned ldsw = (unsigned)wid * 1024u;
    const int aoff = lds_byte(wr * 64 + fr, fq * 8), boff = lds_byte(wc * 32 + fr, fq * 8);
    LAS unsigned* toktab = (LAS unsigned*)(lds + TOKTAB_OFF);
#define PG8_SA(b, h) (((b) * 2 + (h)) * HTB)
#define PG8_SB(b, h) ((4 + (b) * 2 + (h)) * HTB)
#define PG8_STAGE(bufoff, gbase, voff) do { _Pragma("unroll") for (int _i = 0; _i < 2; ++_i) \
        __builtin_amdgcn_global_load_lds((const unsigned*)((const char*)(gbase) + (voff)[_i]), (LAS unsigned*)(lds + (bufoff) + ldsw + _i * 8192), 16, 0, 0); } while (0)
#define PG8_STAGE_A(bufoff, base, h) do { if constexpr (GATHER) { _Pragma("unroll") for (int _i = 0; _i < 2; ++_i) \
        __builtin_amdgcn_global_load_lds((const unsigned*)((const char*)(base) + vA[h][_i]), (LAS unsigned*)(lds + (bufoff) + ldsw + _i * 8192), 16, 0, 0); } \
        else { PG8_STAGE(bufoff, (const char*)(base) + (h) * hstep, voffA); } } while (0)
#define PG8_VA_DIRECT(row0) do { _Pragma("unroll") for (int h = 0; h < 2; ++h) _Pragma("unroll") for (int i = 0; i < 2; ++i) { int R, C; stage_rc(tid * 16 + i * 8192, R, C); \
        vA[h][i] = (unsigned)((row0) + h * HALF + R) * (unsigned)K + (unsigned)C * 2u; } } while (0)
#define PG8_VA_FROM(tab) do { _Pragma("unroll") for (int h = 0; h < 2; ++h) _Pragma("unroll") for (int i = 0; i < 2; ++i) { int R, C; stage_rc(tid * 16 + i * 8192, R, C); \
        const unsigned tk = (tab)[h * HALF + R] & 0xffffu; vA[h][i] = tk * (unsigned)K + (unsigned)C * 2u; } } while (0)
#define PG8_LD2(p) __builtin_bit_cast(v8i_t, __builtin_shufflevector(*(const LAS bf16x8*)(p), *(const LAS bf16x8*)((p) + 1024), 0, 1, 2, 3, 4, 5, 6, 7, 8, 9, 10, 11, 12, 13, 14, 15))
#define PG8_LDA(dst, b, h) do { _Pragma("unroll") for (int m = 0; m < 4; ++m) dst[m] = PG8_LD2(lds + PG8_SA(b, h) + aoff + m * 2048); } while (0)
#define PG8_LDB(dst, b, h) do { _Pragma("unroll") for (int n = 0; n < 2; ++n) dst[n] = PG8_LD2(lds + PG8_SB(b, h) + boff + n * 2048); } while (0)
#define PG8_HALF(v, k) __builtin_bit_cast(bf16x8, __builtin_shufflevector(v, v, 4 * (k), 4 * (k) + 1, 4 * (k) + 2, 4 * (k) + 3))
#define PG8_MMA(ai, bj, At, Bt) do { __builtin_amdgcn_s_setprio(1); _Pragma("unroll") for (int m = 0; m < 4; ++m) _Pragma("unroll") for (int n = 0; n < 2; ++n) { \
        if constexpr (FP8) { acc[ai][bj][m][n] = __builtin_amdgcn_mfma_scale_f32_16x16x128_f8f6f4(Bt[n], At[m], acc[ai][bj][m][n], 0, 0, 0, g.sb, 0, g.sa); } \
        else { acc[ai][bj][m][n] = __builtin_amdgcn_mfma_f32_16x16x32_bf16(PG8_HALF(Bt[n], 0), PG8_HALF(At[m], 0), acc[ai][bj][m][n], 0, 0, 0); \
               acc[ai][bj][m][n] = __builtin_amdgcn_mfma_f32_16x16x32_bf16(PG8_HALF(Bt[n], 1), PG8_HALF(At[m], 1), acc[ai][bj][m][n], 0, 0, 0); } } \
        __builtin_amdgcn_s_setprio(0); } while (0)
#define PG8_WAIT_V(n) asm volatile("s_waitcnt vmcnt(" #n ")" ::: "memory")
#define PG8_WAIT_L(n) asm volatile("s_waitcnt lgkmcnt(" #n ")" ::: "memory")
#define PG8_BAR __builtin_amdgcn_s_barrier()
#define PG8_SCHED __builtin_amdgcn_sched_barrier(0)
    Unit cur, nxt; int ui = 0;
    if (!S.next(0, cur)) return;
    f32x4 acc[2][2][4][2];
#pragma unroll
    for (int a = 0; a < 2; ++a)
#pragma unroll
        for (int b = 0; b < 2; ++b)
#pragma unroll
            for (int m = 0; m < 4; ++m)
#pragma unroll
                for (int n = 0; n < 2; ++n) acc[a][b][m][n] = (f32x4){0.f, 0.f, 0.f, 0.f};
    v8i_t At[4], B0[2], B1[2];
    unsigned vA[2][2];
    if constexpr (AM == 1) { PG8_VA_FROM(g.list + cur.arow); } else if constexpr (AM == 2) { PG8_VA_DIRECT(cur.arow); }
    else {
#pragma unroll
        for (int h = 0; h < 2; ++h)
#pragma unroll
            for (int i = 0; i < 2; ++i) vA[h][i] = 0u;
    }
    const char* cA = GATHER ? (const char*)g.A : (const char*)((Sched::DUAL && cur.e) ? g.A2 : g.A) + (size_t)cur.arow * K;
    const char* cB = (const char*)((Sched::DUAL && cur.e) ? g.Bt2 : g.Bt) + (size_t)cur.brow * K;
    PG8_STAGE(PG8_SB(0, 0), cB, voffB); PG8_STAGE(PG8_SB(0, 1), cB + hstep, voffB); PG8_STAGE_A(PG8_SA(0, 0), cA, 0); PG8_STAGE_A(PG8_SA(0, 1), cA, 1);
    if (wr == 1) PG8_BAR;
    PG8_WAIT_V(2); PG8_BAR;
    PG8_STAGE(PG8_SB(1, 0), cB + kstep, voffB); PG8_STAGE_A(PG8_SA(1, 0), cA + kstep, 0); PG8_STAGE(PG8_SB(1, 1), cB + hstep + kstep, voffB);
    PG8_WAIT_V(6); PG8_BAR;
    for (;;) {
        const bool has_next = S.next(ui + 1, nxt);
        const char* nA = GATHER ? (const char*)g.A : (has_next ? (const char*)((Sched::DUAL && nxt.e) ? g.A2 : g.A) + (size_t)nxt.arow * K : cA);
        const char* nB = has_next ? (const char*)((Sched::DUAL && nxt.e) ? g.Bt2 : g.Bt) + (size_t)nxt.brow * K : cB;
        if constexpr (AM == 1) {
            if (has_next && wid < 4)
                __builtin_amdgcn_global_load_lds((const unsigned*)(g.list + nxt.arow + wid * 64 + lane), (LAS unsigned*)(toktab + ((ui + 1) & 1) * 256 + wid * 64), 4, 0, 0);
        }
#pragma clang loop unroll(disable)
        for (int t = 0; t < nt; t += 2) {
            const bool last = (t == nt - 2);
            const char* a1 = cA + (size_t)(t + 1) * kstep;
            const char* a2 = last ? nA : cA + (size_t)(t + 2) * kstep; const char* b2 = last ? nB : cB + (size_t)(t + 2) * kstep;
            const char* a3 = a2 + kstep; const char* b3 = b2 + kstep;
            PG8_LDB(B0, 0, 0); PG8_LDB(B1, 0, 1); PG8_SCHED; PG8_LDA(At, 0, 0); PG8_STAGE_A(PG8_SA(1, 1), a1, 1);
            if constexpr (AM == 1) { if (last && has_next) { PG8_VA_FROM(toktab + ((ui + 1) & 1) * 256); } } else if constexpr (AM == 2) { if (last && has_next) { PG8_VA_DIRECT(nxt.arow); } }
            PG8_WAIT_V(8); PG8_WAIT_L(0); PG8_BAR; PG8_MMA(0, 0, At, B0); PG8_MMA(0, 1, At, B1); PG8_BAR; PG8_SCHED;
            PG8_LDA(At, 0, 1); PG8_STAGE(PG8_SB(0, 0), b2, voffB); PG8_STAGE(PG8_SB(0, 1), b2 + hstep, voffB); PG8_STAGE_A(PG8_SA(0, 0), a2, 0);
            PG8_WAIT_V(8); PG8_WAIT_L(0); PG8_BAR; PG8_MMA(1, 0, At, B0); PG8_MMA(1, 1, At, B1); PG8_BAR; PG8_SCHED;
            PG8_LDB(B0, 1, 0); PG8_LDB(B1, 1, 1); PG8_SCHED; PG8_LDA(At, 1, 0); PG8_STAGE_A(PG8_SA(0, 1), a2, 1);
            PG8_WAIT_V(8); PG8_WAIT_L(0); PG8_BAR; PG8_MMA(0, 0, At, B0); PG8_MMA(0, 1, At, B1); PG8_BAR; PG8_SCHED;
            PG8_LDA(At, 1, 1); PG8_STAGE(PG8_SB(1, 0), b3, voffB); PG8_STAGE(PG8_SB(1, 1), b3 + hstep, voffB); PG8_STAGE_A(PG8_SA(1, 0), a3, 0);
            PG8_WAIT_V(8); PG8_WAIT_L(0); PG8_BAR; PG8_MMA(1, 0, At, B0); PG8_MMA(1, 1, At, B1); PG8_BAR; PG8_SCHED;
        }
        if (wr == 0) PG8_BAR;
        E(acc, cur, wr, wc, fr, fq);
        if (!has_next) break;
#pragma unroll
        for (int a = 0; a < 2; ++a)
#pragma unroll
            for (int b = 0; b < 2; ++b)
#pragma unroll
                for (int m = 0; m < 4; ++m)
#pragma unroll
                    for (int n = 0; n < 2; ++n) acc[a][b][m][n] = (f32x4){0.f, 0.f, 0.f, 0.f};
        cur = nxt; cA = nA; cB = nB; ++ui;
        if (wr == 1) PG8_BAR;
    }
    PG8_WAIT_V(0);
    PG8_BAR;
#undef PG8_SA
#undef PG8_SB
#undef PG8_STAGE
#undef PG8_STAGE_A
#undef PG8_VA_FROM
#undef PG8_VA_DIRECT
#undef PG8_LDA
#undef PG8_LD2
#undef PG8_HALF
#undef PG8_LDB
#undef PG8_MMA
#undef PG8_WAIT_V
#undef PG8_WAIT_L
#undef PG8_BAR
#undef PG8_SCHED
}
}

struct Ctx {
    LAS unsigned char* lds;
    int tid, lane, wave, G, bx;
    unsigned* ctl;
    unsigned char* ws;
    float* out;
};
DI const float* inp(const Ctx& F, int i) {
    const LAS unsigned* p = (const LAS unsigned*)(F.lds + PTAB_OFF) + 2 * i;
    const unsigned lo = (unsigned)__builtin_amdgcn_readfirstlane((int)p[0]), hi = (unsigned)__builtin_amdgcn_readfirstlane((int)p[1]);
    return (const float*)(const GAS float*)(((unsigned long long)hi << 32) | lo);
}
DI void launder(Ctx& F) { int t = F.wave * 64 + shfl_lane(); asm volatile("" : "+v"(t)); F.tid = t; F.lane = t & 63;
    const unsigned long long w = (unsigned long long)F.ws; int wl = __builtin_amdgcn_readfirstlane((int)(unsigned)w), wh = __builtin_amdgcn_readfirstlane((int)(unsigned)(w >> 32));
    asm volatile("" : "+s"(wl), "+s"(wh)); F.ws = (unsigned char*)(GAS unsigned char*)(((unsigned long long)(unsigned)wh << 32) | (unsigned)wl); F.ctl = (unsigned*)(F.ws + WS_CTL);
    int ll = __builtin_amdgcn_readfirstlane((int)(unsigned)(size_t)F.lds); asm volatile("" : "+s"(ll)); F.lds = (LAS unsigned char*)(size_t)(unsigned)ll;
    int gg = __builtin_amdgcn_readfirstlane(F.G), bb = __builtin_amdgcn_readfirstlane(F.bx); asm volatile("" : "+s"(gg), "+s"(bb)); F.G = gg; F.bx = bb; }
enum { I_X = 0, I_MEM, I_RELB, I_AWIN, I_ACONVW, I_ACONVB, I_AWR, I_ABR, I_AWI, I_ABI, I_ALAM, I_BWIN, I_BKVG, I_BWUK, I_BWUV, I_BIDXG, I_BIDXB,
       I_WMEMKV, I_WOUT, I_LN1G, I_LN1B, I_ROUTW, I_ROUTB, I_W1, I_B1, I_W2, I_B2, I_LN2G, I_LN2B };

DI void tr_item(const float* W, int sstride, bf16_t* dst, int dstride, int k0, int nvalid, LAS float* scr, int lane, bf16_t* dst_lo) {
    float v[32];
#pragma unroll
    for (int i = 0; i < 32; ++i) { const int kk = 2 * i + (lane >> 5), nn = lane & 31; const float x = W[(size_t)(k0 + kk) * sstride + (nn < nvalid ? nn : 0)]; v[i] = (nn < nvalid) ? x : 0.f; }
#pragma unroll
    for (int i = 0; i < 32; ++i) { const int kk = 2 * i + (lane >> 5); scr[kk * 33 + (lane & 31)] = v[i]; }
    LDS_WAIT();
    const int c = lane & 7;
#pragma unroll
    for (int j = 0; j < 4; ++j) { const int n = (lane >> 3) + 8 * j; const LAS float* s = scr + (8 * c) * 33 + n;
        float f[8];
#pragma unroll
        for (int q = 0; q < 8; ++q) f[q] = s[q * 33];
        u32x4 o; o.x = cvt_pk_bf16(f[0], f[1]); o.y = cvt_pk_bf16(f[2], f[3]); o.z = cvt_pk_bf16(f[4], f[5]); o.w = cvt_pk_bf16(f[6], f[7]);
        if (n < nvalid) *(u32x4*)(dst + (size_t)n * dstride + k0 + 8 * c) = o;
        if (dst_lo) {
            float r[8];
            r[0] = f[0] - bflo(o.x); r[1] = f[1] - bfhi(o.x); r[2] = f[2] - bflo(o.y); r[3] = f[3] - bfhi(o.y);
            r[4] = f[4] - bflo(o.z); r[5] = f[5] - bfhi(o.z); r[6] = f[6] - bflo(o.w); r[7] = f[7] - bfhi(o.w);
            u32x4 l; l.x = cvt_pk_bf16(r[0], r[1]); l.y = cvt_pk_bf16(r[2], r[3]); l.z = cvt_pk_bf16(r[4], r[5]); l.w = cvt_pk_bf16(r[6], r[7]);
            if (n < nvalid) *(u32x4*)(dst_lo + (size_t)n * dstride + k0 + 8 * c) = l;
        }
    }
    LDS_WAIT();
}

DI void tr8_load(const float* W, int sstride, int k0, int lane, float (&v)[32]) {
#pragma unroll
    for (int i = 0; i < 32; ++i) { const int kk = 2 * i + (lane >> 5), nn = lane & 31; v[i] = W[(size_t)(k0 + kk) * sstride + nn]; }
}
DI void tr8_store(const float (&v)[32], unsigned char* dst, int dstride, int k0, float scale, LAS float* scr, int lane) {
#pragma unroll
    for (int i = 0; i < 32; ++i) { const int kk = 2 * i + (lane >> 5); scr[kk * 33 + (lane & 31)] = v[i] * scale; }
    LDS_WAIT();
    const int c = lane & 3;
#pragma unroll
    for (int j = 0; j < 2; ++j) { const int n = (lane >> 2) + 16 * j; const LAS float* sp = scr + (16 * c) * 33 + n;
        float f[16];
#pragma unroll
        for (int q = 0; q < 16; ++q) f[q] = sp[q * 33];
        u32x4 o; o.x = pk4_fp8(f[0], f[1], f[2], f[3]); o.y = pk4_fp8(f[4], f[5], f[6], f[7]); o.z = pk4_fp8(f[8], f[9], f[10], f[11]); o.w = pk4_fp8(f[12], f[13], f[14], f[15]);
        *(u32x4*)(dst + (size_t)n * dstride + k0 + 16 * c) = o; }
    LDS_WAIT();
}
DI void tr8_item(const float* W, int sstride, unsigned char* dst, int dstride, int k0, int nvalid, float scale, LAS float* scr, int lane) {
    float v[32];
#pragma unroll
    for (int i = 0; i < 32; ++i) { const int kk = 2 * i + (lane >> 5), nn = lane & 31; const float x = W[(size_t)(k0 + kk) * sstride + (nn < nvalid ? nn : 0)]; v[i] = (nn < nvalid) ? x : 0.f; }
#pragma unroll
    for (int i = 0; i < 32; ++i) { const int kk = 2 * i + (lane >> 5); scr[kk * 33 + (lane & 31)] = v[i] * scale; }
    LDS_WAIT();
    const int c = lane & 3;
#pragma unroll
    for (int j = 0; j < 2; ++j) { const int n = (lane >> 2) + 16 * j; const LAS float* sp = scr + (16 * c) * 33 + n;
        float f[16];
#pragma unroll
        for (int q = 0; q < 16; ++q) f[q] = sp[q * 33];
        u32x4 o; o.x = pk4_fp8(f[0], f[1], f[2], f[3]); o.y = pk4_fp8(f[4], f[5], f[6], f[7]); o.z = pk4_fp8(f[8], f[9], f[10], f[11]); o.w = pk4_fp8(f[12], f[13], f[14], f[15]);
        if (n < nvalid) *(u32x4*)(dst + (size_t)n * dstride + k0 + 16 * c) = o; }
    LDS_WAIT();
}
struct Tr8Item { const float* W; int sstride; unsigned char* dst; int k0; float scale; };
DI Tr8Item tr8_decode(const Ctx& F, int it) {
    constexpr int I1 = 16 * 64, I2 = 16 * 32;
    const int le = it / (I1 + I2); int r = it % (I1 + I2); Tr8Item t;
    if (r < I1) { const int kb = r / 64, nb = r % 64; const int n0 = nb * 32;
        const int drow = (n0 < 1024) ? (256 * (n0 / 128) + (n0 % 128)) : (256 * ((n0 - 1024) / 128) + 128 + ((n0 - 1024) % 128));
        t.W = inp(F, I_W1) + (size_t)le * 1024 * 2048 + n0; t.sstride = 2048; t.dst = F.ws + WS_W1 + ((size_t)le * 2048 + drow) * 1024; t.k0 = kb * 64; t.scale = 32.0f;
    } else { r -= I1; const int kb = r / 32, nb = r % 32; const int n0 = nb * 32;
        t.W = inp(F, I_W2) + (size_t)le * 1024 * 1024 + n0; t.sstride = 1024; t.dst = F.ws + WS_W2 + ((size_t)le * 1024 + n0) * 1024; t.k0 = kb * 64; t.scale = 64.0f; }
    return t;
}

DI void p0_prologue(Ctx& F) {
    LAS float* scr = (LAS float*)(F.lds + F.wave * 16384);
    const int gw = F.bx * 8 + F.wave, NGW = F.G * 8, lane = F.lane;
    unsigned char* ws = F.ws;
    {
        constexpr int NIT = 64 * (16 * 64 + 16 * 32);
#define TR8_STAGE(vb_, idx_) do { const int ii_ = (idx_) < NIT ? (idx_) : NIT - 1; const Tr8Item t_ = tr8_decode(F, ii_); tr8_load(t_.W, t_.sstride, t_.k0, lane, vb_); } while (0)
#define TR8_DRAIN(vb_, idx_) do { if ((idx_) < NIT) { const Tr8Item c_ = tr8_decode(F, (idx_)); tr8_store(vb_, c_.dst, 1024, c_.k0, c_.scale, scr, lane); } } while (0)
        float v0[32], v1[32], v2[32];
        TR8_STAGE(v0, gw); TR8_STAGE(v1, gw + NGW);
        for (int it = gw; it < NIT; it += 3 * NGW) {
            TR8_STAGE(v2, it + 2 * NGW); __builtin_amdgcn_sched_barrier(0); TR8_DRAIN(v0, it); __builtin_amdgcn_sched_barrier(0);
            TR8_STAGE(v0, it + 3 * NGW); __builtin_amdgcn_sched_barrier(0); TR8_DRAIN(v1, it + NGW); __builtin_amdgcn_sched_barrier(0);
            TR8_STAGE(v1, it + 4 * NGW); __builtin_amdgcn_sched_barrier(0); TR8_DRAIN(v2, it + 2 * NGW); __builtin_amdgcn_sched_barrier(0);
        }
#undef TR8_STAGE
#undef TR8_DRAIN
    }
    {
        constexpr int IA = 16 * 56;
        constexpr int IB = 16 * 47;
        constexpr int IKV = 2 * 16 * 16;
        constexpr int IO = 2 * 16 * 32;
        constexpr int IR = 12 * 2 * 2;
        constexpr int IUV = 12 * 2 * 2;
        constexpr int IRT = 2 * 16;
        constexpr int NIT = IA + IB + IKV + IO + IR + IUV + IRT;
        for (int it = gw; it < NIT; it += NGW) {
            int r = it;
            if (r < IA) { const int kb = r / 56, nb = r % 56; tr8_item(inp(F, I_AWIN) + nb * 32, WINA, ws + WS_WINA + (size_t)(nb * 32) * 1024, 1024, kb * 64, 32, 32.0f, scr, lane); continue; } r -= IA;
            if (r < IB) { const int kb = r / 47, nb = r % 47;
                const int scol = (nb < 38) ? nb * 32 : (nb == 38) ? 1216 : 1220 + (nb - 39) * 32, drow = (nb < 38) ? nb * 32 : (nb == 38) ? B_IW : B_MQ + (nb - 39) * 32, nv = (nb == 38) ? 4 : 32;
                tr8_item(inp(F, I_BWIN) + scol, WINB, ws + WS_WINB + (size_t)drow * 1024, 1024, kb * 64, nv, 32.0f, scr, lane); continue; } r -= IB;
            if (r < IKV) { const int l = r / 256, q = r % 256, kb = q / 16, nb = q % 16; tr_item(inp(F, I_WMEMKV) + (size_t)l * 1024 * 512 + nb * 32, 512, (bf16_t*)(ws + WS_WKV) + (size_t)(l * 512 + nb * 32) * 1024, 1024, kb * 64, 32, scr, lane, nullptr); continue; } r -= IKV;
            if (r < IO) { const int l = r / 512, q = r % 512, kb = q / 32, nb = q % 32;
                if (l == 0) tr_item(inp(F, I_WOUT) + nb * 32, 1024, (bf16_t*)(ws + WS_WOUT) + (size_t)(nb * 32) * 1024, 1024, kb * 64, 32, scr, lane, nullptr);
                else tr8_item(inp(F, I_WOUT) + (size_t)1024 * 1024 + nb * 32, 1024, ws + WS_WOUT + (size_t)1024 * 1024 * 2 + (size_t)(nb * 32) * 1024, 1024, kb * 64, 32, 32.0f, scr, lane);
                continue; } r -= IO;
            if (r < IR) { const int n = r / 4, g = (r >> 1) & 1, nb = r & 1; const float* src = (g ? inp(F, I_AWI) : inp(F, I_AWR)) + (size_t)n * 4096 + nb * 32;
                tr_item(src, 64, (bf16_t*)(ws + WS_WRT) + ((size_t)(n * 2 + g) * 64 + nb * 32) * 64, 64, 0, 32, scr, lane, nullptr); continue; } r -= IR;
            if (r < IUV) { const int h = r / 4, kb = (r >> 1) & 1, nb = r & 1; tr_item(inp(F, I_BWUV) + h * 64 + nb * 32, 768, (bf16_t*)(ws + WS_WUVT) + ((size_t)h * 64 + nb * 32) * 128, 128, kb * 64, 32, scr, lane, nullptr); continue; } r -= IUV;
            { const int l = r / 16, kb = r % 16; bf16_t* hi = (bf16_t*)(ws + WS_ROUT) + (size_t)(l * 2) * 32 * 1024; tr_item(inp(F, I_ROUTW) + (size_t)l * 1024 * 32, 32, hi, 1024, kb * 64, 32, scr, lane, hi + 32 * 1024); }
        }
    }
    {
        const size_t gt = (size_t)F.bx * 512 + F.tid, NT = (size_t)F.G * 512;
        const f32x4* x4 = (const f32x4*)inp(F, I_X); unsigned* xb = (unsigned*)(ws + WS_XB8);
        for (size_t i = gt; i < (size_t)T * D / 4; i += NT) { const f32x4 v = x4[i]; xb[i] = pk4_fp8(v[0] * 4.0f, v[1] * 4.0f, v[2] * 4.0f, v[3] * 4.0f); }
        const f32x4* m4 = (const f32x4*)inp(F, I_MEM); u32x2* mb = (u32x2*)(ws + WS_MEMBF);
        for (size_t i = gt; i < (size_t)NB * MEML * D / 4; i += NT) { const f32x4 v = m4[i]; u32x2 o; o.x = cvt_pk_bf16(v[0], v[1]); o.y = cvt_pk_bf16(v[2], v[3]); mb[i] = o; }
        bf16_t* wuk = (bf16_t*)(ws + WS_WUK);
        for (size_t i = gt; i < (size_t)128 * 12 * 64; i += NT) { const int d = (int)(i & 63), h = (int)((i >> 6) % 12), rr = (int)(i / 768); wuk[((size_t)h * 128 + rr) * 64 + d] = f2bf(inp(F, I_BWUK)[i]); }
        unsigned* pad = (unsigned*)(ws + WS_WINB + (size_t)WINB * 1024);
        for (size_t i = gt; i < (size_t)(WINBP - WINB) * 1024 / 4; i += NT) pad[i] = 0u;
    }
}

constexpr int LC = 128, NCHUNK = SEQ / LC;
template <int PASS> DI void lru_phase(Ctx& F) {
    LAS unsigned char* lds = F.lds;
    LAS bf16_t* XC = (LAS bf16_t*)lds;
    LAS float* AA = (LAS float*)(lds + 18432);
    LAS float* UU = (LAS float*)(lds + 51200);
    LAS float* SEG = (LAS float*)(lds + 83968);
    LAS float* CSEG = (LAS float*)(lds + 88832);
    LAS float* PARA = (LAS float*)(lds + 92928);
    LAS float* CW = (LAS float*)(lds + 92928 + 9216);
    const int tid = F.tid, lane = F.lane, w = F.wave, fr = lane & 15, fq = lane >> 4;
    const bf16_t* PROJ = (const bf16_t*)(F.ws + WS_PROJ);
    const bf16_t* WRT = (const bf16_t*)(F.ws + WS_WRT);
    float* LSUM = (float*)(F.ws + WS_LSUM);
    bf16_t* MIX = (bf16_t*)(F.ws + WS_MIX);
    __syncthreads();
    for (int i = tid; i < TOKW; i += 512) { PARA[i] = inp(F, I_ABR)[i]; PARA[TOKW + i] = inp(F, I_ABI)[i]; PARA[2 * TOKW + i] = 8.0f * log1pf(__expf(-inp(F, I_ALAM)[i])); CW[4 * TOKW + i] = inp(F, I_ACONVB)[i]; }
    for (int i = tid; i < 4 * TOKW; i += 512) CW[i] = inp(F, I_ACONVW)[i];
    u32x4 xin[2][4];
#define LRU_LOAD_X(uu) do { const int n_ = (uu) % 12, k_ = ((uu) / 12) % NCHUNK, b_ = (uu) / (12 * NCHUNK); const size_t r0_ = (size_t)b_ * SEQ + (size_t)k_ * LC; \
        _Pragma("unroll") for (int it = 0; it < 2; ++it) { const int item = tid + 512 * it, t = item >> 3, c8 = item & 7, ch = n_ * 64 + c8 * 8; \
            _Pragma("unroll") for (int j = 0; j < 4; ++j) { const int sp = k_ * LC + t - 3 + j; xin[it][j] = (sp >= 0) ? *(const u32x4*)(PROJ + (r0_ + t - 3 + j) * WINA + ch) : (u32x4){0u, 0u, 0u, 0u}; } } } while (0)
    if (F.bx < NB * NCHUNK * 12) LRU_LOAD_X(F.bx);
    for (int u = F.bx; u < NB * NCHUNK * 12; u += F.G) {
        const int n = u % 12, k = (u / 12) % NCHUNK, b = u / (12 * NCHUNK);
        const size_t row0 = (size_t)b * SEQ + (size_t)k * LC;
        __syncthreads();
        const LAS float* PAR = PARA + n * 64;
        if (PASS == 1) {
            const int d = tid & 63, seg = tid >> 6; float A = 1.f, H = 0.f; f32x2 sv[8];
#pragma unroll
            for (int q = 0; q < 8; ++q) { const int kk = seg * 8 + q; sv[q] = (kk < k) ? *(const f32x2*)(LSUM + (((size_t)b * NCHUNK + kk) * TOKW + n * 64 + d) * 2) : (f32x2){1.f, 0.f}; }
#pragma unroll
            for (int q = 0; q < 8; ++q) { H = sv[q].x * H + sv[q].y; A *= sv[q].x; }
            CSEG[(seg * 64 + d) * 2] = A; CSEG[(seg * 64 + d) * 2 + 1] = H;
        }
#pragma unroll
        for (int it = 0; it < 2; ++it) {
            const int item = tid + 512 * it, t = item >> 3, c8 = item & 7, ch = n * 64 + c8 * 8;
            float accv[8];
            { const f32x4 b0 = *(const LAS f32x4*)(CW + 4 * TOKW + ch), b1 = *(const LAS f32x4*)(CW + 4 * TOKW + ch + 4);
#pragma unroll
              for (int q = 0; q < 4; ++q) { accv[q] = b0[q]; accv[4 + q] = b1[q]; } }
#pragma unroll
            for (int j = 0; j < 4; ++j) {
                const u32x4 xv = xin[it][j];
                const f32x4 w0 = *(const LAS f32x4*)(CW + j * TOKW + ch), w1 = *(const LAS f32x4*)(CW + j * TOKW + ch + 4);
                accv[0] += w0[0] * bflo(xv.x); accv[1] += w0[1] * bfhi(xv.x); accv[2] += w0[2] * bflo(xv.y); accv[3] += w0[3] * bfhi(xv.y);
                accv[4] += w1[0] * bflo(xv.z); accv[5] += w1[1] * bfhi(xv.z); accv[6] += w1[2] * bflo(xv.w); accv[7] += w1[3] * bfhi(xv.w);
            }
            u32x4 o; o.x = cvt_pk_bf16(accv[0], accv[1]); o.y = cvt_pk_bf16(accv[2], accv[3]); o.z = cvt_pk_bf16(accv[4], accv[5]); o.w = cvt_pk_bf16(accv[6], accv[7]);
            *(LAS u32x4*)(XC + t * 72 + c8 * 8) = o;
        }
        if (u + F.G < NB * NCHUNK * 12) LRU_LOAD_X(u + F.G);
        unsigned short gbv[16];
        if (PASS == 1) { const bf16_t* gbp = PROJ + (row0 + (tid >> 6) * 16) * WINA + TOKW + n * 64 + (tid & 63);
#pragma unroll
            for (int q = 0; q < 16; ++q) gbv[q] = gbp[(size_t)q * WINA]; }
        __syncthreads();
        {
            bf16x8 xb[2];
#pragma unroll
            for (int ks = 0; ks < 2; ++ks) xb[ks] = *(const LAS bf16x8*)(XC + (16 * w + fr) * 72 + ks * 32 + fq * 8);
            f32x4 acc[2][4];
#pragma unroll
            for (int g = 0; g < 2; ++g)
#pragma unroll
                for (int j = 0; j < 4; ++j) { acc[g][j] = (f32x4){0.f, 0.f, 0.f, 0.f};
#pragma unroll
                    for (int ks = 0; ks < 2; ++ks) { const bf16x8 wf = *(const bf16x8*)(WRT + ((size_t)(n * 2 + g) * 64 + 16 * j + fr) * 64 + ks * 32 + fq * 8); acc[g][j] = MFMA16(wf, xb[ks], acc[g][j]); } }
            const int t = 16 * w + fr;
#pragma unroll
            for (int j = 0; j < 4; ++j) {
                const int d0 = 16 * j + 4 * fq;
                const f32x4 br = *(const LAS f32x4*)(PAR + d0), bi = *(const LAS f32x4*)(PAR + TOKW + d0), sp = *(const LAS f32x4*)(PAR + 2 * TOKW + d0);
                const u32x2 xw = *(const LAS u32x2*)(XC + t * 72 + d0);
                const float xcv[4] = {bflo(xw.x), bfhi(xw.x), bflo(xw.y), bfhi(xw.y)};
                f32x4 av, uv;
#pragma unroll
                for (int q = 0; q < 4; ++q) {
                    const float rg = sigmoidf_(acc[0][j][q] + br[q]), ig = sigmoidf_(acc[1][j][q] + bi[q]);
                    const float la = -sp[q] * rg; const float a = __expf(la); const float x2 = 2.0f * la;
                    const float om = (x2 > -0.1f) ? (-x2 * (1.0f + x2 * (0.5f + x2 * (0.16666667f + x2 * 0.041666667f)))) : (1.0f - a * a);
                    av[q] = a; uv[q] = sqrtf(om) * ig * xcv[q];
                }
                *(LAS f32x4*)(AA + t * 64 + d0) = av; *(LAS f32x4*)(UU + t * 64 + d0) = uv;
            }
        }
        __syncthreads();
        const int d = tid & 63, seg = tid >> 6;
        {
            float A = 1.f, H = 0.f;
#pragma unroll
            for (int q = 0; q < 16; ++q) { const int t = seg * 16 + q; const float a = AA[t * 64 + d], uu = UU[t * 64 + d]; H = a * H + uu; A *= a; }
            SEG[(seg * 64 + d) * 2] = A; SEG[(seg * 64 + d) * 2 + 1] = H;
        }
        __syncthreads();
        if (PASS == 0) {
            if (tid < 64) { float A = 1.f, H = 0.f;
#pragma unroll
                for (int s = 0; s < 8; ++s) { const float As = SEG[(s * 64 + tid) * 2], Hs = SEG[(s * 64 + tid) * 2 + 1]; H = As * H + Hs; A *= As; }
                *(f32x2*)(LSUM + (((size_t)b * NCHUNK + k) * TOKW + n * 64 + tid) * 2) = (f32x2){A, H}; }
        } else {
            float h = 0.f;
#pragma unroll
            for (int s = 0; s < 8; ++s) h = CSEG[(s * 64 + d) * 2] * h + CSEG[(s * 64 + d) * 2 + 1];
#pragma unroll
            for (int s = 0; s < 8; ++s) if (s < seg) h = SEG[(s * 64 + d) * 2] * h + SEG[(s * 64 + d) * 2 + 1];
            bf16_t* op = MIX + (row0 + seg * 16) * D + n * 64 + d;
#pragma unroll
            for (int q = 0; q < 16; ++q) { const int t = seg * 16 + q; h = AA[t * 64 + d] * h + UU[t * 64 + d];
                const float g = bf2f(gbv[q]); const float y = 0.7978845608f * (g + 0.044715f * g * g * g); const float th = 1.0f - 2.0f * __builtin_amdgcn_rcpf(__expf(2.0f * y) + 1.0f);
                op[(size_t)q * D] = f2bf(h * 0.5f * g * (1.0f + th)); }
        }
    }
    __syncthreads();
#undef LRU_LOAD_X
}

DI void memattn_phase(Ctx& F, int layer, int ldp, int mqcol) {
    LAS unsigned char* lds = F.lds;
    LAS bf16_t* Kt = (LAS bf16_t*)lds;
    LAS bf16_t* Vt = (LAS bf16_t*)(lds + 36864);
    const int tid = F.tid, lane = F.lane, w = F.wave, fr = lane & 15, fq = lane >> 4;
    const bf16_t* PROJ = (const bf16_t*)(F.ws + WS_PROJ);
    const bf16_t* KV = (const bf16_t*)(F.ws + WS_KV);
    bf16_t* MIX = (bf16_t*)(F.ws + WS_MIX);
    for (int u = F.bx; u < NB * 4 * 8; u += F.G) {
        const int qc = u & 7, h = (u >> 3) & 3, b = u >> 5;
        __syncthreads();
#pragma unroll
        for (int it = 0; it < 4; ++it) { const int p = tid + 512 * it, key = p >> 3, c8 = p & 7;
            *(LAS u32x4*)(Kt + key * 72 + c8 * 8) = *(const u32x4*)(KV + (size_t)(b * MEML + key) * 1024 + layer * 512 + h * 64 + c8 * 8); }
        { const int key = tid & 255, dh = tid >> 8;
#pragma unroll
          for (int c = 0; c < 4; ++c) { const u32x4 v = *(const u32x4*)(KV + (size_t)(b * MEML + key) * 1024 + layer * 512 + 256 + h * 64 + dh * 32 + c * 8);
              const unsigned wv[4] = {v.x, v.y, v.z, v.w};
#pragma unroll
              for (int q = 0; q < 4; ++q) { const int dd = dh * 32 + c * 8 + 2 * q; Vt[dd * 264 + key] = (bf16_t)(wv[q] & 0xffffu); Vt[(dd + 1) * 264 + key] = (bf16_t)(wv[q] >> 16); } } }
        __syncthreads();
        for (int it = 0; it < 8; ++it) {
            const size_t q0 = (size_t)b * SEQ + qc * 1024 + it * 128 + w * 16;
            bf16x8 qf[2];
#pragma unroll
            for (int ks = 0; ks < 2; ++ks) qf[ks] = *(const bf16x8*)(PROJ + (q0 + fr) * ldp + mqcol + h * 64 + ks * 32 + fq * 8);
            f32x4 s[16];
#pragma unroll
            for (int jg = 0; jg < 4; ++jg) { bf16x8 kf[4][2];
#pragma unroll
                for (int jj = 0; jj < 4; ++jj)
#pragma unroll
                    for (int ks = 0; ks < 2; ++ks) kf[jj][ks] = *(const LAS bf16x8*)(Kt + (16 * (4 * jg + jj) + fr) * 72 + ks * 32 + fq * 8);
#pragma unroll
                for (int jj = 0; jj < 4; ++jj) { const int j = 4 * jg + jj; s[j] = (f32x4){0.f, 0.f, 0.f, 0.f};
#pragma unroll
                    for (int ks = 0; ks < 2; ++ks) s[j] = MFMA16(kf[jj][ks], qf[ks], s[j]); }
                asm volatile("" ::: "memory"); }
            float mx = -3.0e38f;
#pragma unroll
            for (int j = 0; j < 16; ++j) mx = fmaxf(mx, fmaxf(fmaxf(s[j][0], s[j][1]), fmaxf(s[j][2], s[j][3])));
            mx = rows4_max(mx);
            float l = 0.f; bf16x8 pf[8];
#pragma unroll
            for (int ks = 0; ks < 8; ++ks) { float p[8];
#pragma unroll
                for (int q = 0; q < 4; ++q) { p[q] = __expf((s[2 * ks][q] - mx) * 0.125f); p[4 + q] = __expf((s[2 * ks + 1][q] - mx) * 0.125f); }
#pragma unroll
                for (int q = 0; q < 8; ++q) l += p[q];
                u32x4 pw; pw.x = cvt_pk_bf16(p[0], p[1]); pw.y = cvt_pk_bf16(p[2], p[3]); pw.z = cvt_pk_bf16(p[4], p[5]); pw.w = cvt_pk_bf16(p[6], p[7]);
                pf[ks] = __builtin_bit_cast(bf16x8, pw); }
            l = rows4_sum(l);
            const float inv = 1.0f / l;
            f32x4 o[4];
#pragma unroll
            for (int dt = 0; dt < 4; ++dt) o[dt] = (f32x4){0.f, 0.f, 0.f, 0.f};
#pragma unroll
            for (int ks = 0; ks < 8; ++ks) { bf16x8 vf[4];
#pragma unroll
                for (int dt = 0; dt < 4; ++dt) { const LAS bf16_t* vp = Vt + (16 * dt + fr) * 264 + 32 * ks + 4 * fq;
                    const s16x4 lo = *(const LAS s16x4*)vp, hi = *(const LAS s16x4*)(vp + 16); vf[dt] = __builtin_shufflevector(lo, hi, 0, 1, 2, 3, 4, 5, 6, 7); }
#pragma unroll
                for (int dt = 0; dt < 4; ++dt) o[dt] = MFMA16(vf[dt], pf[ks], o[dt]); }
#pragma unroll
            for (int dt = 0; dt < 4; ++dt) { u32x2 ow; ow.x = cvt_pk_bf16(o[dt][0] * inv, o[dt][1] * inv); ow.y = cvt_pk_bf16(o[dt][2] * inv, o[dt][3] * inv);
                if (layer == 0) *(u32x2*)(MIX + (q0 + fr) * D + TOKW + h * 64 + 16 * dt + 4 * fq) = ow;
                else *(unsigned*)((unsigned char*)MIX + (q0 + fr) * D + TOKW + h * 64 + 16 * dt + 4 * fq) = pk4_fp8(o[dt][0] * inv * 16.0f, o[dt][1] * inv * 16.0f, o[dt][2] * inv * 16.0f, o[dt][3] * inv * 16.0f); }
            asm volatile("" ::: "memory");
        }
    }
    __syncthreads();
}

DI void build_mtab(Ctx& F, int layer) {
    LAS int* mtab = (LAS int*)(F.lds + MTAB_OFF);
    __syncthreads();
    if (F.tid < 64) {
        const int l = F.tid; unsigned c = 0u;
        if (l < 32) c = __hip_atomic_load(F.ctl + CW_CNT + (layer * 32 + l) * 16, __ATOMIC_RELAXED, __HIP_MEMORY_SCOPE_AGENT);
        const int nt = (int)((c + 255u) >> 8); int incl = nt;
#pragma unroll
        for (int o = 1; o < 32; o <<= 1) { const int u = shup_i(incl, o); if (l >= o) incl += u; }
        if (l < 32) mtab[l] = incl - nt;
        if (l == 31) mtab[32] = incl; }
    __syncthreads();
    LAS unsigned* gmtab = (LAS unsigned*)(F.lds + GMTAB_OFF);
    for (int gm = F.tid; gm < mtab[32] && gm < 1056; gm += 512) { int e = 0;
        for (int q = 1; q < 32; ++q) e += (gm >= mtab[q]) ? 1 : 0;
        gmtab[gm] = ((unsigned)e << 16) | (unsigned)(gm - mtab[e]); }
    __syncthreads();
}

DI unsigned wave_max_u(unsigned v);
DI void ln_router_phase(Ctx& F, int layer) {
    LAS float* WR = (LAS float*)F.lds;
    LAS unsigned* lcnt = (LAS unsigned*)(F.lds + 147456);
    LAS unsigned* lbase = (LAS unsigned*)(F.lds + 147456 + 128);
    LAS unsigned* stash = (LAS unsigned*)(F.lds + 147456 + 256);
    constexpr int ROWS_IT = 16;
    LAS float* stg = (LAS float*)(stash + 8 * ROWS_IT * 4);
    const int tid = F.tid, lane = F.lane, w = F.wave;
    const bf16_t* Z = (const bf16_t*)(F.ws + WS_Z);
    float* XA = (float*)(F.ws + WS_XA);
    bf16_t* XBF = (bf16_t*)(F.ws + WS_XBF); unsigned char* XB8 = F.ws + WS_XB8;
    const float* gam = inp(F, I_LN1G) + layer * D; const float* bet = inp(F, I_LN1B) + layer * D;
    const float* rw = inp(F, I_ROUTW) + (size_t)layer * 1024 * 32; const float* rb = inp(F, I_ROUTB) + layer * 32;
    unsigned* LIST = (unsigned*)(F.ws + WS_LIST); unsigned* TOKSLOT = (unsigned*)(F.ws + WS_TOKSLOT); float* TOKGATE = (float*)(F.ws + WS_TOKGATE);
    __syncthreads();
    for (int p = tid; p < 1024 * 8; p += 512) { const int c = p >> 3, k = p & 7; *(LAS f32x4*)(WR + ((c & 3) * 256 + (c >> 2)) * 36 + 4 * k) = *(const f32x4*)(rw + (size_t)c * 32 + 4 * k); }
    f32x4 g4[4], b4[4];
#pragma unroll
    for (int j = 0; j < 4; ++j) { g4[j] = *(const f32x4*)(gam + 4 * lane + 256 * j); b4[j] = *(const f32x4*)(bet + 4 * lane + 256 * j); }
    const int myexp = (((lane >> 5) & 1) << 4) | (((lane >> 4) & 1) << 3) | (((lane >> 3) & 1) << 2) | (((lane >> 2) & 1) << 1) | ((lane >> 1) & 1);
    const float mybias = rb[myexp];
    const int rows_blk = 8 * ROWS_IT;
    for (int it = 0; (it * F.G + F.bx) * rows_blk < T; ++it) {
        const int row0 = (it * F.G + F.bx) * rows_blk + w * ROWS_IT;
        __syncthreads();
        if (tid < 32) lcnt[tid] = 0u;
        __syncthreads();
        u32x2 vnx[4]; f32x4 rfx[4]; u32x2 rbx[4];
        const float* xres = inp(F, I_X);
#pragma unroll
        for (int j = 0; j < 4; ++j) { vnx[j] = *(const u32x2*)(Z + (size_t)row0 * D + 4 * lane + 256 * j);
            if (layer == 0) rfx[j] = *(const f32x4*)(xres + (size_t)row0 * D + 4 * lane + 256 * j); else rbx[j] = *(const u32x2*)(XBF + (size_t)row0 * D + 4 * lane + 256 * j); }
        for (int rr2 = 0; rr2 < (DBL(5) ? 2 * ROWS_IT : ROWS_IT); ++rr2) {
            const int r = rr2 % ROWS_IT; const bool publish = !DBL(5) || rr2 >= ROWS_IT;
            const size_t row = (size_t)row0 + r;
            f32x4 v[4];
#pragma unroll
            for (int j = 0; j < 4; ++j) { const f32x4 res = (layer == 0) ? rfx[j] : (f32x4){bflo(rbx[j].x), bfhi(rbx[j].x), bflo(rbx[j].y), bfhi(rbx[j].y)};
                v[j] = res * DN_ALPHA + (f32x4){bflo(vnx[j].x), bfhi(vnx[j].x), bflo(vnx[j].y), bfhi(vnx[j].y)}; }
            { const size_t rown = (size_t)row0 + ((rr2 + 1) % ROWS_IT);
#pragma unroll
              for (int j = 0; j < 4; ++j) { vnx[j] = *(const u32x2*)(Z + rown * D + 4 * lane + 256 * j);
                  if (layer == 0) rfx[j] = *(const f32x4*)(xres + rown * D + 4 * lane + 256 * j); else rbx[j] = *(const u32x2*)(XBF + rown * D + 4 * lane + 256 * j); } }
            __builtin_amdgcn_sched_barrier(0);
            float s = 0.f;
#pragma unroll
            for (int j = 0; j < 4; ++j) s += (v[j][0] + v[j][1]) + (v[j][2] + v[j][3]);
            const float mean = wave_sum_fast(s) * (1.0f / D); float s2 = 0.f;
#pragma unroll
            for (int j = 0; j < 4; ++j) { v[j] = v[j] - mean; s2 += (v[j][0] * v[j][0] + v[j][1] * v[j][1]) + (v[j][2] * v[j][2] + v[j][3] * v[j][3]); }
            const float rstd = 1.0f / sqrtf(wave_sum_fast(s2) * (1.0f / D) + LN_EPS);
#pragma unroll
            for (int j = 0; j < 4; ++j) { v[j] = v[j] * rstd * g4[j] + b4[j];
                u32x2 o; o.x = cvt_pk_bf16(v[j][0], v[j][1]); o.y = cvt_pk_bf16(v[j][2], v[j][3]); *(u32x2*)(XBF + row * D + 4 * lane + 256 * j) = o;
                *(unsigned*)(XB8 + row * D + 4 * lane + 256 * j) = pk4_fp8(v[j][0] * 4.0f, v[j][1] * 4.0f, v[j][2] * 4.0f, v[j][3] * 4.0f); }
            f32x4 accv[8], wq[2][8];
#pragma unroll
            for (int k = 0; k < 8; ++k) { accv[k] = (f32x4){0.f, 0.f, 0.f, 0.f}; wq[0][k] = *(const LAS f32x4*)(WR + lane * 36 + 4 * k); }
#pragma unroll
            for (int ci = 0; ci < 16; ++ci) { const int j = ci >> 2, i = ci & 3;
                if (ci + 1 < 16) { const int jn = (ci + 1) >> 2, in = (ci + 1) & 3; const LAS float* wp = WR + (in * 256 + lane + 64 * jn) * 36;
#pragma unroll
                    for (int k = 0; k < 8; ++k) wq[(ci + 1) & 1][k] = *(const LAS f32x4*)(wp + 4 * k); }
                __builtin_amdgcn_sched_barrier(0);
                const float xv = v[j][i];
#pragma unroll
                for (int k = 0; k < 8; ++k) accv[k] += wq[ci & 1][k] * xv;
                __builtin_amdgcn_sched_barrier(0);
            }
            float acc[32];
#pragma unroll
            for (int e = 0; e < 32; ++e) acc[e] = accv[e >> 2][e & 3];
#define RED_LEVEL(o, n) { const bool up = (lane & (o)) != 0; _Pragma("unroll") for (int q = 0; q < (n); ++q) { const float send = up ? acc[q] : acc[q + (n)]; const float keep = up ? acc[q + (n)] : acc[q]; acc[q] = keep + shx(send, (o)); } }
#pragma unroll
            for (int q = 0; q < 16; ++q) { const auto pr = __builtin_amdgcn_permlane32_swap(__float_as_uint(acc[q]), __float_as_uint(acc[q + 16]), false, false); acc[q] = __uint_as_float(pr[0]) + __uint_as_float(pr[1]); }
#pragma unroll
            for (int q = 0; q < 8; ++q) { const auto pr = __builtin_amdgcn_permlane16_swap(__float_as_uint(acc[q]), __float_as_uint(acc[q + 8]), false, false); acc[q] = __uint_as_float(pr[0]) + __uint_as_float(pr[1]); }
            RED_LEVEL(8, 4) RED_LEVEL(4, 2) RED_LEVEL(2, 1)
#undef RED_LEVEL
            float lg = acc[0] + shx(acc[0], 1) + mybias;
            float tv[4]; int te[4];
#pragma unroll
            for (int k = 0; k < 4; ++k) {
                unsigned ub = __float_as_uint(lg); ub ^= (ub >> 31) ? 0xffffffffu : 0x80000000u;
                const unsigned mxk = wave_max_u(ub);
                const unsigned cand = (ub == mxk) ? (unsigned)(32 - myexp) : 0u;
                const int ewin = 32 - (int)wave_max_u(cand);
                unsigned mb = mxk; mb ^= (mb >> 31) ? 0x80000000u : 0xffffffffu;
                tv[k] = __uint_as_float(mb); te[k] = ewin;
                if (myexp == ewin) lg = -3.0e38f;
            }
            float gsum = 0.f, gk[4];
#pragma unroll
            for (int k = 0; k < 4; ++k) { gk[k] = __expf(tv[k] - tv[0]); gsum += gk[k]; }
            const float ginv = 1.0f / gsum;
            if (lane < 4 && publish) { int e = te[0]; float g = gk[0];
#pragma unroll
                for (int k = 1; k < 4; ++k) if (lane == k) { e = te[k]; g = gk[k]; }
                const unsigned pos = __hip_atomic_fetch_add(lcnt + e, 1u, __ATOMIC_RELAXED, __HIP_MEMORY_SCOPE_WORKGROUP);
                stash[(w * ROWS_IT + r) * 4 + lane] = ((unsigned)e << 24) | pos; stg[(w * ROWS_IT + r) * 4 + lane] = g * ginv; }
        }
        __syncthreads();
        if (tid < 32) lbase[tid] = __hip_atomic_fetch_add(F.ctl + CW_CNT + (layer * 32 + tid) * 16, lcnt[tid], __ATOMIC_RELAXED, __HIP_MEMORY_SCOPE_AGENT);
        __syncthreads();
        { const int rr = lane >> 2, k = lane & 3;
          const unsigned sv = stash[(w * ROWS_IT + rr) * 4 + k]; const int e = (int)(sv >> 24); const unsigned slot = lbase[e] + (sv & 0xffffffu);
          const size_t row = (size_t)row0 + rr;
          LIST[(size_t)e * 65536 + slot] = (unsigned)row; TOKSLOT[row * 4 + k] = ((unsigned)e << 20) | slot; TOKGATE[row * 4 + k] = stg[(w * ROWS_IT + rr) * 4 + k]; }
    }
    __syncthreads();
}

DI void combine_ln_phase(Ctx& F, int layer, float* outf) {
    build_mtab(F, layer);
    const LAS int* mtab = (const LAS int*)(F.lds + MTAB_OFF);
    const int lane = F.lane;
    const float* XA = (const float*)(F.ws + WS_XA);
    const unsigned char* Y = F.ws + WS_Y;
    bf16_t* XBF = (bf16_t*)(F.ws + WS_XBF);
    const unsigned* TOKSLOT = (const unsigned*)(F.ws + WS_TOKSLOT); const float* TOKGATE = (const float*)(F.ws + WS_TOKGATE);
    const float* gam = inp(F, I_LN2G) + layer * D; const float* bet = inp(F, I_LN2B) + layer * D;
    const int gw = F.bx * 8 + F.wave, NGW = F.G * 8;
    const bool perr = (PROBE_CHECK || PROBE_DSA) && layer == 1 && __hip_atomic_load(F.ctl + CW_ERR, __ATOMIC_RELAXED, __HIP_MEMORY_SCOPE_AGENT) != 0u;
    f32x4 g4[4], b4[4];
#pragma unroll
    for (int j = 0; j < 4; ++j) { g4[j] = *(const f32x4*)(gam + 4 * lane + 256 * j); b4[j] = *(const f32x4*)(bet + 4 * lane + 256 * j); }
#define CMB_ISSUE(xw_, yw_, ts_, r_) do { const unsigned tsv_[4] = {ts_.x, ts_.y, ts_.z, ts_.w}; \
        _Pragma("unroll") for (int j = 0; j < 4; ++j) xw_[j] = *(const u32x2*)(XBF + (size_t)(r_) * D + 4 * lane + 256 * j); \
        _Pragma("unroll") for (int k = 0; k < 4; ++k) { const int e_ = (int)(tsv_[k] >> 20), slot_ = (int)(tsv_[k] & 0xfffffu); const size_t yrow_ = (size_t)mtab[e_] * 256 + slot_; \
            _Pragma("unroll") for (int j = 0; j < 4; ++j) yw_[k][j] = *(const unsigned*)(Y + yrow_ * D + 4 * lane + 256 * j); } } while (0)
    u32x2 xwc[4]; unsigned ywc[4][4]; f32x4 tgc;
    u32x4 tsn; f32x4 tgn;
    { const int r0 = gw < T ? gw : 0; const u32x4 ts0 = *(const u32x4*)(TOKSLOT + (size_t)r0 * 4); tgc = *(const f32x4*)(TOKGATE + (size_t)r0 * 4);
      const int r1 = (gw + NGW < T) ? gw + NGW : r0; tsn = *(const u32x4*)(TOKSLOT + (size_t)r1 * 4); tgn = *(const f32x4*)(TOKGATE + (size_t)r1 * 4);
      CMB_ISSUE(xwc, ywc, ts0, r0); }
    for (int row = gw; row < T; row += NGW) {
        u32x2 xwn[4]; unsigned ywn[4][4]; const f32x4 tgn1 = tgn;
        { const int r1 = (row + NGW < T) ? row + NGW : row; CMB_ISSUE(xwn, ywn, tsn, r1);
          const int r2 = (row + 2 * NGW < T) ? row + 2 * NGW : row; tsn = *(const u32x4*)(TOKSLOT + (size_t)r2 * 4); tgn = *(const f32x4*)(TOKGATE + (size_t)r2 * 4); }
        __builtin_amdgcn_sched_barrier(0);
        f32x4 v[4];
#pragma unroll
        for (int j = 0; j < 4; ++j) v[j] = (f32x4){bflo(xwc[j].x), bfhi(xwc[j].x), bflo(xwc[j].y), bfhi(xwc[j].y)} * DN_ALPHA;
#pragma unroll
        for (int k = 0; k < 4; ++k) { const float g = tgc[k] * 0.0625f;
#pragma unroll
            for (int j = 0; j < 4; ++j) { const unsigned yw = ywc[k][j]; const f32x2 ya = __builtin_amdgcn_cvt_pk_f32_fp8((int)yw, false), yb = __builtin_amdgcn_cvt_pk_f32_fp8((int)yw, true);
                v[j][0] += g * ya[0]; v[j][1] += g * ya[1]; v[j][2] += g * yb[0]; v[j][3] += g * yb[1]; } }
        float s = 0.f;
#pragma unroll
        for (int j = 0; j < 4; ++j) s += (v[j][0] + v[j][1]) + (v[j][2] + v[j][3]);
        const float mean = wave_sum_fast(s) * (1.0f / D); float s2 = 0.f;
#pragma unroll
        for (int j = 0; j < 4; ++j) { v[j] = v[j] - mean; s2 += (v[j][0] * v[j][0] + v[j][1] * v[j][1]) + (v[j][2] * v[j][2] + v[j][3] * v[j][3]); }
        const float rstd = 1.0f / sqrtf(wave_sum_fast(s2) * (1.0f / D) + LN_EPS);
#pragma unroll
        for (int j = 0; j < 4; ++j) { const int c = 4 * lane + 256 * j; f32x4 y = v[j] * rstd * g4[j] + b4[j];
            if ((PROBE_CHECK || PROBE_DSA) && perr) y = (f32x4){__builtin_nanf(""), __builtin_nanf(""), __builtin_nanf(""), __builtin_nanf("")};
            if (layer == 1) *(f32x4*)(outf + (size_t)row * D + c) = y;
            if (layer == 0) { u32x2 o; o.x = cvt_pk_bf16(y[0], y[1]); o.y = cvt_pk_bf16(y[2], y[3]); *(u32x2*)(XBF + (size_t)row * D + c) = o; }
            if (layer == 0) *(unsigned*)(F.ws + WS_XB8 + (size_t)row * D + c) = pk4_fp8(y[0] * 4.0f, y[1] * 4.0f, y[2] * 4.0f, y[3] * 4.0f); }
        tgc = tgn1;
#pragma unroll
        for (int j = 0; j < 4; ++j) { xwc[j] = xwn[j];
#pragma unroll
            for (int k = 0; k < 4; ++k) ywc[k][j] = ywn[k][j]; }
    }
#undef CMB_ISSUE
}

DI void dsa_prep_phase(Ctx& F) {
    const bf16_t* PROJ = (const bf16_t*)(F.ws + WS_PROJ);
    bf16_t* CN = (bf16_t*)(F.ws + WS_CN); bf16_t* IKN = (bf16_t*)(F.ws + WS_IKN);
    const int sub = F.lane & 15, tq = F.lane >> 4;
    const int gw = F.bx * 8 + F.wave, NGW = F.G * 8;
    for (int t4 = gw; t4 < T / 4; t4 += NGW) {
        const size_t row = (size_t)t4 * 4 + tq;
        const u32x4 cv = *(const u32x4*)(PROJ + row * WINBP + B_C + sub * 8);
        const u32x2 kv = *(const u32x2*)(PROJ + row * WINBP + B_IK + sub * 4);
        float c[8] = {bflo(cv.x), bfhi(cv.x), bflo(cv.y), bfhi(cv.y), bflo(cv.z), bfhi(cv.z), bflo(cv.w), bfhi(cv.w)};
        float k[4] = {bflo(kv.x), bfhi(kv.x), bflo(kv.y), bfhi(kv.y)};
        float ss = 0.f, s1 = 0.f;
#pragma unroll
        for (int q = 0; q < 8; ++q) ss += c[q] * c[q];
#pragma unroll
        for (int q = 0; q < 4; ++q) s1 += k[q];
#pragma unroll
        for (int o = 1; o < 16; o <<= 1) { ss += shx(ss, o); s1 += shx(s1, o); }
        const float rr = 1.0f / sqrtf(ss * (1.0f / 128.0f) + 1e-6f); const float mean = s1 * (1.0f / 64.0f);
        float s2 = 0.f;
#pragma unroll
        for (int q = 0; q < 4; ++q) { k[q] -= mean; s2 += k[q] * k[q]; }
#pragma unroll
        for (int o = 1; o < 16; o <<= 1) s2 += shx(s2, o);
        const float rs = 1.0f / sqrtf(s2 * (1.0f / 64.0f) + LN_EPS);
        const float* g = inp(F, I_BKVG) + sub * 8; const float* ig = inp(F, I_BIDXG) + sub * 4; const float* ib = inp(F, I_BIDXB) + sub * 4;
        u32x4 co; co.x = cvt_pk_bf16(c[0] * rr * g[0], c[1] * rr * g[1]); co.y = cvt_pk_bf16(c[2] * rr * g[2], c[3] * rr * g[3]);
        co.z = cvt_pk_bf16(c[4] * rr * g[4], c[5] * rr * g[5]); co.w = cvt_pk_bf16(c[6] * rr * g[6], c[7] * rr * g[7]);
        *(u32x4*)(CN + row * 128 + sub * 8) = co;
        u32x2 ko; ko.x = cvt_pk_bf16(k[0] * rs * ig[0] + ib[0], k[1] * rs * ig[1] + ib[1]); ko.y = cvt_pk_bf16(k[2] * rs * ig[2] + ib[2], k[3] * rs * ig[3] + ib[3]);
        *(u32x2*)(IKN + row * 64 + sub * 4) = ko;
    }
}

DI int row_suffix_incl(int v) {
    v += __builtin_amdgcn_update_dpp(0, v, 0x101, 0xf, 0xf, true);
    v += __builtin_amdgcn_update_dpp(0, v, 0x102, 0xf, 0xf, true);
    v += __builtin_amdgcn_update_dpp(0, v, 0x104, 0xf, 0xf, true);
    v += __builtin_amdgcn_update_dpp(0, v, 0x108, 0xf, 0xf, true);
    return v;
}
DI unsigned wave_max_u(unsigned v) {
    int x = (int)v;
#define WMX_STEP(ctrl) { const unsigned o = (unsigned)__builtin_amdgcn_update_dpp(0, x, ctrl, 0xf, 0xf, true); x = (int)(((unsigned)x > o) ? (unsigned)x : o); }
    WMX_STEP(0x101) WMX_STEP(0x102) WMX_STEP(0x104) WMX_STEP(0x108)
#undef WMX_STEP
    const unsigned a = (unsigned)__builtin_amdgcn_readlane(x, 0), b = (unsigned)__builtin_amdgcn_readlane(x, 16), c = (unsigned)__builtin_amdgcn_readlane(x, 32), d = (unsigned)__builtin_amdgcn_readlane(x, 48);
    const unsigned ab = a > b ? a : b, cd = c > d ? c : d; return ab > cd ? ab : cd;
}
DI unsigned lowmask(int k) { return k >= 32 ? 0xffffffffu : ((1u << k) - 1u); }
DI void select_top256_x2(LAS unsigned* cand0, LAS unsigned* cand1, LAS unsigned* cnt0, LAS unsigned* cnt1, LAS unsigned* thr0, LAS unsigned* thr1, bool two, LAS unsigned* hist, int lane) {
    LAS unsigned* cand[2] = {cand0, cand1};
    int n[2]; n[0] = (int)*cnt0; n[1] = two ? (int)*cnt1 : 0;
    unsigned x[2][8];
#pragma unroll
    for (int q = 0; q < 2; ++q)
#pragma unroll
        for (int i = 0; i < 8; ++i) x[q][i] = (lane + 64 * i < n[q]) ? cand[q][lane + 64 * i] : 0u;
    unsigned prefix[2]; int fl[2], need[2] = {256, 256};
#pragma unroll
    for (int q = 0; q < 2; ++q) { unsigned m1 = 0u, m2 = 0u;
#pragma unroll
        for (int i = 0; i < 8; ++i) { m1 = x[q][i] > m1 ? x[q][i] : m1; const unsigned c = x[q][i] ? ~x[q][i] : 0u; m2 = c > m2 ? c : m2; }
        const unsigned mx = wave_max_u(m1), mn = ~wave_max_u(m2);
        const unsigned diff = (mx ^ mn) | 1u; fl[q] = 32 - __builtin_clz(diff); prefix[q] = mx & ~lowmask(fl[q]); }
    const int row = lane >> 4;
    for (int guard = 0; guard < 5 && (fl[0] > 0 || fl[1] > 0); ++guard) {
        int sh[2]; unsigned dm[2], pm[2];
#pragma unroll
        for (int q = 0; q < 2; ++q) { sh[q] = fl[q] > 8 ? fl[q] - 8 : 0; dm[q] = (1u << (fl[q] - sh[q])) - 1u; pm[q] = ~lowmask(fl[q]); }
        { const u32x4 z4 = zero4_local();
#pragma unroll
        for (int q = 0; q < 2; ++q) *(LAS u32x4*)(hist + q * 256 + 4 * lane) = z4; }
        LDS_WAIT();
#pragma unroll
        for (int q = 0; q < 2; ++q)
#pragma unroll
            for (int i = 0; i < 8; ++i) if (x[q][i] != 0u && (x[q][i] & pm[q]) == prefix[q]) __hip_atomic_fetch_add(hist + q * 256 + ((x[q][i] >> sh[q]) & dm[q]), 1u, __ATOMIC_RELAXED, __HIP_MEMORY_SCOPE_WORKGROUP);
        LDS_WAIT();
        u32x4 h4[2]; int sl[2], incl[2];
#pragma unroll
        for (int q = 0; q < 2; ++q) h4[q] = *(const LAS u32x4*)(hist + q * 256 + 4 * lane);
#pragma unroll
        for (int q = 0; q < 2; ++q) { sl[q] = (int)(h4[q].x + h4[q].y + h4[q].z + h4[q].w); const int v = row_suffix_incl(sl[q]);
            const int t1 = __builtin_amdgcn_readlane(v, 16), t2 = __builtin_amdgcn_readlane(v, 32), t3 = __builtin_amdgcn_readlane(v, 48);
            incl[q] = v + (row == 0 ? t1 + t2 + t3 : row == 1 ? t2 + t3 : row == 2 ? t3 : 0); }
#pragma unroll
        for (int q = 0; q < 2; ++q) {
            const unsigned long long bal = __ballot(incl[q] >= need[q]);
            const int L = bal ? 63 - __builtin_clzll(bal) : 0;
            int above = __builtin_amdgcn_readlane(incl[q], L) - __builtin_amdgcn_readlane(sl[q], L);
            const int c3 = __builtin_amdgcn_readlane((int)h4[q].w, L), c2 = __builtin_amdgcn_readlane((int)h4[q].z, L), c1 = __builtin_amdgcn_readlane((int)h4[q].y, L);
            int b = 3;
            if (above + c3 < need[q]) { above += c3; b = 2; if (above + c2 < need[q]) { above += c2; b = 1; if (above + c1 < need[q]) { above += c1; b = 0; } } }
            if (fl[q] > 0) { need[q] -= above; prefix[q] |= (unsigned)(4 * L + b) << sh[q]; fl[q] = sh[q]; }
        }
    }
    const unsigned long long lt = (1ull << lane) - 1ull;
#pragma unroll
    for (int q = 0; q < 2; ++q) {
        if (q == 1 && !two) break;
        int base = 0;
#pragma unroll
        for (int i = 0; i < 8; ++i) { const bool keep = x[q][i] >= prefix[q]; const unsigned long long m = __ballot(keep);
            if (keep) cand[q][base + __builtin_popcountll(m & lt)] = x[q][i];
            base += __builtin_popcountll(m); }
    }
    if (lane == 0) { *cnt0 = 256u; *thr0 = prefix[0]; if (two) { *cnt1 = 256u; *thr1 = prefix[1]; } }
}

DI int idx_bin(float sv) { const unsigned bits = __float_as_uint(sv); const int lin = (int)((bits >> 18) & 0x1fffu);
    if (bits >> 31) { int t = lin - (127 - 13) * 32; t = t < 0 ? 0 : (t > 511 ? 511 : t); return 511 - t; }
    int t = lin - (127 - 9) * 32; t = t < 0 ? 0 : (t > 511 ? 511 : t); return 512 + t; }
DI unsigned idx_bin_lowkey(int tb) {
    if (tb >= 512) { const unsigned lin = (unsigned)(tb - 512 + (127 - 9) * 32); return tb == 512 ? 0x80000000u : (0x80000000u | (lin << 18)); }
    const unsigned lin = (unsigned)((511 - tb) + (127 - 13) * 32);
    const unsigned bits_hi = 0x80000000u | (lin << 18) | 0x3ffffu;
    return (~bits_hi) & 0xffffe000u; }
template <int MODE>
DI void idx_pass(LAS unsigned* BUF, LAS unsigned* CNT, LAS unsigned* ZH, const bf16_t* IKN, size_t rowb, const bf16x8 (&qf)[4][2], const float (&iw)[4], int nsteps, int half, int qloc, int qpos, unsigned thr, int fr, int fq, int sstride = 1) {
    asm volatile("" : "+v"(fr), "+v"(fq), "+v"(qloc), "+v"(qpos));
    const bf16_t* kp = IKN + (rowb + half * 64 + fr) * 64 + fq * 8;
    bf16x8 kf[2][2];
#pragma unroll
    for (int tl = 0; tl < 2; ++tl)
#pragma unroll
        for (int ks = 0; ks < 2; ++ks) kf[tl][ks] = *(const bf16x8*)(kp + (16 * tl) * 64 + ks * 32);
    const int nh = 2 * nsteps;
#pragma clang loop unroll(disable)
    for (int hs = 0; hs < nh; hs += sstride) {
        const int kb = (hs >> 1) * 128 + half * 64 + (hs & 1) * 32;
        bf16x8 kn[2][2];
        { const int hn = (hs + sstride < nh) ? hs + sstride : hs; const int kbn = (hn >> 1) * 128 + (hn & 1) * 32;
#pragma unroll
          for (int tl = 0; tl < 2; ++tl)
#pragma unroll
            for (int ks = 0; ks < 2; ++ks) kn[tl][ks] = *(const bf16x8*)(kp + (size_t)(kbn + 16 * tl) * 64 + ks * 32); }
        __builtin_amdgcn_sched_barrier(0);
        unsigned ckv[8]; int nacc = 0;
#pragma unroll
        for (int tl = 0; tl < 2; ++tl) {
            f32x4 sc = (f32x4){0.f, 0.f, 0.f, 0.f};
#pragma unroll
            for (int h = 0; h < 4; ++h) { f32x4 a = (f32x4){0.f, 0.f, 0.f, 0.f}; a = MFMA16(kf[tl][0], qf[h][0], a); a = MFMA16(kf[tl][1], qf[h][1], a);
#pragma unroll
                for (int i = 0; i < 4; ++i) sc[i] += __builtin_amdgcn_fmed3f(a[i], 0.f, 3.0e38f) * iw[h]; }
#pragma unroll
            for (int i = 0; i < 4; ++i) {
                const int key = kb + 16 * tl + 4 * fq + i;
                const float sv = sc[i] + 0.0f;
                unsigned ub = __float_as_uint(sv); ub ^= (ub >> 31) ? 0xffffffffu : 0x80000000u;
                if (MODE == 1 || (MODE == 4 && (i & 1) == 0)) {
                    const int bin = idx_bin(sv);
                    if (key <= qpos) { __hip_atomic_fetch_add(BUF + qloc * 512 + (bin >> 1), 1u << ((bin & 1) << 4), __ATOMIC_RELAXED, __HIP_MEMORY_SCOPE_WORKGROUP);
                        if (sv == 0.0f) __hip_atomic_fetch_add(ZH + qloc * 32 + (key >> 8), 1u << (((key >> 7) & 1) << 4), __ATOMIC_RELAXED, __HIP_MEMORY_SCOPE_WORKGROUP); }
                } else if (MODE == 3) {
                    nacc += idx_bin(sv) + (int)(ub >> 20);
                } else {
                    const unsigned ck = (ub & 0xffffe000u) | (unsigned)(8191 - key);
                    const bool acc = (key <= qpos) && (ck > thr);
                    ckv[tl * 4 + i] = acc ? ck : 0u; nacc += acc ? 1 : 0;
                }
            }
        }
        if (MODE == 3) asm volatile("" :: "v"(nacc));
        if (MODE == 2) {
            if (__ballot(nacc > 0)) {
                unsigned pos = __hip_atomic_fetch_add(CNT + qloc, (unsigned)nacc, __ATOMIC_RELAXED, __HIP_MEMORY_SCOPE_WORKGROUP);
#pragma unroll
                for (int j = 0; j < 8; ++j) if (ckv[j] != 0u) { if (pos < 512u) BUF[qloc * 512 + pos] = ckv[j]; ++pos; }
            }
        }
#pragma unroll
        for (int tl = 0; tl < 2; ++tl)
#pragma unroll
            for (int ks = 0; ks < 2; ++ks) kf[tl][ks] = kn[tl][ks];
    }
}
DI unsigned idx_threshold(const LAS unsigned* hist, const LAS unsigned* zh, int lane, int& n_ge, const int rank = 256) {
    const u32x4 wa = *(const LAS u32x4*)(hist + 8 * lane), wb = *(const LAS u32x4*)(hist + 8 * lane + 4);
    const unsigned wd[8] = {wa.x, wa.y, wa.z, wa.w, wb.x, wb.y, wb.z, wb.w};
    int sl = 0;
#pragma unroll
    for (int q = 0; q < 8; ++q) sl += (int)(wd[q] & 0xffffu) + (int)(wd[q] >> 16);
    const int v = row_suffix_incl(sl);
    const int t1 = __builtin_amdgcn_readlane(v, 16), t2 = __builtin_amdgcn_readlane(v, 32), t3 = __builtin_amdgcn_readlane(v, 48);
    const int row = lane >> 4;
    const int incl = v + (row == 0 ? t1 + t2 + t3 : row == 1 ? t2 + t3 : row == 2 ? t3 : 0);
    const unsigned long long bal = __ballot(incl >= rank);
    if (bal == 0ull) { n_ge = __builtin_amdgcn_readlane(incl, 0); return 0u; }
    const int L = 63 - __builtin_clzll(bal);
    int above = __builtin_amdgcn_readlane(incl, L) - __builtin_amdgcn_readlane(sl, L);
    int tb = 16 * L; int cnt_tb = 0; bool found = false;
#pragma unroll
    for (int q = 7; q >= 0; --q) {
        const unsigned wq = (unsigned)__builtin_amdgcn_readlane((int)wd[q], L);
        const int chi = (int)(wq >> 16), clo = (int)(wq & 0xffffu);
        if (!found) { if (above + chi >= rank) { tb = 16 * L + 2 * q + 1; cnt_tb = chi; found = true; } else above += chi; }
        if (!found) { if (above + clo >= rank) { tb = 16 * L + 2 * q; cnt_tb = clo; found = true; } else above += clo; }
    }
    n_ge = above + cnt_tb;
    if (tb == 512 && n_ge > rank + rank / 12) {
        const unsigned zw = (lane < 32) ? zh[lane] : 0u; const int z0 = (int)(zw & 0xffffu), z1 = (int)(zw >> 16);
        int incl2 = z0 + z1;
#pragma unroll
        for (int o = 1; o < 32; o <<= 1) { const int u = shup_i(incl2, o); if (lane >= o) incl2 += u; }
        const int needz = rank - above;
        const unsigned long long b2 = __ballot(lane < 32 && incl2 >= needz);
        int cut = 8192;
        if (b2) { const int L2 = __builtin_ctzll(b2); const int before = __builtin_amdgcn_readlane(incl2, L2) - __builtin_amdgcn_readlane(z0 + z1, L2);
            const int zz0 = __builtin_amdgcn_readlane(z0, L2); cut = (before + zz0 >= needz) ? 128 * (2 * L2 + 1) : 128 * (2 * L2 + 2); }
        const int totz = __builtin_amdgcn_readlane(incl2, 31);
        n_ge = above + (cnt_tb - totz) + ((needz + 127 < totz) ? needz + 127 : totz);
        return cut >= 8192 ? 0x7fffffffu : (0x80000000u | (unsigned)(8191 - cut));
    }
    return tb > 0 ? idx_bin_lowkey(tb) - 1u : 0u;
}
DI unsigned ref_threshold(const LAS unsigned* cand, int n, int lane) {
    unsigned x[8];
#pragma unroll
    for (int i = 0; i < 8; ++i) x[i] = (lane + 64 * i < n) ? cand[lane + 64 * i] : 0u;
    unsigned prefix = 0u;
    for (int bit = 31; bit >= 0; --bit) { const unsigned c = prefix | (1u << bit); int tot = 0;
#pragma unroll
        for (int i = 0; i < 8; ++i) tot += __builtin_popcountll(__ballot(x[i] >= c));
        if (tot >= 256) prefix = c; }
    return prefix;
}
template <int IMODE> DI void indexer_phase(Ctx& F) {
    LAS unsigned* CAND = (LAS unsigned*)F.lds;
    LAS unsigned* CNT = (LAS unsigned*)(F.lds + 131072);
    LAS unsigned* THR = (LAS unsigned*)(F.lds + 131072 + 256);
    LAS unsigned* WL = (LAS unsigned*)(F.lds + 131072 + 512 + 16384);
    LAS unsigned* WLN = WL + 64; LAS unsigned* WLH = WL + 65;
    const int tid = F.tid, lane = F.lane, w = F.wave, fr = lane & 15, fq = lane >> 4;
    const bf16_t* PROJ = (const bf16_t*)(F.ws + WS_PROJ);
    const bf16_t* IKN = (const bf16_t*)(F.ws + WS_IKN);
    unsigned short* IDX = (unsigned short*)(F.ws + WS_IDX);
    const int qg = w & 3, half = w >> 2;
    LAS unsigned* UQ = WL + 68;
    for (;;) {
        __syncthreads();
        if (tid == 0) { unsigned res = 0xffffffffu;
#pragma clang loop unroll(disable)
            for (int k = 0; k < 8; ++k) { const unsigned q = (unsigned)(F.bx + k) & 7u; const unsigned v = __hip_atomic_fetch_add(F.ctl + CW_IQ + (IMODE * 8 + (int)q) * 16, 1u, __ATOMIC_RELAXED, __HIP_MEMORY_SCOPE_AGENT); if (v < 128u) { res = q * 128u + v; break; } }
            *UQ = res; }
        __syncthreads();
        const unsigned uq = *UQ;
        if (uq == 0xffffffffu) break;
        const int b = __builtin_amdgcn_readfirstlane((int)(uq >> 7)), qb = 127 - __builtin_amdgcn_readfirstlane((int)(uq & 127u));
        const int q0 = qb * 64;
        const size_t rowb = (size_t)b * SEQ;
        constexpr int pm = IMODE;
        unsigned short* IDXO = pm ? IDX : (unsigned short*)(F.ws + WS_QLAT);
        __syncthreads();
        if (tid < 64) { CNT[tid] = 0u; THR[tid] = 0u; }
        const int qloc = 16 * qg + fr, qpos = q0 + qloc;
        bf16x8 qf[4][2]; float iw[4];
#pragma unroll
        for (int h = 0; h < 4; ++h) {
#pragma unroll
            for (int ks = 0; ks < 2; ++ks) qf[h][ks] = *(const bf16x8*)(PROJ + (rowb + qpos) * WINBP + B_IQ + h * 64 + ks * 32 + fq * 8);
            iw[h] = bf2f(PROJ[(rowb + qpos) * WINBP + B_IW + h]) * 0.0625f;
        }
        __syncthreads();
        const int nsteps = (q0 + 64 + 127) / 128;
        LAS unsigned* FLG = WL + 66;
        LAS unsigned* ZH = WL + 256;
        bool fast = false;
        if (nsteps >= 6 && pm == 1) {
            { const u32x4 z4 = zero4_local(); for (int u = tid; u < 64 * 512 / 4; u += 512) *(LAS u32x4*)(CAND + 4 * u) = z4; *(LAS u32x4*)(ZH + 4 * tid) = z4; }
            if (tid == 0) *FLG = 0u;
            __syncthreads();
            const bool sampled = nsteps >= 16;
            if (sampled) idx_pass<4>(CAND, CNT, ZH, IKN, rowb, qf, iw, nsteps, half, qloc, qpos, 0u, fr, fq); else idx_pass<1>(CAND, CNT, ZH, IKN, rowb, qf, iw, nsteps, half, qloc, qpos, 0u, fr, fq);
#if PROBE_PASS3
            idx_pass<3>(CAND, CNT, ZH, IKN, rowb, qf, iw, nsteps, half, qloc, qpos, 0u, fr, fq); idx_pass<3>(CAND, CNT, ZH, IKN, rowb, qf, iw, nsteps, half, qloc, qpos, 0u, fr, fq);
#endif
            __syncthreads();
#pragma clang loop unroll(disable)
            for (int qq = 0; qq < 8; ++qq) { int nge; const unsigned t = sampled ? idx_threshold(CAND + (w * 8 + qq) * 512, ZH + (w * 8 + qq) * 32, lane, nge, 184) : idx_threshold(CAND + (w * 8 + qq) * 512, ZH + (w * 8 + qq) * 32, lane, nge, 256);
                if (!sampled && nge > 512 && lane == 0) *FLG = 1u;
                if (lane == 0) { THR[w * 8 + qq] = t; CNT[w * 8 + qq] = 0u; } }
            __syncthreads();
            fast = (*FLG == 0u);
            if (fast) {
                if (tid == 0) { *WLN = 0u; *WLH = 0u; }
                __syncthreads();
                idx_pass<2>(CAND, CNT, ZH, IKN, rowb, qf, iw, nsteps, half, qloc, qpos, THR[qloc], fr, fq);
                __syncthreads();
                LAS unsigned* RTY = WL + 67;
                LAS unsigned* THR2 = WL + 128;
                if (tid == 0) *RTY = 0u;
                if (tid < 64) THR2[tid] = 0xffffffffu;
                __syncthreads();
                if (sampled && lane < 8) { const int ql = w * 8 + lane; const unsigned n = CNT[ql];
                    if (n < 256u) *FLG = 1u;
                    else if (n > 512u && PROBE_NORETRY) *FLG = 1u;
                    else if (n > 512u) { *RTY = 1u; CNT[ql] = 512u; THR2[ql] = 0xfffffffeu; const unsigned p = __hip_atomic_fetch_add(WLN, 1u, __ATOMIC_RELAXED, __HIP_MEMORY_SCOPE_WORKGROUP); if (p < 64u) WL[p] = (unsigned)ql; } }
                __syncthreads();
                if (*FLG == 0u && *RTY != 0u) {
                    const int totr = (int)*WLN;
                    LAS unsigned* hist = (LAS unsigned*)(F.lds + 131072 + 512) + w * 512;
                    for (int guard = 0; guard < 40; ++guard) {
                        int idx = 0; if (lane == 0) idx = (int)__hip_atomic_fetch_add(WLH, 2u, __ATOMIC_RELAXED, __HIP_MEMORY_SCOPE_WORKGROUP);
                        idx = __builtin_amdgcn_readfirstlane(idx);
                        if ((unsigned)idx >= (unsigned)totr) break;
                        const bool two = idx + 1 < totr; const int qla = (int)WL[idx], qlb = two ? (int)WL[idx + 1] : qla;
                        select_top256_x2(CAND + qla * 512, CAND + qlb * 512, CNT + qla, CNT + qlb, THR + qla, THR + qlb, two, hist, lane);
                        LDS_WAIT();
                        if (lane == 0) { THR2[qla] = THR[qla]; CNT[qla] = 0u; if (two) { THR2[qlb] = THR[qlb]; CNT[qlb] = 0u; } }
                    }
                    __syncthreads();
                    if (__ballot(THR2[qloc] != 0xffffffffu) != 0ull)
                        idx_pass<2>(CAND, CNT, ZH, IKN, rowb, qf, iw, nsteps, half, qloc, qpos, THR2[qloc], fr, fq);
                    __syncthreads();
                    if (lane < 8) { const int ql = w * 8 + lane; const unsigned n = CNT[ql]; if (n < 256u || n > 512u || THR2[ql] == 0xfffffffeu) *FLG = 1u; }
                }
                __syncthreads();
                if (tid == 0) { *WLN = 0u; *WLH = 0u; }
                __syncthreads();
                fast = (*FLG == 0u);
                if (lane < 8 && fast) { const int ql = w * 8 + lane; if (CNT[ql] > 256u) { const unsigned p = __hip_atomic_fetch_add(WLN, 1u, __ATOMIC_RELAXED, __HIP_MEMORY_SCOPE_WORKGROUP); WL[p] = (unsigned)ql; } }
                __syncthreads();
                const int total = (int)*WLN;
                LAS unsigned* hist = (LAS unsigned*)(F.lds + 131072 + 512) + w * 512;
                for (int guard = 0; guard < 40; ++guard) {
                    int idx = 0; if (lane == 0) idx = (int)__hip_atomic_fetch_add(WLH, 2u, __ATOMIC_RELAXED, __HIP_MEMORY_SCOPE_WORKGROUP);
                    idx = __builtin_amdgcn_readfirstlane(idx);
                    if ((unsigned)idx >= (unsigned)total) break;
                    const bool two = idx + 1 < total; const int qla = (int)WL[idx], qlb = two ? (int)WL[idx + 1] : qla;
                    select_top256_x2(CAND + qla * 512, CAND + qlb * 512, CNT + qla, CNT + qlb, THR + qla, THR + qlb, two, hist, lane);
                    LDS_WAIT();
                }
                __syncthreads();
            }
        }
        if (!fast) { __syncthreads(); if (tid < 64) { CNT[tid] = 0u; THR[tid] = 0u; } __syncthreads(); }
        int lane_s = lane; asm volatile("" : "+v"(lane_s));
        { const int fr = lane_s & 15, fq = lane_s >> 4, qloc = 16 * qg + fr, qpos = q0 + qloc;
        bf16x8 kf[4][2];
#pragma unroll
        for (int tl = 0; tl < 4; ++tl)
#pragma unroll
            for (int ks = 0; ks < 2; ++ks) kf[tl][ks] = *(const bf16x8*)(IKN + (rowb + half * 64 + 16 * tl + fr) * 64 + ks * 32 + fq * 8);
#pragma clang loop unroll(disable)
        for (int st = 0; st < (fast ? 0 : nsteps); ++st) {
            const int kb = st * 128 + half * 64;
            const unsigned thr = THR[qloc];
            if (tid == 0) { *WLN = 0u; *WLH = 0u; }
            bf16x8 kn[4][2];
            { const int kbn = (st + 1 < nsteps) ? kb + 128 : kb;
#pragma unroll
              for (int tl = 0; tl < 4; ++tl)
#pragma unroll
                for (int ks = 0; ks < 2; ++ks) kn[tl][ks] = *(const bf16x8*)(IKN + (rowb + kbn + 16 * tl + fr) * 64 + ks * 32 + fq * 8); }
            unsigned ckv[16]; int nacc = 0;
#pragma unroll
            for (int tl = 0; tl < 4; ++tl) {
                f32x4 sc = (f32x4){0.f, 0.f, 0.f, 0.f};
#pragma unroll
                for (int h = 0; h < 4; ++h) { f32x4 a = (f32x4){0.f, 0.f, 0.f, 0.f}; a = MFMA16(kf[tl][0], qf[h][0], a); a = MFMA16(kf[tl][1], qf[h][1], a);
#pragma unroll
                    for (int i = 0; i < 4; ++i) sc[i] += __builtin_amdgcn_fmed3f(a[i], 0.f, 3.0e38f) * iw[h]; }
#pragma unroll
                for (int i = 0; i < 4; ++i) {
                    const int key = kb + 16 * tl + 4 * fq + i;
                    const float sv = sc[i] + 0.0f;
                    unsigned ub = __float_as_uint(sv); ub ^= (ub >> 31) ? 0xffffffffu : 0x80000000u;
                    const unsigned ck = (ub & 0xffffe000u) | (unsigned)(8191 - key);
                    const bool acc = (key <= qpos) && (ck > thr);
                    ckv[tl * 4 + i] = acc ? ck : 0u; nacc += acc ? 1 : 0;
                }
            }
            if (__ballot(nacc > 0)) {
                unsigned pos = __hip_atomic_fetch_add(CNT + qloc, (unsigned)nacc, __ATOMIC_RELAXED, __HIP_MEMORY_SCOPE_WORKGROUP);
#pragma unroll
                for (int j = 0; j < 16; ++j) if (ckv[j] != 0u) { if (pos < 512u) CAND[qloc * 512 + pos] = ckv[j]; ++pos; }
            }
#pragma unroll
            for (int tl = 0; tl < 4; ++tl)
#pragma unroll
                for (int ks = 0; ks < 2; ++ks) kf[tl][ks] = kn[tl][ks];
            __syncthreads();
            const bool lastst = (st == nsteps - 1);
            {
                if (lane < 8) { const int ql = w * 8 + lane; const unsigned n = CNT[ql];
                    if (n >= 384u || (lastst && n > 256u)) { const unsigned p = __hip_atomic_fetch_add(WLN, 1u, __ATOMIC_RELAXED, __HIP_MEMORY_SCOPE_WORKGROUP); WL[p] = (unsigned)ql; } }
                __syncthreads();
                const int total = (int)*WLN;
                LAS unsigned* hist = (LAS unsigned*)(F.lds + 131072 + 512) + w * 512;
                for (int guard = 0; guard < 40; ++guard) {
                    int idx = 0; if (lane == 0) idx = (int)__hip_atomic_fetch_add(WLH, 2u, __ATOMIC_RELAXED, __HIP_MEMORY_SCOPE_WORKGROUP);
                    idx = __builtin_amdgcn_readfirstlane(idx);
                    if ((unsigned)idx >= (unsigned)total) break;
                    const bool two = idx + 1 < total; const int qla = (int)WL[idx], qlb = two ? (int)WL[idx + 1] : qla;
#if PROBE_SEL
                    const unsigned ra = ref_threshold(CAND + qla * 512, (int)CNT[qla], lane), rb = ref_threshold(CAND + qlb * 512, (int)CNT[qlb], lane);
#endif
                    select_top256_x2(CAND + qla * 512, CAND + qlb * 512, CNT + qla, CNT + qlb, THR + qla, THR + qlb, two, hist, lane);
                    LDS_WAIT();
#if PROBE_SEL
                    if (THR[qla] != ra || (two && THR[qlb] != rb) || CNT[qla] != 256u) { if (lane == 0) __hip_atomic_store(F.ctl + CW_ERR, 1u, __ATOMIC_RELAXED, __HIP_MEMORY_SCOPE_AGENT); }
#endif
                }
            }
            __syncthreads();
        }
        }
        LAS unsigned* bm = (LAS unsigned*)(F.lds + 131072 + 512) + w * 512;
#pragma clang loop unroll(disable)
        for (int qq = 0; qq < 8; ++qq) { const int ql = w * 8 + qq; const int n = (int)CNT[ql];
            unsigned short* dst = IDXO + (rowb + q0 + ql) * 256;
#pragma unroll
            for (int i = 0; i < 4; ++i) bm[lane + 64 * i] = 0u;
#pragma unroll
            for (int i = 0; i < 4; ++i) { const int p = lane + 64 * i; if (p < n) { const unsigned key = 8191u - (CAND[ql * 512 + p] & 0x1fffu); __hip_atomic_fetch_or(bm + (key >> 5), 1u << (key & 31u), __ATOMIC_RELAXED, __HIP_MEMORY_SCOPE_WORKGROUP); } }
            LDS_WAIT();
            const u32x4 wv = *(const LAS u32x4*)(bm + 4 * lane);
            unsigned wd[4] = {wv.x, wv.y, wv.z, wv.w};
            const int cmine = __builtin_popcount(wd[0]) + __builtin_popcount(wd[1]) + __builtin_popcount(wd[2]) + __builtin_popcount(wd[3]);
            int incl = cmine;
#pragma unroll
            for (int o = 1; o < 64; o <<= 1) { const int v = shup_i(incl, o); if (lane >= o) incl += v; }
            int pos = incl - cmine;
#pragma unroll
            for (int jw = 0; jw < 4; ++jw) { unsigned word = wd[jw]; while (word) { const int bpos = __builtin_ctz(word); dst[pos++] = (unsigned short)((4 * lane + jw) * 32 + bpos); word &= word - 1u; } }
#pragma unroll
            for (int i = 0; i < 4; ++i) { const int p = lane + 64 * i; if (p >= n) dst[p] = (unsigned short)0xffffu; }
            LDS_WAIT();
        }
    }
    __syncthreads();
}
DI void idx_compare(Ctx& F) {
    const unsigned* a = (const unsigned*)(F.ws + WS_IDX); const unsigned* b = (const unsigned*)(F.ws + WS_QLAT); bool bad = false;
    for (size_t i = (size_t)F.bx * 512 + F.tid; i < (size_t)T * 128; i += (size_t)F.G * 512) bad |= a[i] != b[i];
    if (__ballot(bad)) { if (F.lane == 0) __hip_atomic_store(F.ctl + CW_ERR, 1u, __ATOMIC_RELAXED, __HIP_MEMORY_SCOPE_AGENT); }
}

DI int rotl4(int k) { return ((k << 1) & 15) | ((k >> 3) & 1); }
DI void dsa_attn_phase(Ctx& F) {
    const int tid = F.tid, lane = F.lane, w = F.wave, fr = lane & 15, fq = lane >> 4;
    LAS unsigned char* wl = F.lds + w * 17408;
    LAS unsigned short* IDL = (LAS unsigned short*)(wl + 16384);
    LAS unsigned char* BKL = wl + 16384 + 512;
    LAS float* RB = (LAS float*)(F.lds + 8 * 17408);
    LAS unsigned char* TBL = (LAS unsigned char*)(F.lds + 8 * 17408 + 1600);
    const bf16_t* PROJ = (const bf16_t*)(F.ws + WS_PROJ);
    const bf16_t* CN = (const bf16_t*)(F.ws + WS_CN);
    const unsigned short* IDX = (const unsigned short*)(F.ws + WS_IDX);
    const bf16_t* WUK = (const bf16_t*)(F.ws + WS_WUK); const bf16_t* WUVT = (const bf16_t*)(F.ws + WS_WUVT);
    bf16_t* QLAT = (bf16_t*)(F.ws + WS_QLAT); bf16_t* OLAT = (bf16_t*)(F.ws + WS_OLAT); bf16_t* MIX = (bf16_t*)(F.ws + WS_MIX);
    __syncthreads();
    if (tid < 384) RB[tid] = inp(F, I_RELB)[tid]; else if (tid < 396) RB[tid] = -1.0e30f;
    if (tid < 128) { int bk = tid; if (tid >= 16) { bk = 16 + (int)(logf((float)tid * (1.0f / 16.0f)) / logf(8.0f) * 16.0f); bk = bk > 31 ? 31 : bk; } TBL[tid] = (unsigned char)bk; }
    __syncthreads();
    for (int it = 0; (it + 1) * ((F.G >> 3) * 8) <= SEQ / 16; ++it) {
        const int tb = (F.bx & 7) * (SEQ / 16) + it * ((F.G >> 3) * 8) + (F.bx >> 3) * 8 + w;
        const size_t t0 = (size_t)tb * 16;
        const int b = (int)(t0 / SEQ);
        for (int h = 0; h < 12; ++h) {
            bf16x8 qf[2];
#pragma unroll
            for (int ks = 0; ks < 2; ++ks) qf[ks] = *(const bf16x8*)(PROJ + (t0 + fr) * WINBP + h * 64 + ks * 32 + fq * 8);
#pragma unroll
            for (int rt = 0; rt < 8; ++rt) { f32x4 a = (f32x4){0.f, 0.f, 0.f, 0.f};
#pragma unroll
                for (int ks = 0; ks < 2; ++ks) { const bf16x8 wf = *(const bf16x8*)(WUK + ((size_t)h * 128 + 16 * rt + fr) * 64 + ks * 32 + fq * 8); a = MFMA16(wf, qf[ks], a); }
                u32x2 o; o.x = cvt_pk_bf16(a[0] * 0.125f, a[1] * 0.125f); o.y = cvt_pk_bf16(a[2] * 0.125f, a[3] * 0.125f);
                *(u32x2*)(QLAT + ((t0 + fr) * 12 + h) * 128 + 16 * rt + 4 * fq) = o; }
        }
        VM_WAIT();
        for (int qi = 0; qi < 16; ++qi) {
            const size_t t = t0 + qi; const int pos = (int)(t % SEQ);
            LDS_WAIT();
            { const u32x2 iw2 = *(const u32x2*)(IDX + t * 256 + 4 * lane);
              const unsigned idv[4] = {iw2.x & 0xffffu, iw2.x >> 16, iw2.y & 0xffffu, iw2.y >> 16}; unsigned pk = 0u;
#pragma unroll
              for (int i = 0; i < 4; ++i) IDL[32 * (lane >> 3) + 8 * i + (lane & 7)] = (unsigned short)idv[i];
#pragma unroll
              for (int i = 0; i < 4; ++i) { const int rel = pos - (int)idv[i]; const bool ok = (idv[i] != 0xffffu) && rel >= 0; const int ti = rel < 0 ? 0 : (rel > 127 ? 127 : rel);
                  const unsigned tb = TBL[ti]; const unsigned bk = !ok ? 32u : (rel > 127 ? 31u : tb); pk |= bk << (8 * i); }
              *(LAS unsigned*)(BKL + 4 * lane) = pk; }
            bf16x8 ql[4];
#pragma unroll
            for (int ks = 0; ks < 4; ++ks) { u32x4 v = (u32x4){0u, 0u, 0u, 0u}; if (fr < 12) v = *(const u32x4*)(QLAT + (t * 12 + fr) * 128 + ks * 32 + fq * 8); ql[ks] = __builtin_bit_cast(bf16x8, v); }
            VM_WAIT(); LDS_WAIT();
            const bf16_t* cb = CN + (size_t)b * SEQ * 128;
#define DSA_ISSUE(c_) do { LAS unsigned char* buf_ = wl + ((c_) & 1) * 8192; const u32x4 iv_ = *(const LAS u32x4*)(IDL + 32 * (c_) + 8 * (lane >> 4)); const unsigned ivw_[4] = {iv_.x, iv_.y, iv_.z, iv_.w}; \
            _Pragma("unroll") for (int i_ = 0; i_ < 8; ++i_) { const int kk_ = 4 * i_ + (lane >> 4); \
                const int id_ = (int)((ivw_[i_ >> 1] >> (16 * (i_ & 1))) & 0x1fffu); const int p_ = (lane & 15) ^ rotl4(kk_ & 15); \
                __builtin_amdgcn_global_load_lds((const unsigned*)(cb + (size_t)id_ * 128 + p_ * 8), (LAS unsigned*)(buf_ + i_ * 1024), 16, 0, 0); } } while (0)
            f32x4 oacc[8];
#pragma unroll
            for (int rt = 0; rt < 8; ++rt) oacc[rt] = (f32x4){0.f, 0.f, 0.f, 0.f};
            float mrun = -INFINITY, lrun = 0.f;
            DSA_ISSUE(0);
            for (int c = 0; c < 8; ++c) {
                if (c < 7) { DSA_ISSUE(c + 1); asm volatile("s_waitcnt vmcnt(8)" ::: "memory"); } else { asm volatile("s_waitcnt vmcnt(0)" ::: "memory"); }
                const LAS unsigned char* buf = wl + (c & 1) * 8192;
                f32x4 sacc[2]; float lg[8];
#pragma unroll
                for (int jt = 0; jt < 2; ++jt) { sacc[jt] = (f32x4){0.f, 0.f, 0.f, 0.f};
#pragma unroll
                    for (int ks = 0; ks < 4; ++ks) { const bf16x8 cf = *(const LAS bf16x8*)(buf + (16 * jt + fr) * 256 + (((ks * 4 + fq) ^ rotl4(fr)) * 16)); sacc[jt] = MFMA16(cf, ql[ks], sacc[jt]); } }
                float mloc = -INFINITY;
                {
                    const unsigned bw0 = *(const LAS unsigned*)(BKL + 32 * c + 4 * fq), bw1 = *(const LAS unsigned*)(BKL + 32 * c + 16 + 4 * fq);
                    const int hh = fr < 12 ? fr : 0;
                    float bv[8]; unsigned bb[8];
#pragma unroll
                    for (int i = 0; i < 4; ++i) { bb[i] = (bw0 >> (8 * i)) & 0xffu; bb[4 + i] = (bw1 >> (8 * i)) & 0xffu; }
#pragma unroll
                    for (int i = 0; i < 8; ++i) bv[i] = RB[bb[i] * 12 + hh];
#pragma unroll
                    for (int i = 0; i < 8; ++i) { const float v = sacc[i >> 2][i & 3] + bv[i]; lg[i] = v; mloc = fmaxf(mloc, v); }
                }
                mloc = rows4_max(mloc);
                const float mnew = fmaxf(mrun, mloc);
                const float scl = __expf(mrun - mnew);
                float p[8], ps = 0.f;
#pragma unroll
                for (int i = 0; i < 8; ++i) { p[i] = __expf(lg[i] - mnew); ps += p[i]; }
                lrun = lrun * scl + ps; mrun = mnew;
                u32x4 pw; pw.x = cvt_pk_bf16(p[0], p[1]); pw.y = cvt_pk_bf16(p[2], p[3]); pw.z = cvt_pk_bf16(p[4], p[5]); pw.w = cvt_pk_bf16(p[6], p[7]);
                const bf16x8 pf = __builtin_bit_cast(bf16x8, pw);
                const int i16 = lane & 15, qr = i16 >> 2, pp = i16 & 3, kk0 = 4 * fq + qr;
                unsigned ta[8];
#pragma unroll
                for (int rt = 0; rt < 8; ++rt) ta[rt] = (unsigned)(size_t)buf + (unsigned)(kk0 * 256 + (((2 * rt + (pp >> 1)) ^ rotl4(kk0)) * 16) + 8 * (pp & 1));
                s16x4 tlo[8], thi[8];
                asm volatile("ds_read_b64_tr_b16 %0, %16\n\tds_read_b64_tr_b16 %8, %16 offset:4096\n\t"
                             "ds_read_b64_tr_b16 %1, %17\n\tds_read_b64_tr_b16 %9, %17 offset:4096\n\t"
                             "ds_read_b64_tr_b16 %2, %18\n\tds_read_b64_tr_b16 %10, %18 offset:4096\n\t"
                             "ds_read_b64_tr_b16 %3, %19\n\tds_read_b64_tr_b16 %11, %19 offset:4096\n\t"
                             "ds_read_b64_tr_b16 %4, %20\n\tds_read_b64_tr_b16 %12, %20 offset:4096\n\t"
                             "ds_read_b64_tr_b16 %5, %21\n\tds_read_b64_tr_b16 %13, %21 offset:4096\n\t"
                             "ds_read_b64_tr_b16 %6, %22\n\tds_read_b64_tr_b16 %14, %22 offset:4096\n\t"
                             "ds_read_b64_tr_b16 %7, %23\n\tds_read_b64_tr_b16 %15, %23 offset:4096\n\t"
                             "s_waitcnt lgkmcnt(0)"
                             : "=&v"(tlo[0]), "=&v"(tlo[1]), "=&v"(tlo[2]), "=&v"(tlo[3]), "=&v"(tlo[4]), "=&v"(tlo[5]), "=&v"(tlo[6]), "=&v"(tlo[7]),
                               "=&v"(thi[0]), "=&v"(thi[1]), "=&v"(thi[2]), "=&v"(thi[3]), "=&v"(thi[4]), "=&v"(thi[5]), "=&v"(thi[6]), "=&v"(thi[7])
                             : "v"(ta[0]), "v"(ta[1]), "v"(ta[2]), "v"(ta[3]), "v"(ta[4]), "v"(ta[5]), "v"(ta[6]), "v"(ta[7]) : "memory");
#pragma unroll
                for (int rt = 0; rt < 8; ++rt) {
                    const bf16x8 cf = __builtin_shufflevector(tlo[rt], thi[rt], 0, 1, 2, 3, 4, 5, 6, 7);
                    oacc[rt] = oacc[rt] * scl; oacc[rt] = MFMA16(cf, pf, oacc[rt]);
                }
                LDS_WAIT();
            }
            lrun = rows4_sum(lrun);
            const float inv = 1.0f / lrun;
            if (fr < 12) {
#pragma unroll
                for (int rt = 0; rt < 8; ++rt) { u32x2 o; o.x = cvt_pk_bf16(oacc[rt][0] * inv, oacc[rt][1] * inv); o.y = cvt_pk_bf16(oacc[rt][2] * inv, oacc[rt][3] * inv);
                    *(u32x2*)(OLAT + (t * 12 + fr) * 128 + 16 * rt + 4 * fq) = o; }
            }
        }
        VM_WAIT();
        for (int h = 0; h < 12; ++h) {
            bf16x8 of[4];
#pragma unroll
            for (int ks = 0; ks < 4; ++ks) of[ks] = *(const bf16x8*)(((DIAG_WUVQ == 1) ? QLAT : OLAT) + ((t0 + fr) * 12 + h) * 128 + ks * 32 + fq * 8);
#pragma unroll
            for (int dt = 0; dt < 4; ++dt) { f32x4 a = (f32x4){0.f, 0.f, 0.f, 0.f};
#pragma unroll
                for (int ks = 0; ks < 4; ++ks) { const bf16x8 wf = *(const bf16x8*)(WUVT + ((size_t)h * 64 + 16 * dt + fr) * 128 + ks * 32 + fq * 8); a = MFMA16(wf, of[ks], a); }
                u32x2 o; o.x = cvt_pk_bf16(a[0], a[1]); o.y = cvt_pk_bf16(a[2], a[3]);
                if (DIAG_WUVQ == 2) { o.x = 0x3f803f80u; o.y = 0x3f803f80u; }
                (void)o; *(unsigned*)((unsigned char*)MIX + (t0 + fr) * D + h * 64 + 16 * dt + 4 * fq) = pk4_fp8(a[0] * 16.0f, a[1] * 16.0f, a[2] * 16.0f, a[3] * 16.0f); }
        }
    }
    __syncthreads();
}

#define WSP(off) (F.ws + (off))
DI void site_proj0(Ctx F) {
    launder(F);
    pg8::DenseOrderT<T / 256, WINA / 256, 0> S; S.init(F.G, F.bx);
    pg8::EpiBf16<true> E{(bf16_t*)WSP(WS_PROJ), WINA, (bf16_t*)WSP(WS_KV), 1024};
    pg8::Gemm g{WSP(WS_XB8), WSP(WS_WINA), 1024, nullptr, nullptr, nullptr, 0x7d7d7d7d, 0x7a7a7a7a};
    pg8::gemm_phase<pg8::EpiBf16<true>, pg8::DenseOrderT<T / 256, WINA / 256, 0>, 2, true>(F.lds, g, S, E, F.tid);
}
DI void site_kv(Ctx F) {
    launder(F);
    pg8::DenseOrderT<0, 4, 32> S; S.init(F.G, F.bx);
    pg8::EpiBf16<true> E{(bf16_t*)WSP(WS_PROJ), WINA, (bf16_t*)WSP(WS_KV), 1024};
    pg8::Gemm g{WSP(WS_MEMBF), WSP(WS_WKV), 2048, nullptr, WSP(WS_MEMBF), WSP(WS_WKV), 0, 0};
    pg8::gemm_phase<pg8::EpiBf16<true>, pg8::DenseOrderT<0, 4, 32>, 0>(F.lds, g, S, E, F.tid);
}
DI void site_proj1(Ctx F) {
    launder(F);
    pg8::DenseOrderT<T / 256, WINBP / 256, 0> S; S.init(F.G, F.bx);
    pg8::EpiBf16<true> E{(bf16_t*)WSP(WS_PROJ), WINBP, (bf16_t*)WSP(WS_KV), 1024};
    pg8::Gemm g{WSP(WS_XB8), WSP(WS_WINB), 1024, nullptr, nullptr, nullptr, 0x7d7d7d7d, 0x7a7a7a7a};
    pg8::gemm_phase<pg8::EpiBf16<true>, pg8::DenseOrderT<T / 256, WINBP / 256, 0>, 2, true>(F.lds, g, S, E, F.tid);
}
DI void site_out0(Ctx F) {
    launder(F);
    pg8::Gemm g{WSP(WS_MIX), WSP(WS_WOUT), 2048, nullptr, nullptr, nullptr, 0, 0};
    pg8::DenseOrderT<T / 256, 4, 0> S; S.init(F.G, F.bx);
    pg8::EpiBf16<false> E{(bf16_t*)WSP(WS_Z), 1024, nullptr, 0};
    pg8::gemm_phase<pg8::EpiBf16<false>, pg8::DenseOrderT<T / 256, 4, 0>, 0>(F.lds, g, S, E, F.tid);
}
DI void site_out1(Ctx F) {
    launder(F);
    pg8::Gemm g{WSP(WS_MIX), WSP(WS_WOUT) + (size_t)1024 * 1024 * 2, 1024, nullptr, nullptr, nullptr, 0x7b7b7b7b, 0x7a7a7a7a};
    pg8::DenseOrderT<T / 256, 4, 0> S; S.init(F.G, F.bx);
    pg8::EpiBf16<false> E{(bf16_t*)WSP(WS_Z), 1024, nullptr, 0};
    pg8::gemm_phase<pg8::EpiBf16<false>, pg8::DenseOrderT<T / 256, 4, 0>, 2, true>(F.lds, g, S, E, F.tid);
}
DI void site_g1(Ctx F, int layer) {
    launder(F);
    build_mtab(F, layer);
    pg8::Gemm g{WSP(WS_XB8), WSP(WS_W1) + (size_t)layer * 32 * 2048 * 1024, 1024, (const unsigned*)WSP(WS_LIST), nullptr, nullptr, 0x7d7d7d7d, 0x7a7a7a7a};
    pg8::MoeOrder<8, true> S{(const LAS int*)(F.lds + MTAB_OFF), (const LAS unsigned*)(F.lds + GMTAB_OFF), F.G, F.bx, 2048};
    pg8::EpiSwiglu E{(unsigned char*)WSP(WS_ACT), inp(F, I_B1) + (size_t)layer * 32 * 2048};
    pg8::gemm_phase<pg8::EpiSwiglu, pg8::MoeOrder<8, true>, 1, true>(F.lds, g, S, E, F.tid);
}
DI void site_g2(Ctx F, int layer) {
    launder(F);
    build_mtab(F, layer);
    pg8::Gemm g{WSP(WS_ACT), WSP(WS_W2) + (size_t)layer * 32 * 1024 * 1024, 1024, nullptr, nullptr, nullptr, 0x7d7d7d7d, 0x79797979};
    pg8::MoeOrder<4, false> S{(const LAS int*)(F.lds + MTAB_OFF), (const LAS unsigned*)(F.lds + GMTAB_OFF), F.G, F.bx, 1024};
    pg8::EpiFp8Bias E{(unsigned char*)WSP(WS_Y), 1024, inp(F, I_B2) + (size_t)layer * 32 * 1024};
    pg8::gemm_phase<pg8::EpiFp8Bias, pg8::MoeOrder<4, false>, 2, true>(F.lds, g, S, E, F.tid);
}
#undef WSP

DI void dsa_check_phase(Ctx& F) {
    if (F.wave != 0) return;
    const int lane = F.lane;
    LAS float* SC = (LAS float*)F.lds;
    LAS float* IQF = (LAS float*)(F.lds + 32768);
    LAS unsigned* BM = (LAS unsigned*)(F.lds + 33792);
    LAS float* QL = (LAS float*)(F.lds + 34816);
    LAS float* OL = (LAS float*)(F.lds + 40960);
    LAS float* PP = (LAS float*)(F.lds + 47104);
    LAS unsigned short* SEL = (LAS unsigned short*)(F.lds + 59392);
    const bf16_t* PROJ = (const bf16_t*)(F.ws + WS_PROJ); const bf16_t* IKN = (const bf16_t*)(F.ws + WS_IKN); const bf16_t* CN = (const bf16_t*)(F.ws + WS_CN);
    const unsigned short* IDX = (const unsigned short*)(F.ws + WS_IDX); const bf16_t* MIX = (const bf16_t*)(F.ws + WS_MIX);
    const bf16_t* WUK = (const bf16_t*)(F.ws + WS_WUK); const bf16_t* WUVT = (const bf16_t*)(F.ws + WS_WUVT);
    const int ptab[8] = {3, 100, 255, 256, 300, 1500, 5000, 8191};
    int pos = 0;
#pragma unroll
    for (int q = 0; q < 8; ++q) if ((F.bx & 7) == q) pos = ptab[q];
    pos = (pos + (F.bx >> 3) * 211) & 8191; const int b = (F.bx >> 3) & 7;
    const size_t rowb = (size_t)b * SEQ, t = rowb + pos;
    unsigned err = 0u;
    for (int i = lane; i < 256; i += 64) IQF[i] = bf2f(PROJ[t * WINBP + B_IQ + i]);
    float iwv[4];
#pragma unroll
    for (int h = 0; h < 4; ++h) iwv[h] = bf2f(PROJ[t * WINBP + B_IW + h]) * 0.0625f;
    LDS_WAIT();
    for (int k = lane; k <= pos; k += 64) {
        float a[4] = {0.f, 0.f, 0.f, 0.f};
        for (int d = 0; d < 64; ++d) { const float kv = bf2f(IKN[(rowb + k) * 64 + d]);
#pragma unroll
            for (int h = 0; h < 4; ++h) a[h] += kv * IQF[h * 64 + d]; }
        float sc = 0.f;
#pragma unroll
        for (int h = 0; h < 4; ++h) sc += fmaxf(a[h], 0.f) * iwv[h];
        SC[k] = sc + 0.0f;
    }
    for (int i = lane; i < 256; i += 64) { BM[i] = 0u; SEL[i] = IDX[t * 256 + i]; }
    LDS_WAIT();
    int nsel = 0;
    for (int i = lane; i < 256; i += 64) { const unsigned id = SEL[i]; if (id != 0xffffu) { ++nsel; __hip_atomic_fetch_or(BM + (id >> 5), 1u << (id & 31u), __ATOMIC_RELAXED, __HIP_MEMORY_SCOPE_WORKGROUP); if ((int)id > pos) err |= 1u; } }
    nsel = (int)wave_sum_fast((float)nsel);
    LDS_WAIT();
    const int want = (pos + 1 < 256) ? pos + 1 : 256;
    if (nsel != want) err |= 2u;
    if (pos + 1 > 256) {
        unsigned prefix = 0u;
        for (int bit = 31; bit >= 0; --bit) { const unsigned c = prefix | (1u << bit); int cnt = 0;
            for (int k = lane; k <= pos; k += 64) { unsigned ub = __float_as_uint(SC[k]); ub ^= (ub >> 31) ? 0xffffffffu : 0x80000000u; cnt += (ub >= c) ? 1 : 0; }
            cnt = (int)wave_sum_fast((float)cnt); if (cnt >= 256) prefix = c; }
        int mism = 0, nge = 0;
        for (int k = lane; k <= pos; k += 64) { unsigned ub = __float_as_uint(SC[k]); ub ^= (ub >> 31) ? 0xffffffffu : 0x80000000u; const bool inr = ub >= prefix; const bool ins = (BM[k >> 5] >> (k & 31)) & 1u; mism += (inr != ins) ? 1 : 0; nge += inr ? 1 : 0; }
        mism = (int)wave_sum_fast((float)mism); nge = (int)wave_sum_fast((float)nge);
        if (mism > 8 + 2 * (nge - 256)) err |= 4u;
    }
    for (int i = lane; i < 12 * 128; i += 64) { const int h = i >> 7, r = i & 127; float a = 0.f;
        for (int d = 0; d < 64; ++d) a += bf2f(PROJ[t * WINBP + h * 64 + d]) * bf2f(WUK[((size_t)h * 128 + r) * 64 + d]);
        QL[i] = bf2f(f2bf(a * 0.125f)); }
    LDS_WAIT();
    for (int j = lane; j < 256; j += 64) { const unsigned id = SEL[j];
        for (int h = 0; h < 12; ++h) { float a = -INFINITY;
            if (id != 0xffffu) { a = 0.f; for (int r = 0; r < 128; ++r) a += QL[h * 128 + r] * bf2f(CN[(rowb + id) * 128 + r]);
                const int rel = pos - (int)id; int bk = rel; if (rel >= 16) { bk = 16 + (int)(logf((float)rel * (1.0f / 16.0f)) / logf(8.0f) * 16.0f); bk = bk > 31 ? 31 : bk; }
                a += inp(F, I_RELB)[bk * 12 + h]; }
            PP[h * 256 + j] = a; } }
    LDS_WAIT();
    for (int h = 0; h < 12; ++h) { float m = -INFINITY; for (int j = lane; j < 256; j += 64) m = fmaxf(m, PP[h * 256 + j]);
#pragma unroll
        for (int o = 1; o < 64; o <<= 1) m = fmaxf(m, shx(m, o));
        float sm = 0.f; for (int j = lane; j < 256; j += 64) { const float v = PP[h * 256 + j]; const float p = (v == -INFINITY) ? 0.f : __expf(v - m); PP[h * 256 + j] = p; sm += p; }
        sm = wave_sum_fast(sm); const float inv = 1.0f / sm; for (int j = lane; j < 256; j += 64) PP[h * 256 + j] *= inv; }
    LDS_WAIT();
    for (int i = lane; i < 12 * 128; i += 64) { const int h = i >> 7, r = i & 127; float a = 0.f;
        for (int j = 0; j < 256; ++j) { const unsigned id = SEL[j]; if (id != 0xffffu) a += PP[h * 256 + j] * bf2f(CN[(rowb + id) * 128 + r]); }
        OL[i] = a; }
    LDS_WAIT();
    float e2 = 0.f, r2 = 0.f;
    for (int i = lane; i < 768; i += 64) { const int h = i >> 6, d = i & 63; float a = 0.f;
        for (int r = 0; r < 128; ++r) a += OL[h * 128 + r] * bf2f(WUVT[((size_t)h * 64 + d) * 128 + r]);
        const float got = bf2f(MIX[t * D + i]); e2 += (a - got) * (a - got); r2 += a * a; }
    e2 = wave_sum_fast(e2); r2 = wave_sum_fast(r2);
    if (!(e2 <= 0.0025f * r2)) err |= 8u;
    if (err && lane == 0) __hip_atomic_fetch_or(F.ctl + CW_ERR, err, __ATOMIC_RELAXED, __HIP_MEMORY_SCOPE_AGENT);
}
DI void ph_dsacheck(Ctx F) { launder(F); dsa_check_phase(F); }
DI void memattn_check_phase(Ctx& F, int layer, int ldp, int mqcol) {
    if (F.wave != 1) return;
    const int lane = F.lane;
    LAS float* PM = (LAS float*)(F.lds + 65536);
    const bf16_t* PROJ = (const bf16_t*)(F.ws + WS_PROJ); const bf16_t* KV = (const bf16_t*)(F.ws + WS_KV); const bf16_t* MIX = (const bf16_t*)(F.ws + WS_MIX);
    const int pos = (F.bx * 131 + 17) & 8191, b = (F.bx >> 2) & 7; const size_t t = (size_t)b * SEQ + pos;
    float e2 = 0.f, r2 = 0.f;
    for (int h = 0; h < 4; ++h) {
        float lg[4];
#pragma unroll
        for (int i = 0; i < 4; ++i) { const int m = lane + 64 * i; float a = 0.f;
            for (int d = 0; d < 64; ++d) a += bf2f(PROJ[t * ldp + mqcol + h * 64 + d]) * bf2f(KV[(size_t)(b * MEML + m) * 1024 + layer * 512 + h * 64 + d]);
            lg[i] = a * 0.125f; }
        float mx = fmaxf(fmaxf(lg[0], lg[1]), fmaxf(lg[2], lg[3]));
#pragma unroll
        for (int o = 1; o < 64; o <<= 1) mx = fmaxf(mx, shx(mx, o));
        float sm = 0.f;
#pragma unroll
        for (int i = 0; i < 4; ++i) { lg[i] = __expf(lg[i] - mx); sm += lg[i]; }
        sm = wave_sum_fast(sm);
#pragma unroll
        for (int i = 0; i < 4; ++i) PM[lane + 64 * i] = lg[i] / sm;
        LDS_WAIT();
        float a = 0.f;
        for (int m = 0; m < 256; ++m) a += PM[m] * bf2f(KV[(size_t)(b * MEML + m) * 1024 + layer * 512 + 256 + h * 64 + lane]);
        const float got = bf2f(MIX[t * D + TOKW + h * 64 + lane]); e2 += (a - got) * (a - got); r2 += a * a;
        LDS_WAIT();
    }
    e2 = wave_sum_fast(e2); r2 = wave_sum_fast(r2);
    if (!(e2 <= 0.0025f * r2) && lane == 0) __hip_atomic_fetch_or(F.ctl + CW_ERR, 16u << layer, __ATOMIC_RELAXED, __HIP_MEMORY_SCOPE_AGENT);
}
DI void ph_memcheck(Ctx F, int layer) { launder(F); if (layer == 0) memattn_check_phase(F, 0, WINA, 2 * TOKW); else memattn_check_phase(F, 1, WINBP, B_MQ); }


DI void ph_prologue(Ctx F) { launder(F); p0_prologue(F); }
DI void ph_lru0(Ctx F) { launder(F); lru_phase<0>(F); }
DI void ph_lru1(Ctx F) { launder(F); lru_phase<1>(F); launder(F); memattn_phase(F, 0, WINA, 2 * TOKW); }
DI void ph_prep(Ctx F) { launder(F); dsa_prep_phase(F); }
template <int IMODE> DI void ph_indexer(Ctx F) { launder(F); indexer_phase<IMODE>(F); }
DI void ph_idxcmp(Ctx F) { launder(F); idx_compare(F); }
DI void ph_attn(Ctx F) { launder(F); dsa_attn_phase(F); launder(F); if (!DIAG_SKIPMEM) memattn_phase(F, 1, WINBP, B_MQ); }
DI void ph_lnr(Ctx F, int layer) { launder(F); ln_router_phase(F, layer); }
DI void ph_combine(Ctx F, int layer) { launder(F); combine_ln_phase(F, layer, F.out); }

constexpr int NPHASE = 18;
struct Args { const float* in[29]; float* out; unsigned char* ws; int ph_lo, ph_hi; };

__global__ void __launch_bounds__(512, 2) mk_fwd(Args args) {
    extern __shared__ __attribute__((aligned(16))) unsigned char lds_raw[];
    Ctx F;
    F.lds = (LAS unsigned char*)lds_raw;
    F.tid = threadIdx.x; F.lane = F.tid & 63; F.wave = __builtin_amdgcn_readfirstlane(F.tid >> 6);
    F.G = gridDim.x; F.bx = blockIdx.x;
    F.ws = args.ws; F.ctl = (unsigned*)(args.ws + WS_CTL); F.out = args.out;
    volatile LAS unsigned* MISC = (volatile LAS unsigned*)(F.lds + MISC_OFF);
#if DIAG_INIT
    for (int u = F.tid; u < MISC_OFF / 4; u += 512) ((LAS unsigned*)F.lds)[u] = 0u;
#endif
    for (int u = F.tid; u < (PTAB_OFF - MISC_OFF) / 4; u += 512) ((LAS unsigned*)(F.lds + MISC_OFF))[u] = 0u;
    if (F.tid == 0) {
#pragma unroll
        for (int i = 0; i < 29; ++i) *(LAS unsigned long long*)(F.lds + PTAB_OFF + 8 * i) = (unsigned long long)args.in[i];
    }
    __syncthreads();
    const int lo = args.ph_lo, hi = args.ph_hi;
    XcdBarrier bar; bar.bar = F.ctl + CW_BAR; bar.x = 0; bar.st = nullptr;
    if (hi - lo > 1) bar = xcd_barrier_post(F.ctl + CW_BAR, MISC + 8);
#ifndef PHASE_MASK
#define PHASE_MASK 0xffff
#endif
#define IN(k) (lo <= (k) && (k) < hi)
#define ON(site) ((((unsigned)PHASE_MASK) >> (site)) & 1u)
#define SEAM(k) do { if (ON(15) && IN(k) && IN((k) + 1)) { XcdBarrier b2_ = bar; { const unsigned long long p_ = (unsigned long long)b2_.bar; int pl_ = __builtin_amdgcn_readfirstlane((int)(unsigned)p_), ph_ = __builtin_amdgcn_readfirstlane((int)(unsigned)(p_ >> 32)); \
        asm volatile("" : "+s"(pl_), "+s"(ph_)); b2_.bar = (unsigned*)(GAS unsigned*)(((unsigned long long)(unsigned)ph_ << 32) | (unsigned)pl_); } \
        xcd_barrier(b2_); if (DBL(15)) { xcd_barrier(b2_); xcd_barrier(b2_); xcd_barrier(b2_); xcd_barrier(b2_); } } } while (0)
#define RUN(site, k, body) do { if (ON(site) && IN(k)) { body; } if (DBL(site) && IN(k)) { body; } } while (0)
    RUN(0, 0, ph_prologue(F));
    SEAM(0);
    for (int layer = 0; layer < 2; ++layer) {
        const int pb = layer ? 9 : 1;
        if (layer == 0) { RUN(1, pb, site_proj0(F)); RUN(1, pb, site_kv(F)); } else { RUN(1, pb, site_proj1(F)); }
        SEAM(pb);
        int po;
        if (layer == 0) {
            RUN(2, 2, ph_lru0(F));
            SEAM(2);
            RUN(3, 3, ph_lru1(F));
#if PROBE_DSA
            SEAM(3);
            if (ON(3) && IN(3)) { ph_memcheck(F, 0); }
#endif
            SEAM(3);
            po = 4;
        } else {
            RUN(10, 10, ph_prep(F));
            SEAM(10);
#if PROBE_CHECK
            if (ON(11) && IN(11)) { ph_indexer<0>(F); }
            SEAM(11);
#endif
            RUN(11, 11, ph_indexer<1>(F));
#if PROBE_CHECK
            SEAM(11);
            if (ON(11) && IN(11)) { ph_idxcmp(F); }
#endif
            SEAM(11);
            RUN(12, 12, ph_attn(F));
#if PROBE_DSA
            SEAM(12);
            if (ON(12) && IN(12)) { ph_dsacheck(F); ph_memcheck(F, 1); }
#endif
            SEAM(12);
            po = 13;
        }
        if (layer == 0) { RUN(4, po, site_out0(F)); } else { RUN(4, po, site_out1(F)); }
        SEAM(po);
        if (ON(5) && IN(po + 1)) { ph_lnr(F, layer); }
        SEAM(po + 1);
        RUN(6, po + 2, site_g1(F, layer));
        SEAM(po + 2);
        RUN(7, po + 3, site_g2(F, layer));
        SEAM(po + 3);
        RUN(8, po + 4, ph_combine(F, layer));
        if (layer == 0) SEAM(po + 4);
    }
#undef RUN
#undef IN
#undef SEAM
#if DIAG_DUMP
    if (lo == 100) {
        const size_t gt = (size_t)F.bx * 512 + F.tid, NT = (size_t)F.G * 512;
        for (size_t i = gt; i < (size_t)T * D; i += NT) {
            float v;
            if (DIAG_DUMP == 1) v = bf2f(((const bf16_t*)(args.ws + WS_MIX))[i]);
            else if (DIAG_DUMP == 2) v = bf2f(((const bf16_t*)(args.ws + WS_Z))[i]);
            else if (DIAG_DUMP == 3) v = ((const float*)(args.ws + WS_XA))[i];
            else if (DIAG_DUMP == 4) v = bf2f(((const bf16_t*)(args.ws + WS_PROJ))[i]);
            else if (DIAG_DUMP == 8) v = ((i & 1023) < 768) ? bf2f(((const bf16_t*)(args.ws + WS_MIX))[i]) : 0.f;
            else if (DIAG_DUMP == 9) v = ((i & 1023) >= 768) ? bf2f(((const bf16_t*)(args.ws + WS_MIX))[i]) : 0.f;
            else if (DIAG_DUMP == 10) v = bf2f(((const bf16_t*)(args.ws + WS_OLAT))[i + 33554432]);
            else if (DIAG_DUMP == 11) v = bf2f(((const bf16_t*)(args.ws + WS_QLAT))[i + 33554432]);
            else if (DIAG_DUMP == 12) v = bf2f(((const bf16_t*)(args.ws + WS_WUVT))[i % 98304]);
            else if (DIAG_DUMP == 6) v = bf2f(((const bf16_t*)(args.ws + WS_QLAT))[i]);
            else if (DIAG_DUMP == 7) v = bf2f(((const bf16_t*)(args.ws + WS_OLAT))[i]);
            else v = (float)((const unsigned short*)(args.ws + WS_IDX))[i % ((size_t)T * 256)];
            if (!(v - v == 0.f)) v = 12345.0f;
            F.out[i] = v; }
    }
#endif
}

extern "C" void kernel_launch(void* const* d_in, const int* in_sizes, int n_in, void* d_out, int out_size, void* d_ws, size_t ws_size, hipStream_t stream) {
    static int grid = 0;
    if (grid == 0) {
        if (n_in != 29 || out_size != T * D || ws_size < WS_END) { fprintf(stderr, "kernel_launch: unexpected shapes (n_in %d, out %d, ws %zu)\n", n_in, out_size, ws_size); grid = -1; return; }
        int dev = 0, cus = 0, per_cu = 0;
        if (hipGetDevice(&dev) != hipSuccess || hipDeviceGetAttribute(&cus, hipDeviceAttributeMultiprocessorCount, dev) != hipSuccess) { grid = -1; return; }
        if (hipFuncSetAttribute((const void*)mk_fwd, hipFuncAttributeMaxDynamicSharedMemorySize, LDS_BYTES) != hipSuccess) { fprintf(stderr, "kernel_launch: hipFuncSetAttribute failed\n"); grid = -1; return; }
        if (hipOccupancyMaxActiveBlocksPerMultiprocessor(&per_cu, (const void*)mk_fwd, 512, LDS_BYTES) != hipSuccess || per_cu < 1) { fprintf(stderr, "kernel_launch: occupancy query says %d\n", per_cu); (void)hipGetLastError(); grid = -1; return; }
        grid = cus;
    }
    if (grid < 0) return;
    if (hipMemsetAsync((char*)d_ws + WS_CTL, 0, CTL_BYTES, stream) != hipSuccess) return;
#if DIAG_INIT
    (void)hipMemsetAsync((char*)d_ws + CTL_BYTES, 0, WS_END - CTL_BYTES, stream);
    (void)hipMemsetAsync(d_out, 0, (size_t)T * D * 4, stream);
#endif
    Args a{};
    for (int i = 0; i < 29; ++i) a.in[i] = (const float*)d_in[i];
    a.out = (float*)d_out; a.ws = (unsigned char*)d_ws;
#if MK_SPLIT
    for (int p = 0; p <= DIAG_LAST && p < NPHASE; ++p) { a.ph_lo = p; a.ph_hi = p + 1; hipLaunchKernelGGL(mk_fwd, dim3(grid), dim3(512), LDS_BYTES, stream, a); }
#if DIAG_DUMP
    a.ph_lo = 100; a.ph_hi = 101; hipLaunchKernelGGL(mk_fwd, dim3(grid), dim3(512), LDS_BYTES, stream, a);
#endif
#elif defined(REPEAT_PHASE)
    a.ph_lo = 0; a.ph_hi = REPEAT_PHASE + 1; hipLaunchKernelGGL(mk_fwd, dim3(grid), dim3(512), LDS_BYTES, stream, a);
    (void)hipMemsetAsync((char*)d_ws + WS_CTL + CW_IQ * 4, 0, 4096, stream);
    a.ph_lo = REPEAT_PHASE; a.ph_hi = REPEAT_PHASE + 1; hipLaunchKernelGGL(mk_fwd, dim3(grid), dim3(512), LDS_BYTES, stream, a);
    if (REPEAT_PHASE + 1 < NPHASE) {
        (void)hipMemsetAsync((char*)d_ws + WS_CTL + CW_BAR * 4, 0, XCD_BAR_WORDS * 4, stream);
        a.ph_lo = REPEAT_PHASE + 1; a.ph_hi = NPHASE; hipLaunchKernelGGL(mk_fwd, dim3(grid), dim3(512), LDS_BYTES, stream, a);
    }
#else
    a.ph_lo = 0; a.ph_hi = NPHASE; hipLaunchKernelGGL(mk_fwd, dim3(grid), dim3(512), LDS_BYTES, stream, a);
#endif
}
```

```cpp
#include <hip/hip_runtime.h>
#include <cstdio>
#include <cstdint>

#ifndef DIAG_INIT
#define DIAG_INIT 0
#endif
#ifndef DIAG_LAST
#define DIAG_LAST 17
#endif
#ifndef DIAG_DUMP
#define DIAG_DUMP 0
#define DIAG_SKIPMEM 0
#define DIAG_WUVQ 0
#endif
#ifndef PROBE_CHECK
#define PROBE_CHECK 0
#endif
#ifndef PROBE_SEL
#define PROBE_SEL 0
#endif
#ifndef PROBE_PASS3
#define PROBE_PASS3 0
#endif
#ifndef PROBE_NOFB
#define PROBE_NOFB 0
#endif
#ifndef PROBE_NORETRY
#define PROBE_NORETRY 0
#endif
#ifndef PROBE_DSA
#define PROBE_DSA 0
#endif
#ifndef PROBE_SEL2
#define PROBE_SEL2 0
#endif
#ifndef MK_SPLIT
#define MK_SPLIT 0
#endif

#ifndef DBL_MASK
#define DBL_MASK 0
#endif
#define DBL(site) ((((unsigned)DBL_MASK) >> (site)) & 1u)

#define LAS __attribute__((address_space(3)))
#define GAS __attribute__((address_space(1)))
typedef unsigned short bf16_t;
typedef short bf16x8 __attribute__((ext_vector_type(8)));
typedef short s16x4 __attribute__((ext_vector_type(4)));
typedef float f32x4 __attribute__((ext_vector_type(4)));
typedef float f32x2 __attribute__((ext_vector_type(2)));
typedef unsigned u32x4 __attribute__((ext_vector_type(4)));
typedef unsigned u32x2 __attribute__((ext_vector_type(2)));
#define DI __device__ __forceinline__
#define MFMA16(a, b, c) __builtin_amdgcn_mfma_f32_16x16x32_bf16((a), (b), (c), 0, 0, 0)

constexpr int D = 1024, NB = 8, SEQ = 8192, T = NB * SEQ;
constexpr int TOKW = 768, MEMW = 256, MEML = 256;
constexpr int WINA = 1792, WINB = 1476, WINBP = 1536;
constexpr int NEXP = 32, DEXP = 1024;
constexpr float LN_EPS = 1e-5f;
constexpr float DN_ALPHA = 1.41421356237309515f;
constexpr int PMAX = 270336;
constexpr int B_C = 768, B_IQ = 896, B_IK = 1152, B_MQ = 1216, B_IW = 1472;

constexpr size_t MiB = 1u << 20;
constexpr size_t WS_CTL = 0, CTL_BYTES = 1 * MiB;
constexpr size_t WS_WINA = 1 * MiB;
constexpr size_t WS_WINB = 5 * MiB;
constexpr size_t WS_WKV = 8 * MiB;
constexpr size_t WS_WOUT = 10 * MiB;
constexpr size_t WS_WRT = 14 * MiB;
constexpr size_t WS_WUK = 14 * MiB + 256 * 1024;
constexpr size_t WS_WUVT = 14 * MiB + 512 * 1024;
constexpr size_t WS_ROUT = 15 * MiB;
constexpr size_t WS_MEMBF = 16 * MiB;
constexpr size_t WS_KV = 20 * MiB;
constexpr size_t WS_LSUM = 24 * MiB;
constexpr size_t WS_LIST = 32 * MiB;
constexpr size_t WS_TOKSLOT = 40 * MiB;
constexpr size_t WS_TOKGATE = 41 * MiB;
constexpr size_t WS_CN = 48 * MiB;
constexpr size_t WS_IKN = 64 * MiB;
constexpr size_t WS_IDX = 72 * MiB;
constexpr size_t WS_W1 = 112 * MiB;
constexpr size_t WS_W2 = 368 * MiB;
constexpr size_t WS_XB8 = 240 * MiB;
constexpr size_t WS_XA = 496 * MiB;
constexpr size_t WS_XBF = 752 * MiB;
constexpr size_t WS_ACT = 880 * MiB;
constexpr size_t WS_QLAT = WS_ACT, WS_OLAT = WS_ACT + 192 * MiB;
constexpr size_t WS_PROJ = 1408 * MiB;
constexpr size_t WS_MIX = 1632 * MiB;
constexpr size_t WS_Z = 1760 * MiB;
constexpr size_t WS_Y = 1408 * MiB;
constexpr size_t WS_END = 2016 * MiB;
constexpr int CW_BAR = 4096;
constexpr int CW_ERR = 8192;
constexpr int CW_CNT = 16384;
constexpr int CW_IQ = 20480;

constexpr int STAGE_BYTES = 131072;
constexpr int TOKTAB_OFF = STAGE_BYTES;
constexpr int LDS_BYTES = 163840;
constexpr int GMTAB_OFF = STAGE_BYTES + 2048;
constexpr int BIAS_OFF = STAGE_BYTES + 8192;
constexpr int MISC_OFF = LDS_BYTES - 2048;
constexpr int MTAB_OFF = MISC_OFF + 512;
constexpr int PTAB_OFF = MISC_OFF + 1024;

typedef __bf16 bf16x2_t __attribute__((ext_vector_type(2)));
DI unsigned cvt_pk_bf16(float lo, float hi) { const f32x2 v = {lo, hi}; const bf16x2_t r = __builtin_convertvector(v, bf16x2_t); return __builtin_bit_cast(unsigned, r); }
DI unsigned pk4_fp8(float a, float b, float c, float d) { unsigned w = 0u; w = (unsigned)__builtin_amdgcn_cvt_pk_fp8_f32(a, b, (int)w, false); w = (unsigned)__builtin_amdgcn_cvt_pk_fp8_f32(c, d, (int)w, true); return w; }
DI float bf2f(unsigned short b) { return __uint_as_float(((unsigned)b) << 16); }
DI float bflo(unsigned w) { return __uint_as_float(w << 16); }
DI float bfhi(unsigned w) { return __uint_as_float(w & 0xffff0000u); }
DI unsigned short f2bf(float f) { return (unsigned short)(cvt_pk_bf16(f, 0.f) & 0xffffu); }
DI float sigmoidf_(float x) { return __builtin_amdgcn_rcpf(1.0f + __expf(-x)); }
DI int shfl_lane() { unsigned m = 0xffffffffu; asm volatile("" : "+v"(m)); return (int)__builtin_amdgcn_mbcnt_hi(m, __builtin_amdgcn_mbcnt_lo(m, 0u)); }
DI float shx(float v, int o) { return __int_as_float(__builtin_amdgcn_ds_bpermute((shfl_lane() ^ o) << 2, __float_as_int(v))); }
DI int shup_i(int v, int o) { return __builtin_amdgcn_ds_bpermute((shfl_lane() - o) << 2, v); }
DI float rows4_max(float x) { unsigned u = __float_as_uint(x);
    auto a = __builtin_amdgcn_permlane16_swap(u, u, false, false); float m = fmaxf(__uint_as_float(a[0]), __uint_as_float(a[1])); u = __float_as_uint(m);
    auto b = __builtin_amdgcn_permlane32_swap(u, u, false, false); return fmaxf(__uint_as_float(b[0]), __uint_as_float(b[1])); }
DI float rows4_sum(float x) { unsigned u = __float_as_uint(x);
    auto a = __builtin_amdgcn_permlane16_swap(u, u, false, false); float m = __uint_as_float(a[0]) + __uint_as_float(a[1]); u = __float_as_uint(m);
    auto b = __builtin_amdgcn_permlane32_swap(u, u, false, false); return __uint_as_float(b[0]) + __uint_as_float(b[1]); }
DI float wave_sum(float v) {
#pragma unroll
    for (int o = 1; o < 64; o <<= 1) v += shx(v, o);
    return v;
}
DI u32x4 zero4_local() { unsigned z = 0u; asm volatile("" : "+v"(z)); return (u32x4){z, z, z, z}; }
DI float wave_sum_fast(float v) {
    int x = __float_as_int(v);
#define WSF_STEP(ctrl) x = __float_as_int(__int_as_float(x) + __int_as_float(__builtin_amdgcn_update_dpp(0, x, ctrl, 0xf, 0xf, true)));
    WSF_STEP(0x101) WSF_STEP(0x102) WSF_STEP(0x104) WSF_STEP(0x108)
#undef WSF_STEP
    return (__int_as_float(__builtin_amdgcn_readlane(x, 0)) + __int_as_float(__builtin_amdgcn_readlane(x, 16))) + (__int_as_float(__builtin_amdgcn_readlane(x, 32)) + __int_as_float(__builtin_amdgcn_readlane(x, 48)));
}
#define LDS_WAIT() asm volatile("s_waitcnt lgkmcnt(0)" ::: "memory")
#define VM_WAIT() asm volatile("s_waitcnt vmcnt(0)" ::: "memory")

#define XB_TMO      128
#define XB_XCNT(j)  (256  + 64 * (j))
#define XB_XSUB(j)  (1280 + 64 * (j))
#define XB_XGEN(j)  (2304 + 64 * (j))
#define XB_TOP      3328
#define XB_TOPGEN   3392
#define XCD_BAR_WORDS 3456
#define XB_SPIN_CAP (1u << 22)

DI unsigned xb_ld(unsigned* p)              { return __hip_atomic_load(p, __ATOMIC_RELAXED, __HIP_MEMORY_SCOPE_AGENT); }
DI unsigned xb_add(unsigned* p, unsigned v) { return __hip_atomic_fetch_add(p, v, __ATOMIC_RELAXED, __HIP_MEMORY_SCOPE_AGENT); }
DI unsigned xb_xcc_id() { return (unsigned)__builtin_amdgcn_s_getreg((3 << 11) | 20) & 0xFu; }
#define XB_SPIN(cond, bar) do { unsigned _sp = 0; while (cond) { __builtin_amdgcn_s_sleep(1); \
    if ((++_sp & 255u) == 0u) { if (xb_ld(&(bar)[XB_TMO])) break; if (_sp > XB_SPIN_CAP) { atomicAdd(&(bar)[XB_TMO], 1u); break; } } } } while (0)

struct XcdBarrier { unsigned* bar; unsigned x; volatile LAS unsigned* st; };

DI XcdBarrier xcd_barrier_post(unsigned* bar, volatile LAS unsigned* st) {
    XcdBarrier b; b.bar = bar; b.x = xb_xcc_id(); b.st = st;
    if (threadIdx.x == 0) (void)xb_add(&bar[XB_XCNT(b.x)], 1u);
    return b;
}
DI void xcd_barrier_complete(unsigned* bar, unsigned x, unsigned& nloc, unsigned& nx) {
    const unsigned G = gridDim.x * gridDim.y * gridDim.z;
    unsigned sum, cnt, mine, sp = 0u;
    for (;;) {
        sum = 0u; cnt = 0u; mine = 0u;
#pragma unroll
        for (unsigned j = 0; j < 16; ++j) { const unsigned c = xb_ld(&bar[XB_XCNT(j)]); sum += c; cnt += (c > 0u) ? 1u : 0u; mine = (j == x) ? c : mine; }
        if (sum == G) break;
        __builtin_amdgcn_s_sleep(1);
        if ((++sp & 255u) == 0u) { if (xb_ld(&bar[XB_TMO])) break; if (sp > XB_SPIN_CAP) { atomicAdd(&bar[XB_TMO], 1u); break; } }
    }
    nloc = mine > 0u ? mine : 1u; nx = cnt > 0u ? cnt : 1u;
}
DI void xcd_barrier(const XcdBarrier& b) {
    asm volatile("s_waitcnt vmcnt(0)" ::: "memory");
    __syncthreads();
    if (threadIdx.x == 0) {
        unsigned* bar = b.bar;
        __builtin_amdgcn_s_waitcnt(0);
        unsigned nloc = b.st[0], nx = b.st[1];
        if (nloc == 0u) { xcd_barrier_complete(bar, b.x, nloc, nx); b.st[0] = nloc; b.st[1] = nx; }
        const unsigned old = xb_add(&bar[XB_XSUB(b.x)], 1u);
        const unsigned gen = old / nloc;
        if (old + 1u == (gen + 1u) * nloc) {
            __builtin_amdgcn_fence(__ATOMIC_RELEASE, "agent");
            asm volatile("s_waitcnt vmcnt(0)" ::: "memory");
            const unsigned og = xb_add(&bar[XB_TOP], 1u);
            const unsigned tg = og / nx;
            if (og + 1u == (tg + 1u) * nx) xb_add(&bar[XB_TOPGEN], 1u);
            else XB_SPIN(xb_ld(&bar[XB_TOPGEN]) == tg, bar);
            __builtin_amdgcn_fence(__ATOMIC_ACQUIRE, "agent");
            xb_add(&bar[XB_XGEN(b.x)], 1u);
            asm volatile("s_waitcnt vmcnt(0)" ::: "memory");
        } else {
            XB_SPIN(xb_ld(&bar[XB_XGEN(b.x)]) == gen, bar);
            __builtin_amdgcn_fence(__ATOMIC_ACQUIRE, "agent");
            asm volatile("s_waitcnt vmcnt(0)" ::: "memory");
        }
    }
    __syncthreads();
}

namespace pg8 {
constexpr int BM = 256, BK = 64, HALF = 128, HTB = HALF * BK * 2;
DI int lds_byte(int r, int c) { const int st = (r >> 4) * 2 + (c >> 5), rr = r & 15, cc = c & 31, ob = rr * 64 + cc * 2; return st * 1024 + (ob ^ (((ob >> 9) & 1) << 5)); }
DI void stage_rc(int b, int& R, int& C) { const int st = b / 1024, sb = b % 1024, swz = sb ^ (((sb >> 9) & 1) << 5); R = (st >> 1) * 16 + swz / 64; C = (st & 1) * 32 + (swz % 64) / 2; }
DI int perm32(int rho) { const int n = rho >> 4, i = rho & 15; return 8 * (i >> 2) + 4 * n + (i & 3); }

struct Unit { int arow, brow, orow, ocol, e; };
struct Gemm { const void* A; const void* Bt; int K; const unsigned* list; const void* A2; const void* Bt2; int sa, sb; };

template <int nM, int nN, int nx2> struct DenseOrderT {
    static constexpr bool DUAL = true;
    static constexpr int nwg = nM * nN;
    int G, c;
    DI void init(int G_, int c_) { G = G_; c = c_; }
    DI bool next(int i, Unit& u) const {
        const int L = i * G + c; if (L >= nwg + nx2) return false;
        if (L >= nwg) { const int q = L - nwg; u.arow = (q >> 2) * BM; u.brow = (q & 3) * BM; u.orow = u.arow; u.ocol = u.brow; u.e = 1; return true; }
        int wgid = L; { constexpr int q = nwg / 8, r = nwg % 8; const int xcd = wgid % 8, off = wgid / 8; wgid = (xcd < r ? xcd * (q + 1) : r * (q + 1) + (xcd - r) * q) + off; }
        constexpr int nig = 8 * nN; const int gid = wgid / nig, fm = gid * 8, gsz = (nM - fm) < 8 ? (nM - fm) : 8;
        const int rem = wgid % nig; const int pm = fm + (gsz == 8 ? (rem & 7) : (rem % gsz)), pn = gsz == 8 ? (rem >> 3) : (rem / gsz);
        u.arow = pm * BM; u.brow = pn * BM; u.orow = pm * BM; u.ocol = pn * BM; u.e = 0; return true;
    }
};
template <int NN, bool GATHER> struct MoeOrder {
    static constexpr bool DUAL = false;
    const LAS int* mtab; const LAS unsigned* gmtab; int G, c, nrowsB;
    DI bool next(int i, Unit& u) const {
        constexpr int MG = 32 / NN;
        const int x = c & 7, j = c >> 3;
        const int per = G >> 3;
        const int TM = __builtin_amdgcn_readfirstlane(mtab[32]);
        const int slot = i * per + j;
        const int grp = (slot / 32) * 8 + x, within = slot % 32;
        const int gm = grp * MG + within / NN, pn = within % NN;
        if (gm >= TM) return false;
        const unsigned pk = (unsigned)__builtin_amdgcn_readfirstlane((int)gmtab[gm]);
        const int e = (int)(pk >> 16), mt = (int)(pk & 0xffffu);
        u.e = e; u.arow = GATHER ? (e * 65536 + mt * 256) : gm * 256; u.brow = e * nrowsB + pn * 256; u.orow = gm * 256; u.ocol = pn * 256; return true;
    }
};

template <bool DUALOUT> struct EpiBf16 {
    static constexpr bool PERM = true;
    bf16_t* O; int ldc; bf16_t* O2; int ldc2;
    DI void operator()(const f32x4 (&acc)[2][2][4][2], const Unit& u, int wr, int wc, int fr, int fq) const {
        const int row0 = u.orow + wr * 64 + fr, col0 = u.ocol + wc * 32 + 8 * fq;
        bf16_t* Ob = O; int ld = ldc; if (DUALOUT && u.e != 0) { Ob = O2; ld = ldc2; }
#pragma unroll
        for (int ai = 0; ai < 2; ++ai)
#pragma unroll
            for (int m = 0; m < 4; ++m) { bf16_t* rowp = Ob + (size_t)(row0 + ai * HALF + m * 16) * ld + col0;
#pragma unroll
                for (int bj = 0; bj < 2; ++bj) { const f32x4 v0 = acc[ai][bj][m][0], v1 = acc[ai][bj][m][1];
                    u32x4 w; w.x = cvt_pk_bf16(v0[0], v0[1]); w.y = cvt_pk_bf16(v0[2], v0[3]); w.z = cvt_pk_bf16(v1[0], v1[1]); w.w = cvt_pk_bf16(v1[2], v1[3]);
                    *(u32x4*)(rowp + bj * HALF) = w; } }
    }
};
struct EpiBf16Bias {
    static constexpr bool PERM = true;
    bf16_t* O; int ldc; const float* bias;
    DI void operator()(const f32x4 (&acc)[2][2][4][2], const Unit& u, int wr, int wc, int fr, int fq) const {
        const int row0 = u.orow + wr * 64 + fr, col0 = u.ocol + wc * 32 + 8 * fq;
        f32x4 bv[2][2];
#pragma unroll
        for (int bj = 0; bj < 2; ++bj) { bv[bj][0] = *(const f32x4*)(bias + u.e * 1024 + col0 + bj * HALF); bv[bj][1] = *(const f32x4*)(bias + u.e * 1024 + col0 + bj * HALF + 4); }
#pragma unroll
        for (int ai = 0; ai < 2; ++ai)
#pragma unroll
            for (int m = 0; m < 4; ++m) { bf16_t* rowp = O + (size_t)(row0 + ai * HALF + m * 16) * ldc + col0;
#pragma unroll
                for (int bj = 0; bj < 2; ++bj) { const f32x4 v0 = acc[ai][bj][m][0] + bv[bj][0], v1 = acc[ai][bj][m][1] + bv[bj][1];
                    u32x4 w; w.x = cvt_pk_bf16(v0[0], v0[1]); w.y = cvt_pk_bf16(v0[2], v0[3]); w.z = cvt_pk_bf16(v1[0], v1[1]); w.w = cvt_pk_bf16(v1[2], v1[3]);
                    *(u32x4*)(rowp + bj * HALF) = w; } }
    }
};
struct EpiFp8Bias {
    static constexpr bool PERM = true;
    unsigned char* O; int ldc; const float* bias;
    DI void bias_fetch(const Unit& u, LAS unsigned* dst, int lane) const { __builtin_amdgcn_global_load_lds((const unsigned*)(bias + u.e * 1024 + u.ocol + 4 * lane), dst, 16, 0, 0); }
    DI void operator()(const f32x4 (&acc)[2][2][4][2], const Unit& u, int wr, int wc, int fr, int fq, const LAS float* bl) const {
        const int row0 = u.orow + wr * 64 + fr, col0 = u.ocol + wc * 32 + 8 * fq;
        f32x4 bv[2][2];
#pragma unroll
        for (int bj = 0; bj < 2; ++bj) { bv[bj][0] = *(const LAS f32x4*)(bl + wc * 32 + 8 * fq + bj * HALF); bv[bj][1] = *(const LAS f32x4*)(bl + wc * 32 + 8 * fq + bj * HALF + 4); }
#pragma unroll
        for (int ai = 0; ai < 2; ++ai)
#pragma unroll
            for (int m = 0; m < 4; ++m) { unsigned char* rowp = O + (size_t)(row0 + ai * HALF + m * 16) * ldc + col0;
#pragma unroll
                for (int bj = 0; bj < 2; ++bj) { const f32x4 v0 = (acc[ai][bj][m][0] + bv[bj][0]) * 16.0f, v1 = (acc[ai][bj][m][1] + bv[bj][1]) * 16.0f;
                    u32x2 w; w.x = pk4_fp8(v0[0], v0[1], v0[2], v0[3]); w.y = pk4_fp8(v1[0], v1[1], v1[2], v1[3]);
                    *(u32x2*)(rowp + bj * HALF) = w; } }
    }
};
struct EpiResF32 {
    static constexpr bool PERM = false;
    float* Z; const float* res; float alpha; const bf16_t* resb;
    DI void operator()(const f32x4 (&acc)[2][2][4][2], const Unit& u, int wr, int wc, int fr, int fq) const {
        const int row0 = u.orow + wr * 64 + fr, col0 = u.ocol + wc * 32 + 4 * fq;
#pragma unroll
        for (int ai = 0; ai < 2; ++ai)
#pragma unroll
            for (int m = 0; m < 4; ++m) { const size_t off = (size_t)(row0 + ai * HALF + m * 16) * D + col0;
#pragma unroll
                for (int bj = 0; bj < 2; ++bj)
#pragma unroll
                    for (int n = 0; n < 2; ++n) { f32x4 r;
                        if (resb) { const u32x2 rw = *(const u32x2*)(resb + off + bj * HALF + n * 16); r = (f32x4){bflo(rw.x), bfhi(rw.x), bflo(rw.y), bfhi(rw.y)}; }
                        else r = *(const f32x4*)(res + off + bj * HALF + n * 16);
                        *(f32x4*)(Z + off + bj * HALF + n * 16) = r * alpha + acc[ai][bj][m][n]; }
                asm volatile("" ::: "memory"); }
    }
};
struct EpiResBf16 {
    static constexpr bool PERM = true;
    bf16_t* Z; const float* res; float alpha; const bf16_t* resb;
    DI void operator()(const f32x4 (&acc)[2][2][4][2], const Unit& u, int wr, int wc, int fr, int fq) const {
        const int row0 = u.orow + wr * 64 + fr, col0 = u.ocol + wc * 32 + 8 * fq;
#pragma unroll
        for (int ai = 0; ai < 2; ++ai)
#pragma unroll
            for (int m = 0; m < 4; ++m) { const size_t off = (size_t)(row0 + ai * HALF + m * 16) * D + col0;
#pragma unroll
                for (int bj = 0; bj < 2; ++bj) { f32x4 r0, r1;
                    if (resb) { const u32x4 rw = *(const u32x4*)(resb + off + bj * HALF); r0 = (f32x4){bflo(rw.x), bfhi(rw.x), bflo(rw.y), bfhi(rw.y)}; r1 = (f32x4){bflo(rw.z), bfhi(rw.z), bflo(rw.w), bfhi(rw.w)}; }
                    else { r0 = *(const f32x4*)(res + off + bj * HALF); r1 = *(const f32x4*)(res + off + bj * HALF + 4); }
                    const f32x4 v0 = r0 * alpha + acc[ai][bj][m][0], v1 = r1 * alpha + acc[ai][bj][m][1];
                    u32x4 w; w.x = cvt_pk_bf16(v0[0], v0[1]); w.y = cvt_pk_bf16(v0[2], v0[3]); w.z = cvt_pk_bf16(v1[0], v1[1]); w.w = cvt_pk_bf16(v1[2], v1[3]);
                    *(u32x4*)(Z + off + bj * HALF) = w; }
                asm volatile("" ::: "memory"); }
    }
};
struct EpiSwiglu {
    static constexpr bool PERM = true;
    unsigned char* O; const float* b1;
    DI void bias_fetch(const Unit& u, LAS unsigned* dst, int lane) const {
        const float* src = b1 + (size_t)u.e * 2048 + (u.ocol >> 1) + ((lane < 32) ? 4 * lane : 1024 + 4 * (lane - 32));
        __builtin_amdgcn_global_load_lds((const unsigned*)src, dst, 16, 0, 0);
    }
    DI void operator()(const f32x4 (&acc)[2][2][4][2], const Unit& u, int wr, int wc, int fr, int fq, const LAS float* bl) const {
        const int row0 = u.orow + wr * 64 + fr, g0 = (u.ocol >> 1) + wc * 32 + 8 * fq;
        f32x4 bg[2], bu[2];
#pragma unroll
        for (int n = 0; n < 2; ++n) { bg[n] = *(const LAS f32x4*)(bl + wc * 32 + 8 * fq + 4 * n); bu[n] = *(const LAS f32x4*)(bl + 128 + wc * 32 + 8 * fq + 4 * n); }
#pragma unroll
        for (int ai = 0; ai < 2; ++ai)
#pragma unroll
            for (int m = 0; m < 4; ++m) { unsigned char* rowp = O + (size_t)(row0 + ai * HALF + m * 16) * DEXP + g0;
                float o[8];
#pragma unroll
                for (int n = 0; n < 2; ++n)
#pragma unroll
                    for (int q = 0; q < 4; q += 2) {
                        f32x2 gt = (f32x2){acc[ai][0][m][n][q], acc[ai][0][m][n][q + 1]} + (f32x2){bg[n][q], bg[n][q + 1]};
                        f32x2 up = (f32x2){acc[ai][1][m][n][q], acc[ai][1][m][n][q + 1]} + (f32x2){bu[n][q], bu[n][q + 1]};
                        gt.x = fminf(gt.x, 7.0f); gt.y = fminf(gt.y, 7.0f);
                        up.x = __builtin_amdgcn_fmed3f(up.x, -7.0f, 7.0f); up.y = __builtin_amdgcn_fmed3f(up.y, -7.0f, 7.0f);
                        const f32x2 x = gt * (-2.45546696f);
                        f32x2 e; e.x = __builtin_amdgcn_exp2f(x.x); e.y = __builtin_amdgcn_exp2f(x.y);
                        const f32x2 d = e + 1.0f;
                        f32x2 sg; sg.x = __builtin_amdgcn_rcpf(d.x); sg.y = __builtin_amdgcn_rcpf(d.y);
                        const f32x2 u4 = up * 4.0f + 4.0f;
                        const f32x2 r = u4 * (gt * sg);
                        o[n * 4 + q] = r.x; o[n * 4 + q + 1] = r.y;
                    }
                u32x2 w; w.x = pk4_fp8(o[0], o[1], o[2], o[3]); w.y = pk4_fp8(o[4], o[5], o[6], o[7]);
                *(u32x2*)rowp = w; }
    }
};

typedef int v8i_t __attribute__((ext_vector_type(8)));
template <class E> struct epi_has_bias { static constexpr bool value = false; };
template <> struct epi_has_bias<EpiSwiglu> { static constexpr bool value = true; };
template <> struct epi_has_bias<EpiFp8Bias> { static constexpr bool value = true; };
template <class Epi, class Sched, int AM, bool FP8 = false>
DI void gemm_phase(LAS unsigned char* lds, const Gemm g, const Sched& S, const Epi& E, const int tid) {
    constexpr bool GATHER = (AM != 0);
    const int wid = __builtin_amdgcn_readfirstlane(tid >> 6), lane = tid & 63, wr = wid >> 2, wc = wid & 3, fr = lane & 15, fq = lane >> 4;
    const int K = g.K, nt = K / (BK * 2);
    unsigned voffA[2], voffB[2];
#pragma unroll
    for (int i = 0; i < 2; ++i) { int R, C; stage_rc(tid * 16 + i * 8192, R, C); const int Rb = Epi::PERM ? ((R & ~31) + perm32(R & 31)) : R;
        voffA[i] = (unsigned)(R * K + C * 2); voffB[i] = (unsigned)(Rb * K + C * 2); }
    const size_t kstep = (size_t)(BK * 2);
    const size_t hstep = (size_t)HALF * K;
    const unsigned ldsw = (unsigned)wid * 1024u;
    const int aoff = lds_byte(wr * 64 + fr, fq * 8), boff = lds_byte(wc * 32 + fr, fq * 8);
    LAS unsigned* toktab = (LAS unsigned*)(lds + TOKTAB_OFF);
#define PG8_SA(b, h) (((b) * 2 + (h)) * HTB)
#define PG8_SB(b, h) ((4 + (b) * 2 + (h)) * HTB)
#define PG8_STAGE(bufoff, gbase, voff) do { _Pragma("unroll") for (int _i = 0; _i < 2; ++_i) \
        __builtin_amdgcn_global_load_lds((const unsigned*)((const char*)(gbase) + (voff)[_i]), (LAS unsigned*)(lds + (bufoff) + ldsw + _i * 8192), 16, 0, 0); } while (0)
#define PG8_STAGE_A(bufoff, base, h) do { if constexpr (GATHER) { _Pragma("unroll") for (int _i = 0; _i < 2; ++_i) \
        __builtin_amdgcn_global_load_lds((const unsigned*)((const char*)(base) + vA[h][_i]), (LAS unsigned*)(lds + (bufoff) + ldsw + _i * 8192), 16, 0, 0); } \
        else { PG8_STAGE(bufoff, (const char*)(base) + (h) * hstep, voffA); } } while (0)
#define PG8_VA_DIRECT(row0) do { _Pragma("unroll") for (int h = 0; h < 2; ++h) _Pragma("unroll") for (int i = 0; i < 2; ++i) { int R, C; stage_rc(tid * 16 + i * 8192, R, C); \
        vA[h][i] = (unsigned)((row0) + h * HALF + R) * (unsigned)K + (unsigned)C * 2u; } } while (0)
#define PG8_VA_FROM(tab) do { _Pragma("unroll") for (int h = 0; h < 2; ++h) _Pragma("unroll") for (int i = 0; i < 2; ++i) { int R, C; stage_rc(tid * 16 + i * 8192, R, C); \
        const unsigned tk = (tab)[h * HALF + R] & 0xffffu; vA[h][i] = tk * (unsigned)K + (unsigned)C * 2u; } } while (0)
#define PG8_LD2(p) __builtin_bit_cast(v8i_t, __builtin_shufflevector(*(const LAS bf16x8*)(p), *(const LAS bf16x8*)((p) + 1024), 0, 1, 2, 3, 4, 5, 6, 7, 8, 9, 10, 11, 12, 13, 14, 15))
#define PG8_LDA(dst, b, h) do { _Pragma("unroll") for (int m = 0; m < 4; ++m) dst[m] = PG8_LD2(lds + PG8_SA(b, h) + aoff + m * 2048); } while (0)
#define PG8_LDB(dst, b, h) do { _Pragma("unroll") for (int n = 0; n < 2; ++n) dst[n] = PG8_LD2(lds + PG8_SB(b, h) + boff + n * 2048); } while (0)
#define PG8_HALF(v, k) __builtin_bit_cast(bf16x8, __builtin_shufflevector(v, v, 4 * (k), 4 * (k) + 1, 4 * (k) + 2, 4 * (k) + 3))
#define PG8_MMA(ai, bj, At, Bt) do { __builtin_amdgcn_s_setprio(1); _Pragma("unroll") for (int m = 0; m < 4; ++m) _Pragma("unroll") for (int n = 0; n < 2; ++n) { \
        if constexpr (FP8) { acc[ai][bj][m][n] = __builtin_amdgcn_mfma_scale_f32_16x16x128_f8f6f4(Bt[n], At[m], acc[ai][bj][m][n], 0, 0, 0, g.sb, 0, g.sa); } \
        else { acc[ai][bj][m][n] = __builtin_amdgcn_mfma_f32_16x16x32_bf16(PG8_HALF(Bt[n], 0), PG8_HALF(At[m], 0), acc[ai][bj][m][n], 0, 0, 0); \
               acc[ai][bj][m][n] = __builtin_amdgcn_mfma_f32_16x16x32_bf16(PG8_HALF(Bt[n], 1), PG8_HALF(At[m], 1), acc[ai][bj][m][n], 0, 0, 0); } } \
        __builtin_amdgcn_s_setprio(0); } while (0)
#define PG8_WAIT_V(n) asm volatile("s_waitcnt vmcnt(" #n ")" ::: "memory")
#define PG8_WAIT_L(n) asm volatile("s_waitcnt lgkmcnt(" #n ")" ::: "memory")
#define PG8_BAR __builtin_amdgcn_s_barrier()
#define PG8_SCHED __builtin_amdgcn_sched_barrier(0)
    Unit cur, nxt; int ui = 0;
    if (!S.next(0, cur)) return;
    f32x4 acc[2][2][4][2];
#pragma unroll
    for (int a = 0; a < 2; ++a)
#pragma unroll
        for (int b = 0; b < 2; ++b)
#pragma unroll
            for (int m = 0; m < 4; ++m)
#pragma unroll
                for (int n = 0; n < 2; ++n) acc[a][b][m][n] = (f32x4){0.f, 0.f, 0.f, 0.f};
    v8i_t At[4], B0[2], B1[2];
    unsigned vA[2][2];
    if constexpr (AM == 1) { PG8_VA_FROM(g.list + cur.arow); } else if constexpr (AM == 2) { PG8_VA_DIRECT(cur.arow); }
    else {
#pragma unroll
        for (int h = 0; h < 2; ++h)
#pragma unroll
            for (int i = 0; i < 2; ++i) vA[h][i] = 0u;
    }
    const char* cA = GATHER ? (const char*)g.A : (const char*)((Sched::DUAL && cur.e) ? g.A2 : g.A) + (size_t)cur.arow * K;
    const char* cB = (const char*)((Sched::DUAL && cur.e) ? g.Bt2 : g.Bt) + (size_t)cur.brow * K;
    PG8_STAGE(PG8_SB(0, 0), cB, voffB); PG8_STAGE(PG8_SB(0, 1), cB + hstep, voffB); PG8_STAGE_A(PG8_SA(0, 0), cA, 0); PG8_STAGE_A(PG8_SA(0, 1), cA, 1);
    if (wr == 1) PG8_BAR;
    PG8_WAIT_V(2); PG8_BAR;
    PG8_STAGE(PG8_SB(1, 0), cB + kstep, voffB); PG8_STAGE_A(PG8_SA(1, 0), cA + kstep, 0); PG8_STAGE(PG8_SB(1, 1), cB + hstep + kstep, voffB);
    PG8_WAIT_V(6); PG8_BAR;
    for (;;) {
        if constexpr (epi_has_bias<Epi>::value) E.bias_fetch(cur, (LAS unsigned*)(lds + BIAS_OFF + (wid * 2 + (ui & 1)) * 1024), lane);
        const bool has_next = S.next(ui + 1, nxt);
        const char* nA = GATHER ? (const char*)g.A : (has_next ? (const char*)((Sched::DUAL && nxt.e) ? g.A2 : g.A) + (size_t)nxt.arow * K : cA);
        const char* nB = has_next ? (const char*)((Sched::DUAL && nxt.e) ? g.Bt2 : g.Bt) + (size_t)nxt.brow * K : cB;
        if constexpr (AM == 1) {
            if (has_next && wid < 4)
                __builtin_amdgcn_global_load_lds((const unsigned*)(g.list + nxt.arow + wid * 64 + lane), (LAS unsigned*)(toktab + ((ui + 1) & 1) * 256 + wid * 64), 4, 0, 0);
        }
#pragma clang loop unroll(disable)
        for (int t = 0; t < nt; t += 2) {
            const bool last = (t == nt - 2);
            const char* a1 = cA + (size_t)(t + 1) * kstep;
            const char* a2 = last ? nA : cA + (size_t)(t + 2) * kstep; const char* b2 = last ? nB : cB + (size_t)(t + 2) * kstep;
            const char* a3 = a2 + kstep; const char* b3 = b2 + kstep;
            PG8_LDB(B0, 0, 0); PG8_LDB(B1, 0, 1); PG8_SCHED; PG8_LDA(At, 0, 0); PG8_STAGE_A(PG8_SA(1, 1), a1, 1);
            if constexpr (AM == 1) { if (last && has_next) { PG8_VA_FROM(toktab + ((ui + 1) & 1) * 256); } } else if constexpr (AM == 2) { if (last && has_next) { PG8_VA_DIRECT(nxt.arow); } }
            PG8_WAIT_V(8); PG8_WAIT_L(0); PG8_BAR; PG8_MMA(0, 0, At, B0); PG8_MMA(0, 1, At, B1); PG8_BAR; PG8_SCHED;
            PG8_LDA(At, 0, 1); PG8_STAGE(PG8_SB(0, 0), b2, voffB); PG8_STAGE(PG8_SB(0, 1), b2 + hstep, voffB); PG8_STAGE_A(PG8_SA(0, 0), a2, 0);
            PG8_WAIT_V(8); PG8_WAIT_L(0); PG8_BAR; PG8_MMA(1, 0, At, B0); PG8_MMA(1, 1, At, B1); PG8_BAR; PG8_SCHED;
            PG8_LDB(B0, 1, 0); PG8_LDB(B1, 1, 1); PG8_SCHED; PG8_LDA(At, 1, 0); PG8_STAGE_A(PG8_SA(0, 1), a2, 1);
            PG8_WAIT_V(8); PG8_WAIT_L(0); PG8_BAR; PG8_MMA(0, 0, At, B0); PG8_MMA(0, 1, At, B1); PG8_BAR; PG8_SCHED;
            PG8_LDA(At, 1, 1); PG8_STAGE(PG8_SB(1, 0), b3, voffB); PG8_STAGE(PG8_SB(1, 1), b3 + hstep, voffB); PG8_STAGE_A(PG8_SA(1, 0), a3, 0);
            PG8_WAIT_V(8); PG8_WAIT_L(0); PG8_BAR; PG8_MMA(1, 0, At, B0); PG8_MMA(1, 1, At, B1); PG8_BAR; PG8_SCHED;
        }
        if (wr == 0) PG8_BAR;
        if constexpr (epi_has_bias<Epi>::value) E(acc, cur, wr, wc, fr, fq, (const LAS float*)(lds + BIAS_OFF + (wid * 2 + (ui & 1)) * 1024)); else E(acc, cur, wr, wc, fr, fq);
        if (!has_next) break;
#pragma unroll
        for (int a = 0; a < 2; ++a)
#pragma unroll
            for (int b = 0; b < 2; ++b)
#pragma unroll
                for (int m = 0; m < 4; ++m)
#pragma unroll
                    for (int n = 0; n < 2; ++n) acc[a][b][m][n] = (f32x4){0.f, 0.f, 0.f, 0.f};
        cur = nxt; cA = nA; cB = nB; ++ui;
        if (wr == 1) PG8_BAR;
    }
    PG8_WAIT_V(0);
    PG8_BAR;
#undef PG8_SA
#undef PG8_SB
#undef PG8_STAGE
#undef PG8_STAGE_A
#undef PG8_VA_FROM
#undef PG8_VA_DIRECT
#undef PG8_LDA
#undef PG8_LD2
#undef PG8_HALF
#undef PG8_LDB
#undef PG8_MMA
#undef PG8_WAIT_V
#undef PG8_WAIT_L
#undef PG8_BAR
#undef PG8_SCHED
}
}

struct Ctx {
    LAS unsigned char* lds;
    int tid, lane, wave, G, bx;
    unsigned* ctl;
    unsigned char* ws;
    float* out;
};
DI const float* inp(const Ctx& F, int i) {
    const LAS unsigned* p = (const LAS unsigned*)(F.lds + PTAB_OFF) + 2 * i;
    const unsigned lo = (unsigned)__builtin_amdgcn_readfirstlane((int)p[0]), hi = (unsigned)__builtin_amdgcn_readfirstlane((int)p[1]);
    return (const float*)(const GAS float*)(((unsigned long long)hi << 32) | lo);
}
DI void launder(Ctx& F) { int t = F.wave * 64 + shfl_lane(); asm volatile("" : "+v"(t)); F.tid = t; F.lane = t & 63;
    const unsigned long long w = (unsigned long long)F.ws; int wl = __builtin_amdgcn_readfirstlane((int)(unsigned)w), wh = __builtin_amdgcn_readfirstlane((int)(unsigned)(w >> 32));
    asm volatile("" : "+s"(wl), "+s"(wh)); F.ws = (unsigned char*)(GAS unsigned char*)(((unsigned long long)(unsigned)wh << 32) | (unsigned)wl); F.ctl = (unsigned*)(F.ws + WS_CTL);
    int ll = __builtin_amdgcn_readfirstlane((int)(unsigned)(size_t)F.lds); asm volatile("" : "+s"(ll)); F.lds = (LAS unsigned char*)(size_t)(unsigned)ll;
    int gg = __builtin_amdgcn_readfirstlane(F.G), bb = __builtin_amdgcn_readfirstlane(F.bx); asm volatile("" : "+s"(gg), "+s"(bb)); F.G = gg; F.bx = bb; }
enum { I_X = 0, I_MEM, I_RELB, I_AWIN, I_ACONVW, I_ACONVB, I_AWR, I_ABR, I_AWI, I_ABI, I_ALAM, I_BWIN, I_BKVG, I_BWUK, I_BWUV, I_BIDXG, I_BIDXB,
       I_WMEMKV, I_WOUT, I_LN1G, I_LN1B, I_ROUTW, I_ROUTB, I_W1, I_B1, I_W2, I_B2, I_LN2G, I_LN2B };

DI void tr_item(const float* W, int sstride, bf16_t* dst, int dstride, int k0, int nvalid, LAS float* scr, int lane, bf16_t* dst_lo) {
    float v[32];
#pragma unroll
    for (int i = 0; i < 32; ++i) { const int kk = 2 * i + (lane >> 5), nn = lane & 31; const float x = W[(size_t)(k0 + kk) * sstride + (nn < nvalid ? nn : 0)]; v[i] = (nn < nvalid) ? x : 0.f; }
#pragma unroll
    for (int i = 0; i < 32; ++i) { const int kk = 2 * i + (lane >> 5); scr[kk * 33 + (lane & 31)] = v[i]; }
    LDS_WAIT();
    const int c = lane & 7;
#pragma unroll
    for (int j = 0; j < 4; ++j) { const int n = (lane >> 3) + 8 * j; const LAS float* s = scr + (8 * c) * 33 + n;
        float f[8];
#pragma unroll
        for (int q = 0; q < 8; ++q) f[q] = s[q * 33];
        u32x4 o; o.x = cvt_pk_bf16(f[0], f[1]); o.y = cvt_pk_bf16(f[2], f[3]); o.z = cvt_pk_bf16(f[4], f[5]); o.w = cvt_pk_bf16(f[6], f[7]);
        if (n < nvalid) *(u32x4*)(dst + (size_t)n * dstride + k0 + 8 * c) = o;
        if (dst_lo) {
            float r[8];
            r[0] = f[0] - bflo(o.x); r[1] = f[1] - bfhi(o.x); r[2] = f[2] - bflo(o.y); r[3] = f[3] - bfhi(o.y);
            r[4] = f[4] - bflo(o.z); r[5] = f[5] - bfhi(o.z); r[6] = f[6] - bflo(o.w); r[7] = f[7] - bfhi(o.w);
            u32x4 l; l.x = cvt_pk_bf16(r[0], r[1]); l.y = cvt_pk_bf16(r[2], r[3]); l.z = cvt_pk_bf16(r[4], r[5]); l.w = cvt_pk_bf16(r[6], r[7]);
            if (n < nvalid) *(u32x4*)(dst_lo + (size_t)n * dstride + k0 + 8 * c) = l;
        }
    }
    LDS_WAIT();
}

DI void tr8_load(const float* W, int sstride, int k0, int lane, float (&v)[32]) {
#pragma unroll
    for (int i = 0; i < 32; ++i) { const int kk = 2 * i + (lane >> 5), nn = lane & 31; v[i] = W[(size_t)(k0 + kk) * sstride + nn]; }
}
DI void tr8_store(const float (&v)[32], unsigned char* dst, int dstride, int k0, float scale, LAS float* scr, int lane) {
#pragma unroll
    for (int i = 0; i < 32; ++i) { const int kk = 2 * i + (lane >> 5); scr[kk * 33 + (lane & 31)] = v[i] * scale; }
    LDS_WAIT();
    const int c = lane & 3;
#pragma unroll
    for (int j = 0; j < 2; ++j) { const int n = (lane >> 2) + 16 * j; const LAS float* sp = scr + (16 * c) * 33 + n;
        float f[16];
#pragma unroll
        for (int q = 0; q < 16; ++q) f[q] = sp[q * 33];
        u32x4 o; o.x = pk4_fp8(f[0], f[1], f[2], f[3]); o.y = pk4_fp8(f[4], f[5], f[6], f[7]); o.z = pk4_fp8(f[8], f[9], f[10], f[11]); o.w = pk4_fp8(f[12], f[13], f[14], f[15]);
        *(u32x4*)(dst + (size_t)n * dstride + k0 + 16 * c) = o; }
    LDS_WAIT();
}
DI void tr8_item(const float* W, int sstride, unsigned char* dst, int dstride, int k0, int nvalid, float scale, LAS float* scr, int lane) {
    float v[32];
#pragma unroll
    for (int i = 0; i < 32; ++i) { const int kk = 2 * i + (lane >> 5), nn = lane & 31; const float x = W[(size_t)(k0 + kk) * sstride + (nn < nvalid ? nn : 0)]; v[i] = (nn < nvalid) ? x : 0.f; }
#pragma unroll
    for (int i = 0; i < 32; ++i) { const int kk = 2 * i + (lane >> 5); scr[kk * 33 + (lane & 31)] = v[i] * scale; }
    LDS_WAIT();
    const int c = lane & 3;
#pragma unroll
    for (int j = 0; j < 2; ++j) { const int n = (lane >> 2) + 16 * j; const LAS float* sp = scr + (16 * c) * 33 + n;
        float f[16];
#pragma unroll
        for (int q = 0; q < 16; ++q) f[q] = sp[q * 33];
        u32x4 o; o.x = pk4_fp8(f[0], f[1], f[2], f[3]); o.y = pk4_fp8(f[4], f[5], f[6], f[7]); o.z = pk4_fp8(f[8], f[9], f[10], f[11]); o.w = pk4_fp8(f[12], f[13], f[14], f[15]);
        if (n < nvalid) *(u32x4*)(dst + (size_t)n * dstride + k0 + 16 * c) = o; }
    LDS_WAIT();
}
struct Tr8Item { const float* W; int sstride; unsigned char* dst; int k0; float scale; };
DI Tr8Item tr8_decode(const Ctx& F, int it) {
    constexpr int I1 = 16 * 64, I2 = 16 * 32;
    const int le = it / (I1 + I2); int r = it % (I1 + I2); Tr8Item t;
    if (r < I1) { const int kb = r / 64, nb = r % 64; const int n0 = nb * 32;
        const int drow = (n0 < 1024) ? (256 * (n0 / 128) + (n0 % 128)) : (256 * ((n0 - 1024) / 128) + 128 + ((n0 - 1024) % 128));
        t.W = inp(F, I_W1) + (size_t)le * 1024 * 2048 + n0; t.sstride = 2048; t.dst = F.ws + WS_W1 + ((size_t)le * 2048 + drow) * 1024; t.k0 = kb * 64; t.scale = 32.0f;
    } else { r -= I1; const int kb = r / 32, nb = r % 32; const int n0 = nb * 32;
        t.W = inp(F, I_W2) + (size_t)le * 1024 * 1024 + n0; t.sstride = 1024; t.dst = F.ws + WS_W2 + ((size_t)le * 1024 + n0) * 1024; t.k0 = kb * 64; t.scale = 64.0f; }
    return t;
}

DI void p0_prologue(Ctx& F) {
    LAS float* scr = (LAS float*)(F.lds + F.wave * 16384);
    const int gw = F.bx * 8 + F.wave, NGW = F.G * 8, lane = F.lane;
    unsigned char* ws = F.ws;
    {
        constexpr int NIT = 64 * (16 * 64 + 16 * 32);
#define TR8_STAGE(vb_, idx_) do { const int ii_ = (idx_) < NIT ? (idx_) : NIT - 1; const Tr8Item t_ = tr8_decode(F, ii_); tr8_load(t_.W, t_.sstride, t_.k0, lane, vb_); } while (0)
#define TR8_DRAIN(vb_, idx_) do { if ((idx_) < NIT) { const Tr8Item c_ = tr8_decode(F, (idx_)); tr8_store(vb_, c_.dst, 1024, c_.k0, c_.scale, scr, lane); } } while (0)
        float v0[32], v1[32], v2[32];
        TR8_STAGE(v0, gw); TR8_STAGE(v1, gw + NGW);
        for (int it = gw; it < NIT; it += 3 * NGW) {
            TR8_STAGE(v2, it + 2 * NGW); __builtin_amdgcn_sched_barrier(0); TR8_DRAIN(v0, it); __builtin_amdgcn_sched_barrier(0);
            TR8_STAGE(v0, it + 3 * NGW); __builtin_amdgcn_sched_barrier(0); TR8_DRAIN(v1, it + NGW); __builtin_amdgcn_sched_barrier(0);
            TR8_STAGE(v1, it + 4 * NGW); __builtin_amdgcn_sched_barrier(0); TR8_DRAIN(v2, it + 2 * NGW); __builtin_amdgcn_sched_barrier(0);
        }
#undef TR8_STAGE
#undef TR8_DRAIN
    }
    {
        constexpr int IA = 16 * 56;
        constexpr int IB = 16 * 47;
        constexpr int IKV = 2 * 16 * 16;
        constexpr int IO = 2 * 16 * 32;
        constexpr int IR = 12 * 2 * 2;
        constexpr int IUV = 12 * 2 * 2;
        constexpr int IRT = 2 * 16;
        constexpr int NIT = IA + IB + IKV + IO + IR + IUV + IRT;
        for (int it = gw; it < NIT; it += NGW) {
            int r = it;
            if (r < IA) { const int kb = r / 56, nb = r % 56; tr8_item(inp(F, I_AWIN) + nb * 32, WINA, ws + WS_WINA + (size_t)(nb * 32) * 1024, 1024, kb * 64, 32, 32.0f, scr, lane); continue; } r -= IA;
            if (r < IB) { const int kb = r / 47, nb = r % 47;
                const int scol = (nb < 38) ? nb * 32 : (nb == 38) ? 1216 : 1220 + (nb - 39) * 32, drow = (nb < 38) ? nb * 32 : (nb == 38) ? B_IW : B_MQ + (nb - 39) * 32, nv = (nb == 38) ? 4 : 32;
                tr8_item(inp(F, I_BWIN) + scol, WINB, ws + WS_WINB + (size_t)drow * 1024, 1024, kb * 64, nv, 32.0f, scr, lane); continue; } r -= IB;
            if (r < IKV) { const int l = r / 256, q = r % 256, kb = q / 16, nb = q % 16; tr_item(inp(F, I_WMEMKV) + (size_t)l * 1024 * 512 + nb * 32, 512, (bf16_t*)(ws + WS_WKV) + (size_t)(l * 512 + nb * 32) * 1024, 1024, kb * 64, 32, scr, lane, nullptr); continue; } r -= IKV;
            if (r < IO) { const int l = r / 512, q = r % 512, kb = q / 32, nb = q % 32;
                if (l == 0) tr_item(inp(F, I_WOUT) + nb * 32, 1024, (bf16_t*)(ws + WS_WOUT) + (size_t)(nb * 32) * 1024, 1024, kb * 64, 32, scr, lane, nullptr);
                else tr8_item(inp(F, I_WOUT) + (size_t)1024 * 1024 + nb * 32, 1024, ws + WS_WOUT + (size_t)1024 * 1024 * 2 + (size_t)(nb * 32) * 1024, 1024, kb * 64, 32, 32.0f, scr, lane);
                continue; } r -= IO;
            if (r < IR) { const int n = r / 4, g = (r >> 1) & 1, nb = r & 1; const float* src = (g ? inp(F, I_AWI) : inp(F, I_AWR)) + (size_t)n * 4096 + nb * 32;
                tr_item(src, 64, (bf16_t*)(ws + WS_WRT) + ((size_t)(n * 2 + g) * 64 + nb * 32) * 64, 64, 0, 32, scr, lane, nullptr); continue; } r -= IR;
            if (r < IUV) { const int h = r / 4, kb = (r >> 1) & 1, nb = r & 1; tr_item(inp(F, I_BWUV) + h * 64 + nb * 32, 768, (bf16_t*)(ws + WS_WUVT) + ((size_t)h * 64 + nb * 32) * 128, 128, kb * 64, 32, scr, lane, nullptr); continue; } r -= IUV;
            { const int l = r / 16, kb = r % 16; bf16_t* hi = (bf16_t*)(ws + WS_ROUT) + (size_t)(l * 2) * 32 * 1024; tr_item(inp(F, I_ROUTW) + (size_t)l * 1024 * 32, 32, hi, 1024, kb * 64, 32, scr, lane, hi + 32 * 1024); }
        }
    }
    {
        const size_t gt = (size_t)F.bx * 512 + F.tid, NT = (size_t)F.G * 512;
        const f32x4* x4 = (const f32x4*)inp(F, I_X); unsigned* xb = (unsigned*)(ws + WS_XB8);
        for (size_t i = gt; i < (size_t)T * D / 4; i += NT) { const f32x4 v = x4[i]; xb[i] = pk4_fp8(v[0] * 4.0f, v[1] * 4.0f, v[2] * 4.0f, v[3] * 4.0f); }
        const f32x4* m4 = (const f32x4*)inp(F, I_MEM); u32x2* mb = (u32x2*)(ws + WS_MEMBF);
        for (size_t i = gt; i < (size_t)NB * MEML * D / 4; i += NT) { const f32x4 v = m4[i]; u32x2 o; o.x = cvt_pk_bf16(v[0], v[1]); o.y = cvt_pk_bf16(v[2], v[3]); mb[i] = o; }
        bf16_t* wuk = (bf16_t*)(ws + WS_WUK);
        for (size_t i = gt; i < (size_t)128 * 12 * 64; i += NT) { const int d = (int)(i & 63), h = (int)((i >> 6) % 12), rr = (int)(i / 768); wuk[((size_t)h * 128 + rr) * 64 + d] = f2bf(inp(F, I_BWUK)[i]); }
        unsigned* pad = (unsigned*)(ws + WS_WINB + (size_t)WINB * 1024);
        for (size_t i = gt; i < (size_t)(WINBP - WINB) * 1024 / 4; i += NT) pad[i] = 0u;
    }
}

constexpr int LC = 128, NCHUNK = SEQ / LC;
template <int PASS> DI void lru_phase(Ctx& F) {
    LAS unsigned char* lds = F.lds;
    LAS bf16_t* XC = (LAS bf16_t*)lds;
    LAS float* AA = (LAS float*)(lds + 18432);
    LAS float* UU = (LAS float*)(lds + 51200);
    LAS float* SEG = (LAS float*)(lds + 83968);
    LAS float* CSEG = (LAS float*)(lds + 88832);
    LAS float* PARA = (LAS float*)(lds + 92928);
    LAS float* CW = (LAS float*)(lds + 92928 + 9216);
    const int tid = F.tid, lane = F.lane, w = F.wave, fr = lane & 15, fq = lane >> 4;
    const bf16_t* PROJ = (const bf16_t*)(F.ws + WS_PROJ);
    const bf16_t* WRT = (const bf16_t*)(F.ws + WS_WRT);
    float* LSUM = (float*)(F.ws + WS_LSUM);
    bf16_t* MIX = (bf16_t*)(F.ws + WS_MIX);
    __syncthreads();
    for (int i = tid; i < TOKW; i += 512) { PARA[i] = inp(F, I_ABR)[i]; PARA[TOKW + i] = inp(F, I_ABI)[i]; PARA[2 * TOKW + i] = 8.0f * log1pf(__expf(-inp(F, I_ALAM)[i])); CW[4 * TOKW + i] = inp(F, I_ACONVB)[i]; }
    for (int i = tid; i < 4 * TOKW; i += 512) CW[i] = inp(F, I_ACONVW)[i];
    u32x4 xin[2][4];
#define LRU_LOAD_X(uu) do { const int n_ = (uu) % 12, k_ = ((uu) / 12) % NCHUNK, b_ = (uu) / (12 * NCHUNK); const size_t r0_ = (size_t)b_ * SEQ + (size_t)k_ * LC; \
        _Pragma("unroll") for (int it = 0; it < 2; ++it) { const int item = tid + 512 * it, t = item >> 3, c8 = item & 7, ch = n_ * 64 + c8 * 8; \
            _Pragma("unroll") for (int j = 0; j < 4; ++j) { const int sp = k_ * LC + t - 3 + j; xin[it][j] = (sp >= 0) ? *(const u32x4*)(PROJ + (r0_ + t - 3 + j) * WINA + ch) : (u32x4){0u, 0u, 0u, 0u}; } } } while (0)
    if (F.bx < NB * NCHUNK * 12) LRU_LOAD_X(F.bx);
    for (int u = F.bx; u < NB * NCHUNK * 12; u += F.G) {
        const int n = u % 12, k = (u / 12) % NCHUNK, b = u / (12 * NCHUNK);
        const size_t row0 = (size_t)b * SEQ + (size_t)k * LC;
        __syncthreads();
        const LAS float* PAR = PARA + n * 64;
        if (PASS == 1) {
            const int d = tid & 63, seg = tid >> 6; float A = 1.f, H = 0.f; f32x2 sv[8];
#pragma unroll
            for (int q = 0; q < 8; ++q) { const int kk = seg * 8 + q; sv[q] = (kk < k) ? *(const f32x2*)(LSUM + (((size_t)b * NCHUNK + kk) * TOKW + n * 64 + d) * 2) : (f32x2){1.f, 0.f}; }
#pragma unroll
            for (int q = 0; q < 8; ++q) { H = sv[q].x * H + sv[q].y; A *= sv[q].x; }
            CSEG[(seg * 64 + d) * 2] = A; CSEG[(seg * 64 + d) * 2 + 1] = H;
        }
#pragma unroll
        for (int it = 0; it < 2; ++it) {
            const int item = tid + 512 * it, t = item >> 3, c8 = item & 7, ch = n * 64 + c8 * 8;
            float accv[8];
            { const f32x4 b0 = *(const LAS f32x4*)(CW + 4 * TOKW + ch), b1 = *(const LAS f32x4*)(CW + 4 * TOKW + ch + 4);
#pragma unroll
              for (int q = 0; q < 4; ++q) { accv[q] = b0[q]; accv[4 + q] = b1[q]; } }
#pragma unroll
            for (int j = 0; j < 4; ++j) {
                const u32x4 xv = xin[it][j];
                const f32x4 w0 = *(const LAS f32x4*)(CW + j * TOKW + ch), w1 = *(const LAS f32x4*)(CW + j * TOKW + ch + 4);
                accv[0] += w0[0] * bflo(xv.x); accv[1] += w0[1] * bfhi(xv.x); accv[2] += w0[2] * bflo(xv.y); accv[3] += w0[3] * bfhi(xv.y);
                accv[4] += w1[0] * bflo(xv.z); accv[5] += w1[1] * bfhi(xv.z); accv[6] += w1[2] * bflo(xv.w); accv[7] += w1[3] * bfhi(xv.w);
            }
            u32x4 o; o.x = cvt_pk_bf16(accv[0], accv[1]); o.y = cvt_pk_bf16(accv[2], accv[3]); o.z = cvt_pk_bf16(accv[4], accv[5]); o.w = cvt_pk_bf16(accv[6], accv[7]);
            *(LAS u32x4*)(XC + t * 72 + c8 * 8) = o;
        }
        if (u + F.G < NB * NCHUNK * 12) LRU_LOAD_X(u + F.G);
        unsigned short gbv[16];
        if (PASS == 1) { const bf16_t* gbp = PROJ + (row0 + (tid >> 6) * 16) * WINA + TOKW + n * 64 + (tid & 63);
#pragma unroll
            for (int q = 0; q < 16; ++q) gbv[q] = gbp[(size_t)q * WINA]; }
        __syncthreads();
        {
            bf16x8 xb[2];
#pragma unroll
            for (int ks = 0; ks < 2; ++ks) xb[ks] = *(const LAS bf16x8*)(XC + (16 * w + fr) * 72 + ks * 32 + fq * 8);
            f32x4 acc[2][4];
#pragma unroll
            for (int g = 0; g < 2; ++g)
#pragma unroll
                for (int j = 0; j < 4; ++j) { acc[g][j] = (f32x4){0.f, 0.f, 0.f, 0.f};
#pragma unroll
                    for (int ks = 0; ks < 2; ++ks) { const bf16x8 wf = *(const bf16x8*)(WRT + ((size_t)(n * 2 + g) * 64 + 16 * j + fr) * 64 + ks * 32 + fq * 8); acc[g][j] = MFMA16(wf, xb[ks], acc[g][j]); } }
            const int t = 16 * w + fr;
#pragma unroll
            for (int j = 0; j < 4; ++j) {
                const int d0 = 16 * j + 4 * fq;
                const f32x4 br = *(const LAS f32x4*)(PAR + d0), bi = *(const LAS f32x4*)(PAR + TOKW + d0), sp = *(const LAS f32x4*)(PAR + 2 * TOKW + d0);
                const u32x2 xw = *(const LAS u32x2*)(XC + t * 72 + d0);
                const float xcv[4] = {bflo(xw.x), bfhi(xw.x), bflo(xw.y), bfhi(xw.y)};
                f32x4 av, uv;
#pragma unroll
                for (int q = 0; q < 4; ++q) {
                    const float rg = sigmoidf_(acc[0][j][q] + br[q]), ig = sigmoidf_(acc[1][j][q] + bi[q]);
                    const float la = -sp[q] * rg; const float a = __expf(la); const float x2 = 2.0f * la;
                    const float om = (x2 > -0.1f) ? (-x2 * (1.0f + x2 * (0.5f + x2 * (0.16666667f + x2 * 0.041666667f)))) : (1.0f - a * a);
                    av[q] = a; uv[q] = sqrtf(om) * ig * xcv[q];
                }
                *(LAS f32x4*)(AA + t * 64 + d0) = av; *(LAS f32x4*)(UU + t * 64 + d0) = uv;
            }
        }
        __syncthreads();
        const int d = tid & 63, seg = tid >> 6;
        {
            float A = 1.f, H = 0.f;
#pragma unroll
            for (int q = 0; q < 16; ++q) { const int t = seg * 16 + q; const float a = AA[t * 64 + d], uu = UU[t * 64 + d]; H = a * H + uu; A *= a; }
            SEG[(seg * 64 + d) * 2] = A; SEG[(seg * 64 + d) * 2 + 1] = H;
        }
        __syncthreads();
        if (PASS == 0) {
            if (tid < 64) { float A = 1.f, H = 0.f;
#pragma unroll
                for (int s = 0; s < 8; ++s) { const float As = SEG[(s * 64 + tid) * 2], Hs = SEG[(s * 64 + tid) * 2 + 1]; H = As * H + Hs; A *= As; }
                *(f32x2*)(LSUM + (((size_t)b * NCHUNK + k) * TOKW + n * 64 + tid) * 2) = (f32x2){A, H}; }
        } else {
            float h = 0.f;
#pragma unroll
            for (int s = 0; s < 8; ++s) h = CSEG[(s * 64 + d) * 2] * h + CSEG[(s * 64 + d) * 2 + 1];
#pragma unroll
            for (int s = 0; s < 8; ++s) if (s < seg) h = SEG[(s * 64 + d) * 2] * h + SEG[(s * 64 + d) * 2 + 1];
            bf16_t* op = MIX + (row0 + seg * 16) * D + n * 64 + d;
#pragma unroll
            for (int q = 0; q < 16; ++q) { const int t = seg * 16 + q; h = AA[t * 64 + d] * h + UU[t * 64 + d];
                const float g = bf2f(gbv[q]); const float y = 0.7978845608f * (g + 0.044715f * g * g * g); const float th = 1.0f - 2.0f * __builtin_amdgcn_rcpf(__expf(2.0f * y) + 1.0f);
                op[(size_t)q * D] = f2bf(h * 0.5f * g * (1.0f + th)); }
        }
    }
    __syncthreads();
#undef LRU_LOAD_X
}

DI void memattn_phase(Ctx& F, int layer, int ldp, int mqcol) {
    LAS unsigned char* lds = F.lds;
    LAS bf16_t* Kt = (LAS bf16_t*)lds;
    LAS bf16_t* Vt = (LAS bf16_t*)(lds + 36864);
    const int tid = F.tid, lane = F.lane, w = F.wave, fr = lane & 15, fq = lane >> 4;
    const bf16_t* PROJ = (const bf16_t*)(F.ws + WS_PROJ);
    const bf16_t* KV = (const bf16_t*)(F.ws + WS_KV);
    bf16_t* MIX = (bf16_t*)(F.ws + WS_MIX);
    for (int u = F.bx; u < NB * 4 * 8; u += F.G) {
        const int qc = u & 7, h = (u >> 3) & 3, b = u >> 5;
        __syncthreads();
#pragma unroll
        for (int it = 0; it < 4; ++it) { const int p = tid + 512 * it, key = p >> 3, c8 = p & 7;
            *(LAS u32x4*)(Kt + key * 72 + c8 * 8) = *(const u32x4*)(KV + (size_t)(b * MEML + key) * 1024 + layer * 512 + h * 64 + c8 * 8); }
        { const int key = tid & 255, dh = tid >> 8;
#pragma unroll
          for (int c = 0; c < 4; ++c) { const u32x4 v = *(const u32x4*)(KV + (size_t)(b * MEML + key) * 1024 + layer * 512 + 256 + h * 64 + dh * 32 + c * 8);
              const unsigned wv[4] = {v.x, v.y, v.z, v.w};
#pragma unroll
              for (int q = 0; q < 4; ++q) { const int dd = dh * 32 + c * 8 + 2 * q; Vt[dd * 264 + key] = (bf16_t)(wv[q] & 0xffffu); Vt[(dd + 1) * 264 + key] = (bf16_t)(wv[q] >> 16); } } }
        __syncthreads();
        for (int it = 0; it < 8; ++it) {
            const size_t q0 = (size_t)b * SEQ + qc * 1024 + it * 128 + w * 16;
            bf16x8 qf[2];
#pragma unroll
            for (int ks = 0; ks < 2; ++ks) qf[ks] = *(const bf16x8*)(PROJ + (q0 + fr) * ldp + mqcol + h * 64 + ks * 32 + fq * 8);
            f32x4 s[16];
#pragma unroll
            for (int jg = 0; jg < 4; ++jg) { bf16x8 kf[4][2];
#pragma unroll
                for (int jj = 0; jj < 4; ++jj)
#pragma unroll
                    for (int ks = 0; ks < 2; ++ks) kf[jj][ks] = *(const LAS bf16x8*)(Kt + (16 * (4 * jg + jj) + fr) * 72 + ks * 32 + fq * 8);
#pragma unroll
                for (int jj = 0; jj < 4; ++jj) { const int j = 4 * jg + jj; s[j] = (f32x4){0.f, 0.f, 0.f, 0.f};
#pragma unroll
                    for (int ks = 0; ks < 2; ++ks) s[j] = MFMA16(kf[jj][ks], qf[ks], s[j]); }
                asm volatile("" ::: "memory"); }
            float mx = -3.0e38f;
#pragma unroll
            for (int j = 0; j < 16; ++j) mx = fmaxf(mx, fmaxf(fmaxf(s[j][0], s[j][1]), fmaxf(s[j][2], s[j][3])));
            mx = rows4_max(mx);
            float l = 0.f; bf16x8 pf[8];
#pragma unroll
            for (int ks = 0; ks < 8; ++ks) { float p[8];
#pragma unroll
                for (int q = 0; q < 4; ++q) { p[q] = __expf((s[2 * ks][q] - mx) * 0.125f); p[4 + q] = __expf((s[2 * ks + 1][q] - mx) * 0.125f); }
#pragma unroll
                for (int q = 0; q < 8; ++q) l += p[q];
                u32x4 pw; pw.x = cvt_pk_bf16(p[0], p[1]); pw.y = cvt_pk_bf16(p[2], p[3]); pw.z = cvt_pk_bf16(p[4], p[5]); pw.w = cvt_pk_bf16(p[6], p[7]);
                pf[ks] = __builtin_bit_cast(bf16x8, pw); }
            l = rows4_sum(l);
            const float inv = 1.0f / l;
            f32x4 o[4];
#pragma unroll
            for (int dt = 0; dt < 4; ++dt) o[dt] = (f32x4){0.f, 0.f, 0.f, 0.f};
#pragma unroll
            for (int ks = 0; ks < 8; ++ks) { bf16x8 vf[4];
#pragma unroll
                for (int dt = 0; dt < 4; ++dt) { const LAS bf16_t* vp = Vt + (16 * dt + fr) * 264 + 32 * ks + 4 * fq;
                    const s16x4 lo = *(const LAS s16x4*)vp, hi = *(const LAS s16x4*)(vp + 16); vf[dt] = __builtin_shufflevector(lo, hi, 0, 1, 2, 3, 4, 5, 6, 7); }
#pragma unroll
                for (int dt = 0; dt < 4; ++dt) o[dt] = MFMA16(vf[dt], pf[ks], o[dt]); }
#pragma unroll
            for (int dt = 0; dt < 4; ++dt) { u32x2 ow; ow.x = cvt_pk_bf16(o[dt][0] * inv, o[dt][1] * inv); ow.y = cvt_pk_bf16(o[dt][2] * inv, o[dt][3] * inv);
                if (layer == 0) *(u32x2*)(MIX + (q0 + fr) * D + TOKW + h * 64 + 16 * dt + 4 * fq) = ow;
                else *(unsigned*)((unsigned char*)MIX + (q0 + fr) * D + TOKW + h * 64 + 16 * dt + 4 * fq) = pk4_fp8(o[dt][0] * inv * 16.0f, o[dt][1] * inv * 16.0f, o[dt][2] * inv * 16.0f, o[dt][3] * inv * 16.0f); }
            asm volatile("" ::: "memory");
        }
    }
    __syncthreads();
}

DI void build_mtab(Ctx& F, int layer) {
    LAS int* mtab = (LAS int*)(F.lds + MTAB_OFF);
    __syncthreads();
    if (F.tid < 64) {
        const int l = F.tid; unsigned c = 0u;
        if (l < 32) c = __hip_atomic_load(F.ctl + CW_CNT + (layer * 32 + l) * 16, __ATOMIC_RELAXED, __HIP_MEMORY_SCOPE_AGENT);
        const int nt = (int)((c + 255u) >> 8); int incl = nt;
#pragma unroll
        for (int o = 1; o < 32; o <<= 1) { const int u = shup_i(incl, o); if (l >= o) incl += u; }
        if (l < 32) mtab[l] = incl - nt;
        if (l == 31) mtab[32] = incl; }
    __syncthreads();
    LAS unsigned* gmtab = (LAS unsigned*)(F.lds + GMTAB_OFF);
    for (int gm = F.tid; gm < mtab[32] && gm < 1056; gm += 512) { int e = 0;
        for (int q = 1; q < 32; ++q) e += (gm >= mtab[q]) ? 1 : 0;
        gmtab[gm] = ((unsigned)e << 16) | (unsigned)(gm - mtab[e]); }
    __syncthreads();
}

DI unsigned wave_max_u(unsigned v);
DI void ln_router_phase(Ctx& F, int layer) {
    LAS float* WR = (LAS float*)F.lds;
    LAS unsigned* lcnt = (LAS unsigned*)(F.lds + 147456);
    LAS unsigned* lbase = (LAS unsigned*)(F.lds + 147456 + 128);
    LAS unsigned* stash = (LAS unsigned*)(F.lds + 147456 + 256);
    constexpr int ROWS_IT = 16;
    LAS float* stg = (LAS float*)(stash + 8 * ROWS_IT * 4);
    const int tid = F.tid, lane = F.lane, w = F.wave;
    const bf16_t* Z = (const bf16_t*)(F.ws + WS_Z);
    float* XA = (float*)(F.ws + WS_XA);
    bf16_t* XBF = (bf16_t*)(F.ws + WS_XBF); unsigned char* XB8 = F.ws + WS_XB8;
    const float* gam = inp(F, I_LN1G) + layer * D; const float* bet = inp(F, I_LN1B) + layer * D;
    const float* rw = inp(F, I_ROUTW) + (size_t)layer * 1024 * 32; const float* rb = inp(F, I_ROUTB) + layer * 32;
    unsigned* LIST = (unsigned*)(F.ws + WS_LIST); unsigned* TOKSLOT = (unsigned*)(F.ws + WS_TOKSLOT); float* TOKGATE = (float*)(F.ws + WS_TOKGATE);
    __syncthreads();
    for (int p = tid; p < 1024 * 8; p += 512) { const int c = p >> 3, k = p & 7; *(LAS f32x4*)(WR + ((c & 3) * 256 + (c >> 2)) * 36 + 4 * k) = *(const f32x4*)(rw + (size_t)c * 32 + 4 * k); }
    f32x4 g4[4], b4[4];
#pragma unroll
    for (int j = 0; j < 4; ++j) { g4[j] = *(const f32x4*)(gam + 4 * lane + 256 * j); b4[j] = *(const f32x4*)(bet + 4 * lane + 256 * j); }
    const int myexp = (((lane >> 5) & 1) << 4) | (((lane >> 4) & 1) << 3) | (((lane >> 3) & 1) << 2) | (((lane >> 2) & 1) << 1) | ((lane >> 1) & 1);
    const float mybias = rb[myexp];
    const int rows_blk = 8 * ROWS_IT;
    for (int it = 0; (it * F.G + F.bx) * rows_blk < T; ++it) {
        const int row0 = (it * F.G + F.bx) * rows_blk + w * ROWS_IT;
        __syncthreads();
        if (tid < 32) lcnt[tid] = 0u;
        __syncthreads();
        u32x2 vnx[4]; f32x4 rfx[4]; u32x2 rbx[4];
        const float* xres = inp(F, I_X);
#pragma unroll
        for (int j = 0; j < 4; ++j) { vnx[j] = *(const u32x2*)(Z + (size_t)row0 * D + 4 * lane + 256 * j);
            if (layer == 0) rfx[j] = *(const f32x4*)(xres + (size_t)row0 * D + 4 * lane + 256 * j); else rbx[j] = *(const u32x2*)(XBF + (size_t)row0 * D + 4 * lane + 256 * j); }
        for (int rr2 = 0; rr2 < (DBL(5) ? 2 * ROWS_IT : ROWS_IT); ++rr2) {
            const int r = rr2 % ROWS_IT; const bool publish = !DBL(5) || rr2 >= ROWS_IT;
            const size_t row = (size_t)row0 + r;
            f32x4 v[4];
#pragma unroll
            for (int j = 0; j < 4; ++j) { const f32x4 res = (layer == 0) ? rfx[j] : (f32x4){bflo(rbx[j].x), bfhi(rbx[j].x), bflo(rbx[j].y), bfhi(rbx[j].y)};
                v[j] = res * DN_ALPHA + (f32x4){bflo(vnx[j].x), bfhi(vnx[j].x), bflo(vnx[j].y), bfhi(vnx[j].y)}; }
            { const size_t rown = (size_t)row0 + ((rr2 + 1) % ROWS_IT);
#pragma unroll
              for (int j = 0; j < 4; ++j) { vnx[j] = *(const u32x2*)(Z + rown * D + 4 * lane + 256 * j);
                  if (layer == 0) rfx[j] = *(const f32x4*)(xres + rown * D + 4 * lane + 256 * j); else rbx[j] = *(const u32x2*)(XBF + rown * D + 4 * lane + 256 * j); } }
            __builtin_amdgcn_sched_barrier(0);
            float s = 0.f;
#pragma unroll
            for (int j = 0; j < 4; ++j) s += (v[j][0] + v[j][1]) + (v[j][2] + v[j][3]);
            const float mean = wave_sum_fast(s) * (1.0f / D); float s2 = 0.f;
#pragma unroll
            for (int j = 0; j < 4; ++j) { v[j] = v[j] - mean; s2 += (v[j][0] * v[j][0] + v[j][1] * v[j][1]) + (v[j][2] * v[j][2] + v[j][3] * v[j][3]); }
            const float rstd = 1.0f / sqrtf(wave_sum_fast(s2) * (1.0f / D) + LN_EPS);
#pragma unroll
            for (int j = 0; j < 4; ++j) { v[j] = v[j] * rstd * g4[j] + b4[j];
                u32x2 o; o.x = cvt_pk_bf16(v[j][0], v[j][1]); o.y = cvt_pk_bf16(v[j][2], v[j][3]); *(u32x2*)(XBF + row * D + 4 * lane + 256 * j) = o;
                *(unsigned*)(XB8 + row * D + 4 * lane + 256 * j) = pk4_fp8(v[j][0] * 4.0f, v[j][1] * 4.0f, v[j][2] * 4.0f, v[j][3] * 4.0f); }
            f32x4 accv[8], wq[2][8];
#pragma unroll
            for (int k = 0; k < 8; ++k) { accv[k] = (f32x4){0.f, 0.f, 0.f, 0.f}; wq[0][k] = *(const LAS f32x4*)(WR + lane * 36 + 4 * k); }
#pragma unroll
            for (int ci = 0; ci < 16; ++ci) { const int j = ci >> 2, i = ci & 3;
                if (ci + 1 < 16) { const int jn = (ci + 1) >> 2, in = (ci + 1) & 3; const LAS float* wp = WR + (in * 256 + lane + 64 * jn) * 36;
#pragma unroll
                    for (int k = 0; k < 8; ++k) wq[(ci + 1) & 1][k] = *(const LAS f32x4*)(wp + 4 * k); }
                __builtin_amdgcn_sched_barrier(0);
                const float xv = v[j][i];
#pragma unroll
                for (int k = 0; k < 8; ++k) accv[k] += wq[ci & 1][k] * xv;
                __builtin_amdgcn_sched_barrier(0);
            }
            float acc[32];
#pragma unroll
            for (int e = 0; e < 32; ++e) acc[e] = accv[e >> 2][e & 3];
#define RED_LEVEL(o, n) { const bool up = (lane & (o)) != 0; _Pragma("unroll") for (int q = 0; q < (n); ++q) { const float send = up ? acc[q] : acc[q + (n)]; const float keep = up ? acc[q + (n)] : acc[q]; acc[q] = keep + shx(send, (o)); } }
#pragma unroll
            for (int q = 0; q < 16; ++q) { const auto pr = __builtin_amdgcn_permlane32_swap(__float_as_uint(acc[q]), __float_as_uint(acc[q + 16]), false, false); acc[q] = __uint_as_float(pr[0]) + __uint_as_float(pr[1]); }
#pragma unroll
            for (int q = 0; q < 8; ++q) { const auto pr = __builtin_amdgcn_permlane16_swap(__float_as_uint(acc[q]), __float_as_uint(acc[q + 8]), false, false); acc[q] = __uint_as_float(pr[0]) + __uint_as_float(pr[1]); }
            RED_LEVEL(8, 4) RED_LEVEL(4, 2) RED_LEVEL(2, 1)
#undef RED_LEVEL
            float lg = acc[0] + shx(acc[0], 1) + mybias;
            float tv[4]; int te[4];
#pragma unroll
            for (int k = 0; k < 4; ++k) {
                unsigned ub = __float_as_uint(lg); ub ^= (ub >> 31) ? 0xffffffffu : 0x80000000u;
                const unsigned mxk = wave_max_u(ub);
                const unsigned cand = (ub == mxk) ? (unsigned)(32 - myexp) : 0u;
                const int ewin = 32 - (int)wave_max_u(cand);
                unsigned mb = mxk; mb ^= (mb >> 31) ? 0x80000000u : 0xffffffffu;
                tv[k] = __uint_as_float(mb); te[k] = ewin;
                if (myexp == ewin) lg = -3.0e38f;
            }
            float gsum = 0.f, gk[4];
#pragma unroll
            for (int k = 0; k < 4; ++k) { gk[k] = __expf(tv[k] - tv[0]); gsum += gk[k]; }
            const float ginv = 1.0f / gsum;
            if (lane < 4 && publish) { int e = te[0]; float g = gk[0];
#pragma unroll
                for (int k = 1; k < 4; ++k) if (lane == k) { e = te[k]; g = gk[k]; }
                const unsigned pos = __hip_atomic_fetch_add(lcnt + e, 1u, __ATOMIC_RELAXED, __HIP_MEMORY_SCOPE_WORKGROUP);
                stash[(w * ROWS_IT + r) * 4 + lane] = ((unsigned)e << 24) | pos; stg[(w * ROWS_IT + r) * 4 + lane] = g * ginv; }
        }
        __syncthreads();
        if (tid < 32) lbase[tid] = __hip_atomic_fetch_add(F.ctl + CW_CNT + (layer * 32 + tid) * 16, lcnt[tid], __ATOMIC_RELAXED, __HIP_MEMORY_SCOPE_AGENT);
        __syncthreads();
        { const int rr = lane >> 2, k = lane & 3;
          const unsigned sv = stash[(w * ROWS_IT + rr) * 4 + k]; const int e = (int)(sv >> 24); const unsigned slot = lbase[e] + (sv & 0xffffffu);
          const size_t row = (size_t)row0 + rr;
          LIST[(size_t)e * 65536 + slot] = (unsigned)row; TOKSLOT[row * 4 + k] = ((unsigned)e << 20) | slot; TOKGATE[row * 4 + k] = stg[(w * ROWS_IT + rr) * 4 + k]; }
    }
    __syncthreads();
}

DI void combine_ln_phase(Ctx& F, int layer, float* outf) {
    build_mtab(F, layer);
    const LAS int* mtab = (const LAS int*)(F.lds + MTAB_OFF);
    const int lane = F.lane;
    const float* XA = (const float*)(F.ws + WS_XA);
    const unsigned char* Y = F.ws + WS_Y;
    bf16_t* XBF = (bf16_t*)(F.ws + WS_XBF);
    const unsigned* TOKSLOT = (const unsigned*)(F.ws + WS_TOKSLOT); const float* TOKGATE = (const float*)(F.ws + WS_TOKGATE);
    const float* gam = inp(F, I_LN2G) + layer * D; const float* bet = inp(F, I_LN2B) + layer * D;
    const int gw = F.bx * 8 + F.wave, NGW = F.G * 8;
    const bool perr = (PROBE_CHECK || PROBE_DSA) && layer == 1 && __hip_atomic_load(F.ctl + CW_ERR, __ATOMIC_RELAXED, __HIP_MEMORY_SCOPE_AGENT) != 0u;
    f32x4 g4[4], b4[4];
#pragma unroll
    for (int j = 0; j < 4; ++j) { g4[j] = *(const f32x4*)(gam + 4 * lane + 256 * j); b4[j] = *(const f32x4*)(bet + 4 * lane + 256 * j); }
#define CMB_ISSUE(xw_, yw_, ts_, r_) do { const unsigned tsv_[4] = {ts_.x, ts_.y, ts_.z, ts_.w}; \
        _Pragma("unroll") for (int j = 0; j < 4; ++j) xw_[j] = *(const u32x2*)(XBF + (size_t)(r_) * D + 4 * lane + 256 * j); \
        _Pragma("unroll") for (int k = 0; k < 4; ++k) { const int e_ = (int)(tsv_[k] >> 20), slot_ = (int)(tsv_[k] & 0xfffffu); const size_t yrow_ = (size_t)mtab[e_] * 256 + slot_; \
            _Pragma("unroll") for (int j = 0; j < 4; ++j) yw_[k][j] = *(const unsigned*)(Y + yrow_ * D + 4 * lane + 256 * j); } } while (0)
    u32x2 xwc[4]; unsigned ywc[4][4]; f32x4 tgc;
    u32x4 tsn; f32x4 tgn;
    { const int r0 = gw < T ? gw : 0; const u32x4 ts0 = *(const u32x4*)(TOKSLOT + (size_t)r0 * 4); tgc = *(const f32x4*)(TOKGATE + (size_t)r0 * 4);
      const int r1 = (gw + NGW < T) ? gw + NGW : r0; tsn = *(const u32x4*)(TOKSLOT + (size_t)r1 * 4); tgn = *(const f32x4*)(TOKGATE + (size_t)r1 * 4);
      CMB_ISSUE(xwc, ywc, ts0, r0); }
    for (int row = gw; row < T; row += NGW) {
        u32x2 xwn[4]; unsigned ywn[4][4]; const f32x4 tgn1 = tgn;
        { const int r1 = (row + NGW < T) ? row + NGW : row; CMB_ISSUE(xwn, ywn, tsn, r1);
          const int r2 = (row + 2 * NGW < T) ? row + 2 * NGW : row; tsn = *(const u32x4*)(TOKSLOT + (size_t)r2 * 4); tgn = *(const f32x4*)(TOKGATE + (size_t)r2 * 4); }
        __builtin_amdgcn_sched_barrier(0);
        f32x4 v[4];
#pragma unroll
        for (int j = 0; j < 4; ++j) v[j] = (f32x4){bflo(xwc[j].x), bfhi(xwc[j].x), bflo(xwc[j].y), bfhi(xwc[j].y)} * DN_ALPHA;
#pragma unroll
        for (int k = 0; k < 4; ++k) { const float g = tgc[k] * 0.0625f;
#pragma unroll
            for (int j = 0; j < 4; ++j) { const unsigned yw = ywc[k][j]; const f32x2 ya = __builtin_amdgcn_cvt_pk_f32_fp8((int)yw, false), yb = __builtin_amdgcn_cvt_pk_f32_fp8((int)yw, true);
                v[j][0] += g * ya[0]; v[j][1] += g * ya[1]; v[j][2] += g * yb[0]; v[j][3] += g * yb[1]; } }
        float s = 0.f;
#pragma unroll
        for (int j = 0; j < 4; ++j) s += (v[j][0] + v[j][1]) + (v[j][2] + v[j][3]);
        const float mean = wave_sum_fast(s) * (1.0f / D); float s2 = 0.f;
#pragma unroll
        for (int j = 0; j < 4; ++j) { v[j] = v[j] - mean; s2 += (v[j][0] * v[j][0] + v[j][1] * v[j][1]) + (v[j][2] * v[j][2] + v[j][3] * v[j][3]); }
        const float rstd = 1.0f / sqrtf(wave_sum_fast(s2) * (1.0f / D) + LN_EPS);
#pragma unroll
        for (int j = 0; j < 4; ++j) { const int c = 4 * lane + 256 * j; f32x4 y = v[j] * rstd * g4[j] + b4[j];
            if ((PROBE_CHECK || PROBE_DSA) && perr) y = (f32x4){__builtin_nanf(""), __builtin_nanf(""), __builtin_nanf(""), __builtin_nanf("")};
            if (layer == 1) *(f32x4*)(outf + (size_t)row * D + c) = y;
            if (layer == 0) { u32x2 o; o.x = cvt_pk_bf16(y[0], y[1]); o.y = cvt_pk_bf16(y[2], y[3]); *(u32x2*)(XBF + (size_t)row * D + c) = o; }
            if (layer == 0) *(unsigned*)(F.ws + WS_XB8 + (size_t)row * D + c) = pk4_fp8(y[0] * 4.0f, y[1] * 4.0f, y[2] * 4.0f, y[3] * 4.0f); }
        tgc = tgn1;
#pragma unroll
        for (int j = 0; j < 4; ++j) { xwc[j] = xwn[j];
#pragma unroll
            for (int k = 0; k < 4; ++k) ywc[k][j] = ywn[k][j]; }
    }
#undef CMB_ISSUE
}

DI void dsa_prep_phase(Ctx& F) {
    const bf16_t* PROJ = (const bf16_t*)(F.ws + WS_PROJ);
    bf16_t* CN = (bf16_t*)(F.ws + WS_CN); bf16_t* IKN = (bf16_t*)(F.ws + WS_IKN);
    const int sub = F.lane & 15, tq = F.lane >> 4;
    const int gw = F.bx * 8 + F.wave, NGW = F.G * 8;
    for (int t4 = gw; t4 < T / 4; t4 += NGW) {
        const size_t row = (size_t)t4 * 4 + tq;
        const u32x4 cv = *(const u32x4*)(PROJ + row * WINBP + B_C + sub * 8);
        const u32x2 kv = *(const u32x2*)(PROJ + row * WINBP + B_IK + sub * 4);
        float c[8] = {bflo(cv.x), bfhi(cv.x), bflo(cv.y), bfhi(cv.y), bflo(cv.z), bfhi(cv.z), bflo(cv.w), bfhi(cv.w)};
        float k[4] = {bflo(kv.x), bfhi(kv.x), bflo(kv.y), bfhi(kv.y)};
        float ss = 0.f, s1 = 0.f;
#pragma unroll
        for (int q = 0; q < 8; ++q) ss += c[q] * c[q];
#pragma unroll
        for (int q = 0; q < 4; ++q) s1 += k[q];
#pragma unroll
        for (int o = 1; o < 16; o <<= 1) { ss += shx(ss, o); s1 += shx(s1, o); }
        const float rr = 1.0f / sqrtf(ss * (1.0f / 128.0f) + 1e-6f); const float mean = s1 * (1.0f / 64.0f);
        float s2 = 0.f;
#pragma unroll
        for (int q = 0; q < 4; ++q) { k[q] -= mean; s2 += k[q] * k[q]; }
#pragma unroll
        for (int o = 1; o < 16; o <<= 1) s2 += shx(s2, o);
        const float rs = 1.0f / sqrtf(s2 * (1.0f / 64.0f) + LN_EPS);
        const float* g = inp(F, I_BKVG) + sub * 8; const float* ig = inp(F, I_BIDXG) + sub * 4; const float* ib = inp(F, I_BIDXB) + sub * 4;
        u32x4 co; co.x = cvt_pk_bf16(c[0] * rr * g[0], c[1] * rr * g[1]); co.y = cvt_pk_bf16(c[2] * rr * g[2], c[3] * rr * g[3]);
        co.z = cvt_pk_bf16(c[4] * rr * g[4], c[5] * rr * g[5]); co.w = cvt_pk_bf16(c[6] * rr * g[6], c[7] * rr * g[7]);
        *(u32x4*)(CN + row * 128 + sub * 8) = co;
        u32x2 ko; ko.x = cvt_pk_bf16(k[0] * rs * ig[0] + ib[0], k[1] * rs * ig[1] + ib[1]); ko.y = cvt_pk_bf16(k[2] * rs * ig[2] + ib[2], k[3] * rs * ig[3] + ib[3]);
        *(u32x2*)(IKN + row * 64 + sub * 4) = ko;
    }
}

DI int row_suffix_incl(int v) {
    v += __builtin_amdgcn_update_dpp(0, v, 0x101, 0xf, 0xf, true);
    v += __builtin_amdgcn_update_dpp(0, v, 0x102, 0xf, 0xf, true);
    v += __builtin_amdgcn_update_dpp(0, v, 0x104, 0xf, 0xf, true);
    v += __builtin_amdgcn_update_dpp(0, v, 0x108, 0xf, 0xf, true);
    return v;
}
DI unsigned wave_max_u(unsigned v) {
    int x = (int)v;
#define WMX_STEP(ctrl) { const unsigned o = (unsigned)__builtin_amdgcn_update_dpp(0, x, ctrl, 0xf, 0xf, true); x = (int)(((unsigned)x > o) ? (unsigned)x : o); }
    WMX_STEP(0x101) WMX_STEP(0x102) WMX_STEP(0x104) WMX_STEP(0x108)
#undef WMX_STEP
    const unsigned a = (unsigned)__builtin_amdgcn_readlane(x, 0), b = (unsigned)__builtin_amdgcn_readlane(x, 16), c = (unsigned)__builtin_amdgcn_readlane(x, 32), d = (unsigned)__builtin_amdgcn_readlane(x, 48);
    const unsigned ab = a > b ? a : b, cd = c > d ? c : d; return ab > cd ? ab : cd;
}
DI unsigned lowmask(int k) { return k >= 32 ? 0xffffffffu : ((1u << k) - 1u); }
DI void select_top256_x2(LAS unsigned* cand0, LAS unsigned* cand1, LAS unsigned* cnt0, LAS unsigned* cnt1, LAS unsigned* thr0, LAS unsigned* thr1, bool two, LAS unsigned* hist, int lane) {
    LAS unsigned* cand[2] = {cand0, cand1};
    int n[2]; n[0] = (int)*cnt0; n[1] = two ? (int)*cnt1 : 0;
    unsigned x[2][8];
#pragma unroll
    for (int q = 0; q < 2; ++q)
#pragma unroll
        for (int i = 0; i < 8; ++i) x[q][i] = (lane + 64 * i < n[q]) ? cand[q][lane + 64 * i] : 0u;
    unsigned prefix[2]; int fl[2], need[2] = {256, 256};
#pragma unroll
    for (int q = 0; q < 2; ++q) { unsigned m1 = 0u, m2 = 0u;
#pragma unroll
        for (int i = 0; i < 8; ++i) { m1 = x[q][i] > m1 ? x[q][i] : m1; const unsigned c = x[q][i] ? ~x[q][i] : 0u; m2 = c > m2 ? c : m2; }
        const unsigned mx = wave_max_u(m1), mn = ~wave_max_u(m2);
        const unsigned diff = (mx ^ mn) | 1u; fl[q] = 32 - __builtin_clz(diff); prefix[q] = mx & ~lowmask(fl[q]); }
    const int row = lane >> 4;
    for (int guard = 0; guard < 5 && (fl[0] > 0 || fl[1] > 0); ++guard) {
        int sh[2]; unsigned dm[2], pm[2];
#pragma unroll
        for (int q = 0; q < 2; ++q) { sh[q] = fl[q] > 8 ? fl[q] - 8 : 0; dm[q] = (1u << (fl[q] - sh[q])) - 1u; pm[q] = ~lowmask(fl[q]); }
        { const u32x4 z4 = zero4_local();
#pragma unroll
        for (int q = 0; q < 2; ++q) *(LAS u32x4*)(hist + q * 256 + 4 * lane) = z4; }
        LDS_WAIT();
#pragma unroll
        for (int q = 0; q < 2; ++q)
#pragma unroll
            for (int i = 0; i < 8; ++i) if (x[q][i] != 0u && (x[q][i] & pm[q]) == prefix[q]) __hip_atomic_fetch_add(hist + q * 256 + ((x[q][i] >> sh[q]) & dm[q]), 1u, __ATOMIC_RELAXED, __HIP_MEMORY_SCOPE_WORKGROUP);
        LDS_WAIT();
        u32x4 h4[2]; int sl[2], incl[2];
#pragma unroll
        for (int q = 0; q < 2; ++q) h4[q] = *(const LAS u32x4*)(hist + q * 256 + 4 * lane);
#pragma unroll
        for (int q = 0; q < 2; ++q) { sl[q] = (int)(h4[q].x + h4[q].y + h4[q].z + h4[q].w); const int v = row_suffix_incl(sl[q]);
            const int t1 = __builtin_amdgcn_readlane(v, 16), t2 = __builtin_amdgcn_readlane(v, 32), t3 = __builtin_amdgcn_readlane(v, 48);
            incl[q] = v + (row == 0 ? t1 + t2 + t3 : row == 1 ? t2 + t3 : row == 2 ? t3 : 0); }
#pragma unroll
        for (int q = 0; q < 2; ++q) {
            const unsigned long long bal = __ballot(incl[q] >= need[q]);
            const int L = bal ? 63 - __builtin_clzll(bal) : 0;
            int above = __builtin_amdgcn_readlane(incl[q], L) - __builtin_amdgcn_readlane(sl[q], L);
            const int c3 = __builtin_amdgcn_readlane((int)h4[q].w, L), c2 = __builtin_amdgcn_readlane((int)h4[q].z, L), c1 = __builtin_amdgcn_readlane((int)h4[q].y, L);
            int b = 3;
            if (above + c3 < need[q]) { above += c3; b = 2; if (above + c2 < need[q]) { above += c2; b = 1; if (above + c1 < need[q]) { above += c1; b = 0; } } }
            if (fl[q] > 0) { need[q] -= above; prefix[q] |= (unsigned)(4 * L + b) << sh[q]; fl[q] = sh[q]; }
        }
    }
    const unsigned long long lt = (1ull << lane) - 1ull;
#pragma unroll
    for (int q = 0; q < 2; ++q) {
        if (q == 1 && !two) break;
        int base = 0;
#pragma unroll
        for (int i = 0; i < 8; ++i) { const bool keep = x[q][i] >= prefix[q]; const unsigned long long m = __ballot(keep);
            if (keep) cand[q][base + __builtin_popcountll(m & lt)] = x[q][i];
            base += __builtin_popcountll(m); }
    }
    if (lane == 0) { *cnt0 = 256u; *thr0 = prefix[0]; if (two) { *cnt1 = 256u; *thr1 = prefix[1]; } }
}

DI int idx_bin(float sv) { const unsigned bits = __float_as_uint(sv); const int lin = (int)((bits >> 18) & 0x1fffu);
    if (bits >> 31) { int t = lin - (127 - 13) * 32; t = t < 0 ? 0 : (t > 511 ? 511 : t); return 511 - t; }
    int t = lin - (127 - 9) * 32; t = t < 0 ? 0 : (t > 511 ? 511 : t); return 512 + t; }
DI unsigned idx_bin_lowkey(int tb) {
    if (tb >= 512) { const unsigned lin = (unsigned)(tb - 512 + (127 - 9) * 32); return tb == 512 ? 0x80000000u : (0x80000000u | (lin << 18)); }
    const unsigned lin = (unsigned)((511 - tb) + (127 - 13) * 32);
    const unsigned bits_hi = 0x80000000u | (lin << 18) | 0x3ffffu;
    return (~bits_hi) & 0xffffe000u; }
template <int MODE>
DI void idx_pass(LAS unsigned* BUF, LAS unsigned* CNT, LAS unsigned* ZH, const bf16_t* IKN, size_t rowb, const bf16x8 (&qf)[4][2], const float (&iw)[4], int nsteps, int half, int qloc, int qpos, unsigned thr, int fr, int fq, int sstride = 1) {
    asm volatile("" : "+v"(fr), "+v"(fq), "+v"(qloc), "+v"(qpos));
    const bf16_t* kp = IKN + (rowb + half * 64 + fr) * 64 + fq * 8;
    bf16x8 kf[2][2];
#pragma unroll
    for (int tl = 0; tl < 2; ++tl)
#pragma unroll
        for (int ks = 0; ks < 2; ++ks) kf[tl][ks] = *(const bf16x8*)(kp + (16 * tl) * 64 + ks * 32);
    const int nh = 2 * nsteps;
#pragma clang loop unroll(disable)
    for (int hs = 0; hs < nh; hs += sstride) {
        const int kb = (hs >> 1) * 128 + half * 64 + (hs & 1) * 32;
        bf16x8 kn[2][2];
        { const int hn = (hs + sstride < nh) ? hs + sstride : hs; const int kbn = (hn >> 1) * 128 + (hn & 1) * 32;
#pragma unroll
          for (int tl = 0; tl < 2; ++tl)
#pragma unroll
            for (int ks = 0; ks < 2; ++ks) kn[tl][ks] = *(const bf16x8*)(kp + (size_t)(kbn + 16 * tl) * 64 + ks * 32); }
        __builtin_amdgcn_sched_barrier(0);
        unsigned ckv[8]; int nacc = 0;
#pragma unroll
        for (int tl = 0; tl < 2; ++tl) {
            f32x4 sc = (f32x4){0.f, 0.f, 0.f, 0.f};
#pragma unroll
            for (int h = 0; h < 4; ++h) { f32x4 a = (f32x4){0.f, 0.f, 0.f, 0.f}; a = MFMA16(kf[tl][0], qf[h][0], a); a = MFMA16(kf[tl][1], qf[h][1], a);
#pragma unroll
                for (int i = 0; i < 4; ++i) sc[i] += __builtin_amdgcn_fmed3f(a[i], 0.f, 3.0e38f) * iw[h]; }
#pragma unroll
            for (int i = 0; i < 4; ++i) {
                const int key = kb + 16 * tl + 4 * fq + i;
                const float sv = sc[i] + 0.0f;
                unsigned ub = __float_as_uint(sv); ub ^= (ub >> 31) ? 0xffffffffu : 0x80000000u;
                if (MODE == 1 || (MODE == 4 && (i & 1) == 0)) {
                    const int bin = idx_bin(sv);
                    if (key <= qpos) { __hip_atomic_fetch_add(BUF + qloc * 512 + (bin >> 1), 1u << ((bin & 1) << 4), __ATOMIC_RELAXED, __HIP_MEMORY_SCOPE_WORKGROUP);
                        if (sv == 0.0f) __hip_atomic_fetch_add(ZH + qloc * 32 + (key >> 8), 1u << (((key >> 7) & 1) << 4), __ATOMIC_RELAXED, __HIP_MEMORY_SCOPE_WORKGROUP); }
                } else if (MODE == 3) {
                    nacc += idx_bin(sv) + (int)(ub >> 20);
                } else {
                    const unsigned ck = (ub & 0xffffe000u) | (unsigned)(8191 - key);
                    const bool acc = (key <= qpos) && (ck > thr);
                    ckv[tl * 4 + i] = acc ? ck : 0u; nacc += acc ? 1 : 0;
                }
            }
        }
        if (MODE == 3) asm volatile("" :: "v"(nacc));
        if (MODE == 2) {
            if (__ballot(nacc > 0)) {
                unsigned pos = __hip_atomic_fetch_add(CNT + qloc, (unsigned)nacc, __ATOMIC_RELAXED, __HIP_MEMORY_SCOPE_WORKGROUP);
#pragma unroll
                for (int j = 0; j < 8; ++j) if (ckv[j] != 0u) { if (pos < 512u) BUF[qloc * 512 + pos] = ckv[j]; ++pos; }
            }
        }
#pragma unroll
        for (int tl = 0; tl < 2; ++tl)
#pragma unroll
            for (int ks = 0; ks < 2; ++ks) kf[tl][ks] = kn[tl][ks];
    }
}
DI unsigned idx_threshold(const LAS unsigned* hist, const LAS unsigned* zh, int lane, int& n_ge, const int rank = 256) {
    const u32x4 wa = *(const LAS u32x4*)(hist + 8 * lane), wb = *(const LAS u32x4*)(hist + 8 * lane + 4);
    const unsigned wd[8] = {wa.x, wa.y, wa.z, wa.w, wb.x, wb.y, wb.z, wb.w};
    int sl = 0;
#pragma unroll
    for (int q = 0; q < 8; ++q) sl += (int)(wd[q] & 0xffffu) + (int)(wd[q] >> 16);
    const int v = row_suffix_incl(sl);
    const int t1 = __builtin_amdgcn_readlane(v, 16), t2 = __builtin_amdgcn_readlane(v, 32), t3 = __builtin_amdgcn_readlane(v, 48);
    const int row = lane >> 4;
    const int incl = v + (row == 0 ? t1 + t2 + t3 : row == 1 ? t2 + t3 : row == 2 ? t3 : 0);
    const unsigned long long bal = __ballot(incl >= rank);
    if (bal == 0ull) { n_ge = __builtin_amdgcn_readlane(incl, 0); return 0u; }
    const int L = 63 - __builtin_clzll(bal);
    int above = __builtin_amdgcn_readlane(incl, L) - __builtin_amdgcn_readlane(sl, L);
    int tb = 16 * L; int cnt_tb = 0; bool found = false;
#pragma unroll
    for (int q = 7; q >= 0; --q) {
        const unsigned wq = (unsigned)__builtin_amdgcn_readlane((int)wd[q], L);
        const int chi = (int)(wq >> 16), clo = (int)(wq & 0xffffu);
        if (!found) { if (above + chi >= rank) { tb = 16 * L + 2 * q + 1; cnt_tb = chi; found = true; } else above += chi; }
        if (!found) { if (above + clo >= rank) { tb = 16 * L + 2 * q; cnt_tb = clo; found = true; } else above += clo; }
    }
    n_ge = above + cnt_tb;
    if (tb == 512 && n_ge > rank + rank / 12) {
        const unsigned zw = (lane < 32) ? zh[lane] : 0u; const int z0 = (int)(zw & 0xffffu), z1 = (int)(zw >> 16);
        int incl2 = z0 + z1;
#pragma unroll
        for (int o = 1; o < 32; o <<= 1) { const int u = shup_i(incl2, o); if (lane >= o) incl2 += u; }
        const int needz = rank - above;
        const unsigned long long b2 = __ballot(lane < 32 && incl2 >= needz);
        int cut = 8192;
        if (b2) { const int L2 = __builtin_ctzll(b2); const int before = __builtin_amdgcn_readlane(incl2, L2) - __builtin_amdgcn_readlane(z0 + z1, L2);
            const int zz0 = __builtin_amdgcn_readlane(z0, L2); cut = (before + zz0 >= needz) ? 128 * (2 * L2 + 1) : 128 * (2 * L2 + 2); }
        const int totz = __builtin_amdgcn_readlane(incl2, 31);
        n_ge = above + (cnt_tb - totz) + ((needz + 127 < totz) ? needz + 127 : totz);
        return cut >= 8192 ? 0x7fffffffu : (0x80000000u | (unsigned)(8191 - cut));
    }
    return tb > 0 ? idx_bin_lowkey(tb) - 1u : 0u;
}
DI unsigned ref_threshold(const LAS unsigned* cand, int n, int lane) {
    unsigned x[8];
#pragma unroll
    for (int i = 0; i < 8; ++i) x[i] = (lane + 64 * i < n) ? cand[lane + 64 * i] : 0u;
    unsigned prefix = 0u;
    for (int bit = 31; bit >= 0; --bit) { const unsigned c = prefix | (1u << bit); int tot = 0;
#pragma unroll
        for (int i = 0; i < 8; ++i) tot += __builtin_popcountll(__ballot(x[i] >= c));
        if (tot >= 256) prefix = c; }
    return prefix;
}
template <int IMODE> DI void indexer_phase(Ctx& F) {
    LAS unsigned* CAND = (LAS unsigned*)F.lds;
    LAS unsigned* CNT = (LAS unsigned*)(F.lds + 131072);
    LAS unsigned* THR = (LAS unsigned*)(F.lds + 131072 + 256);
    LAS unsigned* WL = (LAS unsigned*)(F.lds + 131072 + 512 + 16384);
    LAS unsigned* WLN = WL + 64; LAS unsigned* WLH = WL + 65;
    const int tid = F.tid, lane = F.lane, w = F.wave, fr = lane & 15, fq = lane >> 4;
    const bf16_t* PROJ = (const bf16_t*)(F.ws + WS_PROJ);
    const bf16_t* IKN = (const bf16_t*)(F.ws + WS_IKN);
    unsigned short* IDX = (unsigned short*)(F.ws + WS_IDX);
    const int qg = w & 3, half = w >> 2;
    LAS unsigned* UQ = WL + 68;
    for (;;) {
        __syncthreads();
        if (tid == 0) { unsigned res = 0xffffffffu;
#pragma clang loop unroll(disable)
            for (int k = 0; k < 8; ++k) { const unsigned q = (unsigned)(F.bx + k) & 7u; const unsigned v = __hip_atomic_fetch_add(F.ctl + CW_IQ + (IMODE * 8 + (int)q) * 16, 1u, __ATOMIC_RELAXED, __HIP_MEMORY_SCOPE_AGENT); if (v < 128u) { res = q * 128u + v; break; } }
            *UQ = res; }
        __syncthreads();
        const unsigned uq = *UQ;
        if (uq == 0xffffffffu) break;
        const int b = __builtin_amdgcn_readfirstlane((int)(uq >> 7)), qb = 127 - __builtin_amdgcn_readfirstlane((int)(uq & 127u));
        const int q0 = qb * 64;
        const size_t rowb = (size_t)b * SEQ;
        constexpr int pm = IMODE;
        unsigned short* IDXO = pm ? IDX : (unsigned short*)(F.ws + WS_QLAT);
        __syncthreads();
        if (tid < 64) { CNT[tid] = 0u; THR[tid] = 0u; }
        const int qloc = 16 * qg + fr, qpos = q0 + qloc;
        bf16x8 qf[4][2]; float iw[4];
#pragma unroll
        for (int h = 0; h < 4; ++h) {
#pragma unroll
            for (int ks = 0; ks < 2; ++ks) qf[h][ks] = *(const bf16x8*)(PROJ + (rowb + qpos) * WINBP + B_IQ + h * 64 + ks * 32 + fq * 8);
            iw[h] = bf2f(PROJ[(rowb + qpos) * WINBP + B_IW + h]) * 0.0625f;
        }
        __syncthreads();
        const int nsteps = (q0 + 64 + 127) / 128;
        LAS unsigned* FLG = WL + 66;
        LAS unsigned* ZH = WL + 256;
        bool fast = false;
        if (nsteps >= 6 && pm == 1) {
            { const u32x4 z4 = zero4_local(); for (int u = tid; u < 64 * 512 / 4; u += 512) *(LAS u32x4*)(CAND + 4 * u) = z4; *(LAS u32x4*)(ZH + 4 * tid) = z4; }
            if (tid == 0) *FLG = 0u;
            __syncthreads();
            const bool sampled = nsteps >= 16;
            if (sampled) idx_pass<4>(CAND, CNT, ZH, IKN, rowb, qf, iw, nsteps, half, qloc, qpos, 0u, fr, fq); else idx_pass<1>(CAND, CNT, ZH, IKN, rowb, qf, iw, nsteps, half, qloc, qpos, 0u, fr, fq);
#if PROBE_PASS3
            idx_pass<3>(CAND, CNT, ZH, IKN, rowb, qf, iw, nsteps, half, qloc, qpos, 0u, fr, fq); idx_pass<3>(CAND, CNT, ZH, IKN, rowb, qf, iw, nsteps, half, qloc, qpos, 0u, fr, fq);
#endif
            __syncthreads();
#pragma clang loop unroll(disable)
            for (int qq = 0; qq < 8; ++qq) { int nge; const unsigned t = sampled ? idx_threshold(CAND + (w * 8 + qq) * 512, ZH + (w * 8 + qq) * 32, lane, nge, 184) : idx_threshold(CAND + (w * 8 + qq) * 512, ZH + (w * 8 + qq) * 32, lane, nge, 256);
                if (!sampled && nge > 512 && lane == 0) *FLG = 1u;
                if (lane == 0) { THR[w * 8 + qq] = t; CNT[w * 8 + qq] = 0u; } }
            __syncthreads();
            fast = (*FLG == 0u);
            if (fast) {
                if (tid == 0) { *WLN = 0u; *WLH = 0u; }
                __syncthreads();
                idx_pass<2>(CAND, CNT, ZH, IKN, rowb, qf, iw, nsteps, half, qloc, qpos, THR[qloc], fr, fq);
                __syncthreads();
                LAS unsigned* RTY = WL + 67;
                LAS unsigned* THR2 = WL + 128;
                if (tid == 0) *RTY = 0u;
                if (tid < 64) THR2[tid] = 0xffffffffu;
                __syncthreads();
                if (sampled && lane < 8) { const int ql = w * 8 + lane; const unsigned n = CNT[ql];
                    if (n < 256u) *FLG = 1u;
                    else if (n > 512u && PROBE_NORETRY) *FLG = 1u;
                    else if (n > 512u) { *RTY = 1u; CNT[ql] = 512u; THR2[ql] = 0xfffffffeu; const unsigned p = __hip_atomic_fetch_add(WLN, 1u, __ATOMIC_RELAXED, __HIP_MEMORY_SCOPE_WORKGROUP); if (p < 64u) WL[p] = (unsigned)ql; } }
                __syncthreads();
                if (*FLG == 0u && *RTY != 0u) {
                    const int totr = (int)*WLN;
                    LAS unsigned* hist = (LAS unsigned*)(F.lds + 131072 + 512) + w * 512;
                    for (int guard = 0; guard < 40; ++guard) {
                        int idx = 0; if (lane == 0) idx = (int)__hip_atomic_fetch_add(WLH, 2u, __ATOMIC_RELAXED, __HIP_MEMORY_SCOPE_WORKGROUP);
                        idx = __builtin_amdgcn_readfirstlane(idx);
                        if ((unsigned)idx >= (unsigned)totr) break;
                        const bool two = idx + 1 < totr; const int qla = (int)WL[idx], qlb = two ? (int)WL[idx + 1] : qla;
                        select_top256_x2(CAND + qla * 512, CAND + qlb * 512, CNT + qla, CNT + qlb, THR + qla, THR + qlb, two, hist, lane);
                        LDS_WAIT();
                        if (lane == 0) { THR2[qla] = THR[qla]; CNT[qla] = 0u; if (two) { THR2[qlb] = THR[qlb]; CNT[qlb] = 0u; } }
                    }
                    __syncthreads();
                    if (__ballot(THR2[qloc] != 0xffffffffu) != 0ull)
                        idx_pass<2>(CAND, CNT, ZH, IKN, rowb, qf, iw, nsteps, half, qloc, qpos, THR2[qloc], fr, fq);
                    __syncthreads();
                    if (lane < 8) { const int ql = w * 8 + lane; const unsigned n = CNT[ql]; if (n < 256u || n > 512u || THR2[ql] == 0xfffffffeu) *FLG = 1u; }
                }
                __syncthreads();
                if (tid == 0) { *WLN = 0u; *WLH = 0u; }
                __syncthreads();
                fast = (*FLG == 0u);
                if (lane < 8 && fast) { const int ql = w * 8 + lane; if (CNT[ql] > 256u) { const unsigned p = __hip_atomic_fetch_add(WLN, 1u, __ATOMIC_RELAXED, __HIP_MEMORY_SCOPE_WORKGROUP); WL[p] = (unsigned)ql; } }
                __syncthreads();
                const int total = (int)*WLN;
                LAS unsigned* hist = (LAS unsigned*)(F.lds + 131072 + 512) + w * 512;
                for (int guard = 0; guard < 40; ++guard) {
                    int idx = 0; if (lane == 0) idx = (int)__hip_atomic_fetch_add(WLH, 2u, __ATOMIC_RELAXED, __HIP_MEMORY_SCOPE_WORKGROUP);
                    idx = __builtin_amdgcn_readfirstlane(idx);
                    if ((unsigned)idx >= (unsigned)total) break;
                    const bool two = idx + 1 < total; const int qla = (int)WL[idx], qlb = two ? (int)WL[idx + 1] : qla;
                    select_top256_x2(CAND + qla * 512, CAND + qlb * 512, CNT + qla, CNT + qlb, THR + qla, THR + qlb, two, hist, lane);
                    LDS_WAIT();
                }
                __syncthreads();
            }
        }
        if (!fast) { __syncthreads(); if (tid < 64) { CNT[tid] = 0u; THR[tid] = 0u; } __syncthreads(); }
        int lane_s = lane; asm volatile("" : "+v"(lane_s));
        { const int fr = lane_s & 15, fq = lane_s >> 4, qloc = 16 * qg + fr, qpos = q0 + qloc;
        bf16x8 kf[4][2];
#pragma unroll
        for (int tl = 0; tl < 4; ++tl)
#pragma unroll
            for (int ks = 0; ks < 2; ++ks) kf[tl][ks] = *(const bf16x8*)(IKN + (rowb + half * 64 + 16 * tl + fr) * 64 + ks * 32 + fq * 8);
#pragma clang loop unroll(disable)
        for (int st = 0; st < (fast ? 0 : nsteps); ++st) {
            const int kb = st * 128 + half * 64;
            const unsigned thr = THR[qloc];
            if (tid == 0) { *WLN = 0u; *WLH = 0u; }
            bf16x8 kn[4][2];
            { const int kbn = (st + 1 < nsteps) ? kb + 128 : kb;
#pragma unroll
              for (int tl = 0; tl < 4; ++tl)
#pragma unroll
                for (int ks = 0; ks < 2; ++ks) kn[tl][ks] = *(const bf16x8*)(IKN + (rowb + kbn + 16 * tl + fr) * 64 + ks * 32 + fq * 8); }
            unsigned ckv[16]; int nacc = 0;
#pragma unroll
            for (int tl = 0; tl < 4; ++tl) {
                f32x4 sc = (f32x4){0.f, 0.f, 0.f, 0.f};
#pragma unroll
                for (int h = 0; h < 4; ++h) { f32x4 a = (f32x4){0.f, 0.f, 0.f, 0.f}; a = MFMA16(kf[tl][0], qf[h][0], a); a = MFMA16(kf[tl][1], qf[h][1], a);
#pragma unroll
                    for (int i = 0; i < 4; ++i) sc[i] += __builtin_amdgcn_fmed3f(a[i], 0.f, 3.0e38f) * iw[h]; }
#pragma unroll
                for (int i = 0; i < 4; ++i) {
                    const int key = kb + 16 * tl + 4 * fq + i;
                    const float sv = sc[i] + 0.0f;
                    unsigned ub = __float_as_uint(sv); ub ^= (ub >> 31) ? 0xffffffffu : 0x80000000u;
                    const unsigned ck = (ub & 0xffffe000u) | (unsigned)(8191 - key);
                    const bool acc = (key <= qpos) && (ck > thr);
                    ckv[tl * 4 + i] = acc ? ck : 0u; nacc += acc ? 1 : 0;
                }
            }
            if (__ballot(nacc > 0)) {
                unsigned pos = __hip_atomic_fetch_add(CNT + qloc, (unsigned)nacc, __ATOMIC_RELAXED, __HIP_MEMORY_SCOPE_WORKGROUP);
#pragma unroll
                for (int j = 0; j < 16; ++j) if (ckv[j] != 0u) { if (pos < 512u) CAND[qloc * 512 + pos] = ckv[j]; ++pos; }
            }
#pragma unroll
            for (int tl = 0; tl < 4; ++tl)
#pragma unroll
                for (int ks = 0; ks < 2; ++ks) kf[tl][ks] = kn[tl][ks];
            __syncthreads();
            const bool lastst = (st == nsteps - 1);
            {
                if (lane < 8) { const int ql = w * 8 + lane; const unsigned n = CNT[ql];
                    if (n >= 384u || (lastst && n > 256u)) { const unsigned p = __hip_atomic_fetch_add(WLN, 1u, __ATOMIC_RELAXED, __HIP_MEMORY_SCOPE_WORKGROUP); WL[p] = (unsigned)ql; } }
                __syncthreads();
                const int total = (int)*WLN;
                LAS unsigned* hist = (LAS unsigned*)(F.lds + 131072 + 512) + w * 512;
                for (int guard = 0; guard < 40; ++guard) {
                    int idx = 0; if (lane == 0) idx = (int)__hip_atomic_fetch_add(WLH, 2u, __ATOMIC_RELAXED, __HIP_MEMORY_SCOPE_WORKGROUP);
                    idx = __builtin_amdgcn_readfirstlane(idx);
                    if ((unsigned)idx >= (unsigned)total) break;
                    const bool two = idx + 1 < total; const int qla = (int)WL[idx], qlb = two ? (int)WL[idx + 1] : qla;
#if PROBE_SEL
                    const unsigned ra = ref_threshold(CAND + qla * 512, (int)CNT[qla], lane), rb = ref_threshold(CAND + qlb * 512, (int)CNT[qlb], lane);
#endif
                    select_top256_x2(CAND + qla * 512, CAND + qlb * 512, CNT + qla, CNT + qlb, THR + qla, THR + qlb, two, hist, lane);
                    LDS_WAIT();
#if PROBE_SEL
                    if (THR[qla] != ra || (two && THR[qlb] != rb) || CNT[qla] != 256u) { if (lane == 0) __hip_atomic_store(F.ctl + CW_ERR, 1u, __ATOMIC_RELAXED, __HIP_MEMORY_SCOPE_AGENT); }
#endif
                }
            }
            __syncthreads();
        }
        }
        LAS unsigned* bm = (LAS unsigned*)(F.lds + 131072 + 512) + w * 512;
#pragma clang loop unroll(disable)
        for (int qq = 0; qq < 8; ++qq) { const int ql = w * 8 + qq; const int n = (int)CNT[ql];
            unsigned short* dst = IDXO + (rowb + q0 + ql) * 256;
#pragma unroll
            for (int i = 0; i < 4; ++i) bm[lane + 64 * i] = 0u;
#pragma unroll
            for (int i = 0; i < 4; ++i) { const int p = lane + 64 * i; if (p < n) { const unsigned key = 8191u - (CAND[ql * 512 + p] & 0x1fffu); __hip_atomic_fetch_or(bm + (key >> 5), 1u << (key & 31u), __ATOMIC_RELAXED, __HIP_MEMORY_SCOPE_WORKGROUP); } }
            LDS_WAIT();
            const u32x4 wv = *(const LAS u32x4*)(bm + 4 * lane);
            unsigned wd[4] = {wv.x, wv.y, wv.z, wv.w};
            const int cmine = __builtin_popcount(wd[0]) + __builtin_popcount(wd[1]) + __builtin_popcount(wd[2]) + __builtin_popcount(wd[3]);
            int incl = cmine;
#pragma unroll
            for (int o = 1; o < 64; o <<= 1) { const int v = shup_i(incl, o); if (lane >= o) incl += v; }
            int pos = incl - cmine;
#pragma unroll
            for (int jw = 0; jw < 4; ++jw) { unsigned word = wd[jw]; while (word) { const int bpos = __builtin_ctz(word); dst[pos++] = (unsigned short)((4 * lane + jw) * 32 + bpos); word &= word - 1u; } }
#pragma unroll
            for (int i = 0; i < 4; ++i) { const int p = lane + 64 * i; if (p >= n) dst[p] = (unsigned short)0xffffu; }
            LDS_WAIT();
        }
    }
    __syncthreads();
}
DI void idx_compare(Ctx& F) {
    const unsigned* a = (const unsigned*)(F.ws + WS_IDX); const unsigned* b = (const unsigned*)(F.ws + WS_QLAT); bool bad = false;
    for (size_t i = (size_t)F.bx * 512 + F.tid; i < (size_t)T * 128; i += (size_t)F.G * 512) bad |= a[i] != b[i];
    if (__ballot(bad)) { if (F.lane == 0) __hip_atomic_store(F.ctl + CW_ERR, 1u, __ATOMIC_RELAXED, __HIP_MEMORY_SCOPE_AGENT); }
}

DI int rotl4(int k) { return ((k << 1) & 15) | ((k >> 3) & 1); }
DI void dsa_attn_phase(Ctx& F) {
    const int tid = F.tid, lane = F.lane, w = F.wave, fr = lane & 15, fq = lane >> 4;
    LAS unsigned char* wl = F.lds + w * 17408;
    LAS unsigned short* IDL = (LAS unsigned short*)(wl + 16384);
    LAS unsigned char* BKL = wl + 16384 + 512;
    LAS float* RB = (LAS float*)(F.lds + 8 * 17408);
    LAS unsigned char* TBL = (LAS unsigned char*)(F.lds + 8 * 17408 + 1600);
    const bf16_t* PROJ = (const bf16_t*)(F.ws + WS_PROJ);
    const bf16_t* CN = (const bf16_t*)(F.ws + WS_CN);
    const unsigned short* IDX = (const unsigned short*)(F.ws + WS_IDX);
    const bf16_t* WUK = (const bf16_t*)(F.ws + WS_WUK); const bf16_t* WUVT = (const bf16_t*)(F.ws + WS_WUVT);
    bf16_t* QLAT = (bf16_t*)(F.ws + WS_QLAT); bf16_t* OLAT = (bf16_t*)(F.ws + WS_OLAT); bf16_t* MIX = (bf16_t*)(F.ws + WS_MIX);
    __syncthreads();
    if (tid < 384) RB[tid] = inp(F, I_RELB)[tid]; else if (tid < 396) RB[tid] = -1.0e30f;
    if (tid < 128) { int bk = tid; if (tid >= 16) { bk = 16 + (int)(logf((float)tid * (1.0f / 16.0f)) / logf(8.0f) * 16.0f); bk = bk > 31 ? 31 : bk; } TBL[tid] = (unsigned char)bk; }
    __syncthreads();
    for (int it = 0; (it + 1) * ((F.G >> 3) * 8) <= SEQ / 16; ++it) {
        const int tb = (F.bx & 7) * (SEQ / 16) + it * ((F.G >> 3) * 8) + (F.bx >> 3) * 8 + w;
        const size_t t0 = (size_t)tb * 16;
        const int b = (int)(t0 / SEQ);
        for (int h = 0; h < 12; ++h) {
            bf16x8 qf[2];
#pragma unroll
            for (int ks = 0; ks < 2; ++ks) qf[ks] = *(const bf16x8*)(PROJ + (t0 + fr) * WINBP + h * 64 + ks * 32 + fq * 8);
#pragma unroll
            for (int rt = 0; rt < 8; ++rt) { f32x4 a = (f32x4){0.f, 0.f, 0.f, 0.f};
#pragma unroll
                for (int ks = 0; ks < 2; ++ks) { const bf16x8 wf = *(const bf16x8*)(WUK + ((size_t)h * 128 + 16 * rt + fr) * 64 + ks * 32 + fq * 8); a = MFMA16(wf, qf[ks], a); }
                u32x2 o; o.x = cvt_pk_bf16(a[0] * 0.125f, a[1] * 0.125f); o.y = cvt_pk_bf16(a[2] * 0.125f, a[3] * 0.125f);
                *(u32x2*)(QLAT + ((t0 + fr) * 12 + h) * 128 + 16 * rt + 4 * fq) = o; }
        }
        VM_WAIT();
        for (int qi = 0; qi < 16; ++qi) {
            const size_t t = t0 + qi; const int pos = (int)(t % SEQ);
            LDS_WAIT();
            { const u32x2 iw2 = *(const u32x2*)(IDX + t * 256 + 4 * lane);
              const unsigned idv[4] = {iw2.x & 0xffffu, iw2.x >> 16, iw2.y & 0xffffu, iw2.y >> 16}; unsigned pk = 0u;
#pragma unroll
              for (int i = 0; i < 4; ++i) IDL[32 * (lane >> 3) + 8 * i + (lane & 7)] = (unsigned short)idv[i];
#pragma unroll
              for (int i = 0; i < 4; ++i) { const int rel = pos - (int)idv[i]; const bool ok = (idv[i] != 0xffffu) && rel >= 0; const int ti = rel < 0 ? 0 : (rel > 127 ? 127 : rel);
                  const unsigned tb = TBL[ti]; const unsigned bk = !ok ? 32u : (rel > 127 ? 31u : tb); pk |= bk << (8 * i); }
              *(LAS unsigned*)(BKL + 4 * lane) = pk; }
            bf16x8 ql[4];
#pragma unroll
            for (int ks = 0; ks < 4; ++ks) { u32x4 v = (u32x4){0u, 0u, 0u, 0u}; if (fr < 12) v = *(const u32x4*)(QLAT + (t * 12 + fr) * 128 + ks * 32 + fq * 8); ql[ks] = __builtin_bit_cast(bf16x8, v); }
            VM_WAIT(); LDS_WAIT();
            const bf16_t* cb = CN + (size_t)b * SEQ * 128;
#define DSA_ISSUE(c_) do { LAS unsigned char* buf_ = wl + ((c_) & 1) * 8192; const u32x4 iv_ = *(const LAS u32x4*)(IDL + 32 * (c_) + 8 * (lane >> 4)); const unsigned ivw_[4] = {iv_.x, iv_.y, iv_.z, iv_.w}; \
            _Pragma("unroll") for (int i_ = 0; i_ < 8; ++i_) { const int kk_ = 4 * i_ + (lane >> 4); \
                const int id_ = (int)((ivw_[i_ >> 1] >> (16 * (i_ & 1))) & 0x1fffu); const int p_ = (lane & 15) ^ rotl4(kk_ & 15); \
                __builtin_amdgcn_global_load_lds((const unsigned*)(cb + (size_t)id_ * 128 + p_ * 8), (LAS unsigned*)(buf_ + i_ * 1024), 16, 0, 0); } } while (0)
            f32x4 oacc[8];
#pragma unroll
            for (int rt = 0; rt < 8; ++rt) oacc[rt] = (f32x4){0.f, 0.f, 0.f, 0.f};
            float mrun = -INFINITY, lrun = 0.f;
            DSA_ISSUE(0);
            for (int c = 0; c < 8; ++c) {
                if (c < 7) { DSA_ISSUE(c + 1); asm volatile("s_waitcnt vmcnt(8)" ::: "memory"); } else { asm volatile("s_waitcnt vmcnt(0)" ::: "memory"); }
                const LAS unsigned char* buf = wl + (c & 1) * 8192;
                f32x4 sacc[2]; float lg[8];
#pragma unroll
                for (int jt = 0; jt < 2; ++jt) { sacc[jt] = (f32x4){0.f, 0.f, 0.f, 0.f};
#pragma unroll
                    for (int ks = 0; ks < 4; ++ks) { const bf16x8 cf = *(const LAS bf16x8*)(buf + (16 * jt + fr) * 256 + (((ks * 4 + fq) ^ rotl4(fr)) * 16)); sacc[jt] = MFMA16(cf, ql[ks], sacc[jt]); } }
                float mloc = -INFINITY;
                {
                    const unsigned bw0 = *(const LAS unsigned*)(BKL + 32 * c + 4 * fq), bw1 = *(const LAS unsigned*)(BKL + 32 * c + 16 + 4 * fq);
                    const int hh = fr < 12 ? fr : 0;
                    float bv[8]; unsigned bb[8];
#pragma unroll
                    for (int i = 0; i < 4; ++i) { bb[i] = (bw0 >> (8 * i)) & 0xffu; bb[4 + i] = (bw1 >> (8 * i)) & 0xffu; }
#pragma unroll
                    for (int i = 0; i < 8; ++i) bv[i] = RB[bb[i] * 12 + hh];
#pragma unroll
                    for (int i = 0; i < 8; ++i) { const float v = sacc[i >> 2][i & 3] + bv[i]; lg[i] = v; mloc = fmaxf(mloc, v); }
                }
                mloc = rows4_max(mloc);
                const float mnew = fmaxf(mrun, mloc);
                const float scl = __expf(mrun - mnew);
                float p[8], ps = 0.f;
#pragma unroll
                for (int i = 0; i < 8; ++i) { p[i] = __expf(lg[i] - mnew); ps += p[i]; }
                lrun = lrun * scl + ps; mrun = mnew;
                u32x4 pw; pw.x = cvt_pk_bf16(p[0], p[1]); pw.y = cvt_pk_bf16(p[2], p[3]); pw.z = cvt_pk_bf16(p[4], p[5]); pw.w = cvt_pk_bf16(p[6], p[7]);
                const bf16x8 pf = __builtin_bit_cast(bf16x8, pw);
                const int i16 = lane & 15, qr = i16 >> 2, pp = i16 & 3, kk0 = 4 * fq + qr;
                unsigned ta[8];
#pragma unroll
                for (int rt = 0; rt < 8; ++rt) ta[rt] = (unsigned)(size_t)buf + (unsigned)(kk0 * 256 + (((2 * rt + (pp >> 1)) ^ rotl4(kk0)) * 16) + 8 * (pp & 1));
                s16x4 tlo[8], thi[8];
                asm volatile("ds_read_b64_tr_b16 %0, %16\n\tds_read_b64_tr_b16 %8, %16 offset:4096\n\t"
                             "ds_read_b64_tr_b16 %1, %17\n\tds_read_b64_tr_b16 %9, %17 offset:4096\n\t"
                             "ds_read_b64_tr_b16 %2, %18\n\tds_read_b64_tr_b16 %10, %18 offset:4096\n\t"
                             "ds_read_b64_tr_b16 %3, %19\n\tds_read_b64_tr_b16 %11, %19 offset:4096\n\t"
                             "ds_read_b64_tr_b16 %4, %20\n\tds_read_b64_tr_b16 %12, %20 offset:4096\n\t"
                             "ds_read_b64_tr_b16 %5, %21\n\tds_read_b64_tr_b16 %13, %21 offset:4096\n\t"
                             "ds_read_b64_tr_b16 %6, %22\n\tds_read_b64_tr_b16 %14, %22 offset:4096\n\t"
                             "ds_read_b64_tr_b16 %7, %23\n\tds_read_b64_tr_b16 %15, %23 offset:4096\n\t"
                             "s_waitcnt lgkmcnt(0)"
                             : "=&v"(tlo[0]), "=&v"(tlo[1]), "=&v"(tlo[2]), "=&v"(tlo[3]), "=&v"(tlo[4]), "=&v"(tlo[5]), "=&v"(tlo[6]), "=&v"(tlo[7]),
                               "=&v"(thi[0]), "=&v"(thi[1]), "=&v"(thi[2]), "=&v"(thi[3]), "=&v"(thi[4]), "=&v"(thi[5]), "=&v"(thi[6]), "=&v"(thi[7])
                             : "v"(ta[0]), "v"(ta[1]), "v"(ta[2]), "v"(ta[3]), "v"(ta[4]), "v"(ta[5]), "v"(ta[6]), "v"(ta[7]) : "memory");
#pragma unroll
                for (int rt = 0; rt < 8; ++rt) {
                    const bf16x8 cf = __builtin_shufflevector(tlo[rt], thi[rt], 0, 1, 2, 3, 4, 5, 6, 7);
                    oacc[rt] = oacc[rt] * scl; oacc[rt] = MFMA16(cf, pf, oacc[rt]);
                }
                LDS_WAIT();
            }
            lrun = rows4_sum(lrun);
            const float inv = 1.0f / lrun;
            if (fr < 12) {
#pragma unroll
                for (int rt = 0; rt < 8; ++rt) { u32x2 o; o.x = cvt_pk_bf16(oacc[rt][0] * inv, oacc[rt][1] * inv); o.y = cvt_pk_bf16(oacc[rt][2] * inv, oacc[rt][3] * inv);
                    *(u32x2*)(OLAT + (t * 12 + fr) * 128 + 16 * rt + 4 * fq) = o; }
            }
        }
        VM_WAIT();
        for (int h = 0; h < 12; ++h) {
            bf16x8 of[4];
#pragma unroll
            for (int ks = 0; ks < 4; ++ks) of[ks] = *(const bf16x8*)(((DIAG_WUVQ == 1) ? QLAT : OLAT) + ((t0 + fr) * 12 + h) * 128 + ks * 32 + fq * 8);
#pragma unroll
            for (int dt = 0; dt < 4; ++dt) { f32x4 a = (f32x4){0.f, 0.f, 0.f, 0.f};
#pragma unroll
                for (int ks = 0; ks < 4; ++ks) { const bf16x8 wf = *(const bf16x8*)(WUVT + ((size_t)h * 64 + 16 * dt + fr) * 128 + ks * 32 + fq * 8); a = MFMA16(wf, of[ks], a); }
                u32x2 o; o.x = cvt_pk_bf16(a[0], a[1]); o.y = cvt_pk_bf16(a[2], a[3]);
                if (DIAG_WUVQ == 2) { o.x = 0x3f803f80u; o.y = 0x3f803f80u; }
                (void)o; *(unsigned*)((unsigned char*)MIX + (t0 + fr) * D + h * 64 + 16 * dt + 4 * fq) = pk4_fp8(a[0] * 16.0f, a[1] * 16.0f, a[2] * 16.0f, a[3] * 16.0f); }
        }
    }
    __syncthreads();
}

#define WSP(off) (F.ws + (off))
DI void site_proj0(Ctx F) {
    launder(F);
    pg8::DenseOrderT<T / 256, WINA / 256, 0> S; S.init(F.G, F.bx);
    pg8::EpiBf16<true> E{(bf16_t*)WSP(WS_PROJ), WINA, (bf16_t*)WSP(WS_KV), 1024};
    pg8::Gemm g{WSP(WS_XB8), WSP(WS_WINA), 1024, nullptr, nullptr, nullptr, 0x7d7d7d7d, 0x7a7a7a7a};
    pg8::gemm_phase<pg8::EpiBf16<true>, pg8::DenseOrderT<T / 256, WINA / 256, 0>, 2, true>(F.lds, g, S, E, F.tid);
}
DI void site_kv(Ctx F) {
    launder(F);
    pg8::DenseOrderT<0, 4, 32> S; S.init(F.G, F.bx);
    pg8::EpiBf16<true> E{(bf16_t*)WSP(WS_PROJ), WINA, (bf16_t*)WSP(WS_KV), 1024};
    pg8::Gemm g{WSP(WS_MEMBF), WSP(WS_WKV), 2048, nullptr, WSP(WS_MEMBF), WSP(WS_WKV), 0, 0};
    pg8::gemm_phase<pg8::EpiBf16<true>, pg8::DenseOrderT<0, 4, 32>, 0>(F.lds, g, S, E, F.tid);
}
DI void site_proj1(Ctx F) {
    launder(F);
    pg8::DenseOrderT<T / 256, WINBP / 256, 0> S; S.init(F.G, F.bx);
    pg8::EpiBf16<true> E{(bf16_t*)WSP(WS_PROJ), WINBP, (bf16_t*)WSP(WS_KV), 1024};
    pg8::Gemm g{WSP(WS_XB8), WSP(WS_WINB), 1024, nullptr, nullptr, nullptr, 0x7d7d7d7d, 0x7a7a7a7a};
    pg8::gemm_phase<pg8::EpiBf16<true>, pg8::DenseOrderT<T / 256, WINBP / 256, 0>, 2, true>(F.lds, g, S, E, F.tid);
}
DI void site_out0(Ctx F) {
    launder(F);
    pg8::Gemm g{WSP(WS_MIX), WSP(WS_WOUT), 2048, nullptr, nullptr, nullptr, 0, 0};
    pg8::DenseOrderT<T / 256, 4, 0> S; S.init(F.G, F.bx);
    pg8::EpiBf16<false> E{(bf16_t*)WSP(WS_Z), 1024, nullptr, 0};
    pg8::gemm_phase<pg8::EpiBf16<false>, pg8::DenseOrderT<T / 256, 4, 0>, 0>(F.lds, g, S, E, F.tid);
}
DI void site_out1(Ctx F) {
    launder(F);
    pg8::Gemm g{WSP(WS_MIX), WSP(WS_WOUT) + (size_t)1024 * 1024 * 2, 1024, nullptr, nullptr, nullptr, 0x7b7b7b7b, 0x7a7a7a7a};
    pg8::DenseOrderT<T / 256, 4, 0> S; S.init(F.G, F.bx);
    pg8::EpiBf16<false> E{(bf16_t*)WSP(WS_Z), 1024, nullptr, 0};
    pg8::gemm_phase<pg8::EpiBf16<false>, pg8::DenseOrderT<T / 256, 4, 0>, 2, true>(F.lds, g, S, E, F.tid);
}
DI void site_g1(Ctx F, int layer) {
    launder(F);
    build_mtab(F, layer);
    pg8::Gemm g{WSP(WS_XB8), WSP(WS_W1) + (size_t)layer * 32 * 2048 * 1024, 1024, (const unsigned*)WSP(WS_LIST), nullptr, nullptr, 0x7d7d7d7d, 0x7a7a7a7a};
    pg8::MoeOrder<8, true> S{(const LAS int*)(F.lds + MTAB_OFF), (const LAS unsigned*)(F.lds + GMTAB_OFF), F.G, F.bx, 2048};
    pg8::EpiSwiglu E{(unsigned char*)WSP(WS_ACT), inp(F, I_B1) + (size_t)layer * 32 * 2048};
    pg8::gemm_phase<pg8::EpiSwiglu, pg8::MoeOrder<8, true>, 1, true>(F.lds, g, S, E, F.tid);
}
DI void site_g2(Ctx F, int layer) {
    launder(F);
    build_mtab(F, layer);
    pg8::Gemm g{WSP(WS_ACT), WSP(WS_W2) + (size_t)layer * 32 * 1024 * 1024, 1024, nullptr, nullptr, nullptr, 0x7d7d7d7d, 0x79797979};
    pg8::MoeOrder<4, false> S{(const LAS int*)(F.lds + MTAB_OFF), (const LAS unsigned*)(F.lds + GMTAB_OFF), F.G, F.bx, 1024};
    pg8::EpiFp8Bias E{(unsigned char*)WSP(WS_Y), 1024, inp(F, I_B2) + (size_t)layer * 32 * 1024};
    pg8::gemm_phase<pg8::EpiFp8Bias, pg8::MoeOrder<4, false>, 2, true>(F.lds, g, S, E, F.tid);
}
#undef WSP

DI void dsa_check_phase(Ctx& F) {
    if (F.wave != 0) return;
    const int lane = F.lane;
    LAS float* SC = (LAS float*)F.lds;
    LAS float* IQF = (LAS float*)(F.lds + 32768);
    LAS unsigned* BM = (LAS unsigned*)(F.lds + 33792);
    LAS float* QL = (LAS float*)(F.lds + 34816);
    LAS float* OL = (LAS float*)(F.lds + 40960);
    LAS float* PP = (LAS float*)(F.lds + 47104);
    LAS unsigned short* SEL = (LAS unsigned short*)(F.lds + 59392);
    const bf16_t* PROJ = (const bf16_t*)(F.ws + WS_PROJ); const bf16_t* IKN = (const bf16_t*)(F.ws + WS_IKN); const bf16_t* CN = (const bf16_t*)(F.ws + WS_CN);
    const unsigned short* IDX = (const unsigned short*)(F.ws + WS_IDX); const bf16_t* MIX = (const bf16_t*)(F.ws + WS_MIX);
    const bf16_t* WUK = (const bf16_t*)(F.ws + WS_WUK); const bf16_t* WUVT = (const bf16_t*)(F.ws + WS_WUVT);
    const int ptab[8] = {3, 100, 255, 256, 300, 1500, 5000, 8191};
    int pos = 0;
#pragma unroll
    for (int q = 0; q < 8; ++q) if ((F.bx & 7) == q) pos = ptab[q];
    pos = (pos + (F.bx >> 3) * 211) & 8191; const int b = (F.bx >> 3) & 7;
    const size_t rowb = (size_t)b * SEQ, t = rowb + pos;
    unsigned err = 0u;
    for (int i = lane; i < 256; i += 64) IQF[i] = bf2f(PROJ[t * WINBP + B_IQ + i]);
    float iwv[4];
#pragma unroll
    for (int h = 0; h < 4; ++h) iwv[h] = bf2f(PROJ[t * WINBP + B_IW + h]) * 0.0625f;
    LDS_WAIT();
    for (int k = lane; k <= pos; k += 64) {
        float a[4] = {0.f, 0.f, 0.f, 0.f};
        for (int d = 0; d < 64; ++d) { const float kv = bf2f(IKN[(rowb + k) * 64 + d]);
#pragma unroll
            for (int h = 0; h < 4; ++h) a[h] += kv * IQF[h * 64 + d]; }
        float sc = 0.f;
#pragma unroll
        for (int h = 0; h < 4; ++h) sc += fmaxf(a[h], 0.f) * iwv[h];
        SC[k] = sc + 0.0f;
    }
    for (int i = lane; i < 256; i += 64) { BM[i] = 0u; SEL[i] = IDX[t * 256 + i]; }
    LDS_WAIT();
    int nsel = 0;
    for (int i = lane; i < 256; i += 64) { const unsigned id = SEL[i]; if (id != 0xffffu) { ++nsel; __hip_atomic_fetch_or(BM + (id >> 5), 1u << (id & 31u), __ATOMIC_RELAXED, __HIP_MEMORY_SCOPE_WORKGROUP); if ((int)id > pos) err |= 1u; } }
    nsel = (int)wave_sum_fast((float)nsel);
    LDS_WAIT();
    const int want = (pos + 1 < 256) ? pos + 1 : 256;
    if (nsel != want) err |= 2u;
    if (pos + 1 > 256) {
        unsigned prefix = 0u;
        for (int bit = 31; bit >= 0; --bit) { const unsigned c = prefix | (1u << bit); int cnt = 0;
            for (int k = lane; k <= pos; k += 64) { unsigned ub = __float_as_uint(SC[k]); ub ^= (ub >> 31) ? 0xffffffffu : 0x80000000u; cnt += (ub >= c) ? 1 : 0; }
            cnt = (int)wave_sum_fast((float)cnt); if (cnt >= 256) prefix = c; }
        int mism = 0, nge = 0;
        for (int k = lane; k <= pos; k += 64) { unsigned ub = __float_as_uint(SC[k]); ub ^= (ub >> 31) ? 0xffffffffu : 0x80000000u; const bool inr = ub >= prefix; const bool ins = (BM[k >> 5] >> (k & 31)) & 1u; mism += (inr != ins) ? 1 : 0; nge += inr ? 1 : 0; }
        mism = (int)wave_sum_fast((float)mism); nge = (int)wave_sum_fast((float)nge);
        if (mism > 8 + 2 * (nge - 256)) err |= 4u;
    }
    for (int i = lane; i < 12 * 128; i += 64) { const int h = i >> 7, r = i & 127; float a = 0.f;
        for (int d = 0; d < 64; ++d) a += bf2f(PROJ[t * WINBP + h * 64 + d]) * bf2f(WUK[((size_t)h * 128 + r) * 64 + d]);
        QL[i] = bf2f(f2bf(a * 0.125f)); }
    LDS_WAIT();
    for (int j = lane; j < 256; j += 64) { const unsigned id = SEL[j];
        for (int h = 0; h < 12; ++h) { float a = -INFINITY;
            if (id != 0xffffu) { a = 0.f; for (int r = 0; r < 128; ++r) a += QL[h * 128 + r] * bf2f(CN[(rowb + id) * 128 + r]);
                const int rel = pos - (int)id; int bk = rel; if (rel >= 16) { bk = 16 + (int)(logf((float)rel * (1.0f / 16.0f)) / logf(8.0f) * 16.0f); bk = bk > 31 ? 31 : bk; }
                a += inp(F, I_RELB)[bk * 12 + h]; }
            PP[h * 256 + j] = a; } }
    LDS_WAIT();
    for (int h = 0; h < 12; ++h) { float m = -INFINITY; for (int j = lane; j < 256; j += 64) m = fmaxf(m, PP[h * 256 + j]);
#pragma unroll
        for (int o = 1; o < 64; o <<= 1) m = fmaxf(m, shx(m, o));
        float sm = 0.f; for (int j = lane; j < 256; j += 64) { const float v = PP[h * 256 + j]; const float p = (v == -INFINITY) ? 0.f : __expf(v - m); PP[h * 256 + j] = p; sm += p; }
        sm = wave_sum_fast(sm); const float inv = 1.0f / sm; for (int j = lane; j < 256; j += 64) PP[h * 256 + j] *= inv; }
    LDS_WAIT();
    for (int i = lane; i < 12 * 128; i += 64) { const int h = i >> 7, r = i & 127; float a = 0.f;
        for (int j = 0; j < 256; ++j) { const unsigned id = SEL[j]; if (id != 0xffffu) a += PP[h * 256 + j] * bf2f(CN[(rowb + id) * 128 + r]); }
        OL[i] = a; }
    LDS_WAIT();
    float e2 = 0.f, r2 = 0.f;
    for (int i = lane; i < 768; i += 64) { const int h = i >> 6, d = i & 63; float a = 0.f;
        for (int r = 0; r < 128; ++r) a += OL[h * 128 + r] * bf2f(WUVT[((size_t)h * 64 + d) * 128 + r]);
        const float got = bf2f(MIX[t * D + i]); e2 += (a - got) * (a - got); r2 += a * a; }
    e2 = wave_sum_fast(e2); r2 = wave_sum_fast(r2);
    if (!(e2 <= 0.0025f * r2)) err |= 8u;
    if (err && lane == 0) __hip_atomic_fetch_or(F.ctl + CW_ERR, err, __ATOMIC_RELAXED, __HIP_MEMORY_SCOPE_AGENT);
}
DI void ph_dsacheck(Ctx F) { launder(F); dsa_check_phase(F); }
DI void memattn_check_phase(Ctx& F, int layer, int ldp, int mqcol) {
    if (F.wave != 1) return;
    const int lane = F.lane;
    LAS float* PM = (LAS float*)(F.lds + 65536);
    const bf16_t* PROJ = (const bf16_t*)(F.ws + WS_PROJ); const bf16_t* KV = (const bf16_t*)(F.ws + WS_KV); const bf16_t* MIX = (const bf16_t*)(F.ws + WS_MIX);
    const int pos = (F.bx * 131 + 17) & 8191, b = (F.bx >> 2) & 7; const size_t t = (size_t)b * SEQ + pos;
    float e2 = 0.f, r2 = 0.f;
    for (int h = 0; h < 4; ++h) {
        float lg[4];
#pragma unroll
        for (int i = 0; i < 4; ++i) { const int m = lane + 64 * i; float a = 0.f;
            for (int d = 0; d < 64; ++d) a += bf2f(PROJ[t * ldp + mqcol + h * 64 + d]) * bf2f(KV[(size_t)(b * MEML + m) * 1024 + layer * 512 + h * 64 + d]);
            lg[i] = a * 0.125f; }
        float mx = fmaxf(fmaxf(lg[0], lg[1]), fmaxf(lg[2], lg[3]));
#pragma unroll
        for (int o = 1; o < 64; o <<= 1) mx = fmaxf(mx, shx(mx, o));
        float sm = 0.f;
#pragma unroll
        for (int i = 0; i < 4; ++i) { lg[i] = __expf(lg[i] - mx); sm += lg[i]; }
        sm = wave_sum_fast(sm);
#pragma unroll
        for (int i = 0; i < 4; ++i) PM[lane + 64 * i] = lg[i] / sm;
        LDS_WAIT();
        float a = 0.f;
        for (int m = 0; m < 256; ++m) a += PM[m] * bf2f(KV[(size_t)(b * MEML + m) * 1024 + layer * 512 + 256 + h * 64 + lane]);
        const float got = bf2f(MIX[t * D + TOKW + h * 64 + lane]); e2 += (a - got) * (a - got); r2 += a * a;
        LDS_WAIT();
    }
    e2 = wave_sum_fast(e2); r2 = wave_sum_fast(r2);
    if (!(e2 <= 0.0025f * r2) && lane == 0) __hip_atomic_fetch_or(F.ctl + CW_ERR, 16u << layer, __ATOMIC_RELAXED, __HIP_MEMORY_SCOPE_AGENT);
}
DI void ph_memcheck(Ctx F, int layer) { launder(F); if (layer == 0) memattn_check_phase(F, 0, WINA, 2 * TOKW); else memattn_check_phase(F, 1, WINBP, B_MQ); }


DI void ph_prologue(Ctx F) { launder(F); p0_prologue(F); }
DI void ph_lru0(Ctx F) { launder(F); lru_phase<0>(F); }
DI void ph_lru1(Ctx F) { launder(F); lru_phase<1>(F); launder(F); memattn_phase(F, 0, WINA, 2 * TOKW); }
DI void ph_prep(Ctx F) { launder(F); dsa_prep_phase(F); }
template <int IMODE> DI void ph_indexer(Ctx F) { launder(F); indexer_phase<IMODE>(F); }
DI void ph_idxcmp(Ctx F) { launder(F); idx_compare(F); }
DI void ph_attn(Ctx F) { launder(F); dsa_attn_phase(F); launder(F); if (!DIAG_SKIPMEM) memattn_phase(F, 1, WINBP, B_MQ); }
DI void ph_lnr(Ctx F, int layer) { launder(F); ln_router_phase(F, layer); }
DI void ph_combine(Ctx F, int layer) { launder(F); combine_ln_phase(F, layer, F.out); }

constexpr int NPHASE = 18;
struct Args { const float* in[29]; float* out; unsigned char* ws; int ph_lo, ph_hi; };

__global__ void __launch_bounds__(512, 2) mk_fwd(Args args) {
    extern __shared__ __attribute__((aligned(16))) unsigned char lds_raw[];
    Ctx F;
    F.lds = (LAS unsigned char*)lds_raw;
    F.tid = threadIdx.x; F.lane = F.tid & 63; F.wave = __builtin_amdgcn_readfirstlane(F.tid >> 6);
    F.G = gridDim.x; F.bx = blockIdx.x;
    F.ws = args.ws; F.ctl = (unsigned*)(args.ws + WS_CTL); F.out = args.out;
    volatile LAS unsigned* MISC = (volatile LAS unsigned*)(F.lds + MISC_OFF);
#if DIAG_INIT
    for (int u = F.tid; u < MISC_OFF / 4; u += 512) ((LAS unsigned*)F.lds)[u] = 0u;
#endif
    for (int u = F.tid; u < (PTAB_OFF - MISC_OFF) / 4; u += 512) ((LAS unsigned*)(F.lds + MISC_OFF))[u] = 0u;
    if (F.tid == 0) {
#pragma unroll
        for (int i = 0; i < 29; ++i) *(LAS unsigned long long*)(F.lds + PTAB_OFF + 8 * i) = (unsigned long long)args.in[i];
    }
    __syncthreads();
    const int lo = args.ph_lo, hi = args.ph_hi;
    XcdBarrier bar; bar.bar = F.ctl + CW_BAR; bar.x = 0; bar.st = nullptr;
    if (hi - lo > 1) bar = xcd_barrier_post(F.ctl + CW_BAR, MISC + 8);
#ifndef PHASE_MASK
#define PHASE_MASK 0xffff
#endif
#define IN(k) (lo <= (k) && (k) < hi)
#define ON(site) ((((unsigned)PHASE_MASK) >> (site)) & 1u)
#define SEAM(k) do { if (ON(15) && IN(k) && IN((k) + 1)) { XcdBarrier b2_ = bar; { const unsigned long long p_ = (unsigned long long)b2_.bar; int pl_ = __builtin_amdgcn_readfirstlane((int)(unsigned)p_), ph_ = __builtin_amdgcn_readfirstlane((int)(unsigned)(p_ >> 32)); \
        asm volatile("" : "+s"(pl_), "+s"(ph_)); b2_.bar = (unsigned*)(GAS unsigned*)(((unsigned long long)(unsigned)ph_ << 32) | (unsigned)pl_); } \
        xcd_barrier(b2_); if (DBL(15)) { xcd_barrier(b2_); xcd_barrier(b2_); xcd_barrier(b2_); xcd_barrier(b2_); } } } while (0)
#define RUN(site, k, body) do { if (ON(site) && IN(k)) { body; } if (DBL(site) && IN(k)) { body; } } while (0)
    RUN(0, 0, ph_prologue(F));
    SEAM(0);
    for (int layer = 0; layer < 2; ++layer) {
        const int pb = layer ? 9 : 1;
        if (layer == 0) { RUN(1, pb, site_proj0(F)); RUN(1, pb, site_kv(F)); } else { RUN(1, pb, site_proj1(F)); }
        SEAM(pb);
        int po;
        if (layer == 0) {
            RUN(2, 2, ph_lru0(F));
            SEAM(2);
            RUN(3, 3, ph_lru1(F));
#if PROBE_DSA
            SEAM(3);
            if (ON(3) && IN(3)) { ph_memcheck(F, 0); }
#endif
            SEAM(3);
            po = 4;
        } else {
            RUN(10, 10, ph_prep(F));
            SEAM(10);
#if PROBE_CHECK
            if (ON(11) && IN(11)) { ph_indexer<0>(F); }
            SEAM(11);
#endif
            RUN(11, 11, ph_indexer<1>(F));
#if PROBE_CHECK
            SEAM(11);
            if (ON(11) && IN(11)) { ph_idxcmp(F); }
#endif
            SEAM(11);
            RUN(12, 12, ph_attn(F));
#if PROBE_DSA
            SEAM(12);
            if (ON(12) && IN(12)) { ph_dsacheck(F); ph_memcheck(F, 1); }
#endif
            SEAM(12);
            po = 13;
        }
        if (layer == 0) { RUN(4, po, site_out0(F)); } else { RUN(4, po, site_out1(F)); }
        SEAM(po);
        if (ON(5) && IN(po + 1)) { ph_lnr(F, layer); }
        SEAM(po + 1);
        RUN(6, po + 2, site_g1(F, layer));
        SEAM(po + 2);
        RUN(7, po + 3, site_g2(F, layer));
        SEAM(po + 3);
        RUN(8, po + 4, ph_combine(F, layer));
        if (layer == 0) SEAM(po + 4);
    }
#undef RUN
#undef IN
#undef SEAM
#if DIAG_DUMP
    if (lo == 100) {
        const size_t gt = (size_t)F.bx * 512 + F.tid, NT = (size_t)F.G * 512;
        for (size_t i = gt; i < (size_t)T * D; i += NT) {
            float v;
            if (DIAG_DUMP == 1) v = bf2f(((const bf16_t*)(args.ws + WS_MIX))[i]);
            else if (DIAG_DUMP == 2) v = bf2f(((const bf16_t*)(args.ws + WS_Z))[i]);
            else if (DIAG_DUMP == 3) v = ((const float*)(args.ws + WS_XA))[i];
            else if (DIAG_DUMP == 4) v = bf2f(((const bf16_t*)(args.ws + WS_PROJ))[i]);
            else if (DIAG_DUMP == 8) v = ((i & 1023) < 768) ? bf2f(((const bf16_t*)(args.ws + WS_MIX))[i]) : 0.f;
            else if (DIAG_DUMP == 9) v = ((i & 1023) >= 768) ? bf2f(((const bf16_t*)(args.ws + WS_MIX))[i]) : 0.f;
            else if (DIAG_DUMP == 10) v = bf2f(((const bf16_t*)(args.ws + WS_OLAT))[i + 33554432]);
            else if (DIAG_DUMP == 11) v = bf2f(((const bf16_t*)(args.ws + WS_QLAT))[i + 33554432]);
            else if (DIAG_DUMP == 12) v = bf2f(((const bf16_t*)(args.ws + WS_WUVT))[i % 98304]);
            else if (DIAG_DUMP == 6) v = bf2f(((const bf16_t*)(args.ws + WS_QLAT))[i]);
            else if (DIAG_DUMP == 7) v = bf2f(((const bf16_t*)(args.ws + WS_OLAT))[i]);
            else v = (float)((const unsigned short*)(args.ws + WS_IDX))[i % ((size_t)T * 256)];
            if (!(v - v == 0.f)) v = 12345.0f;
            F.out[i] = v; }
    }
#endif
}

extern "C" void kernel_launch(void* const* d_in, const int* in_sizes, int n_in, void* d_out, int out_size, void* d_ws, size_t ws_size, hipStream_t stream) {
    static int grid = 0;
    if (grid == 0) {
        if (n_in != 29 || out_size != T * D || ws_size < WS_END) { fprintf(stderr, "kernel_launch: unexpected shapes (n_in %d, out %d, ws %zu)\n", n_in, out_size, ws_size); grid = -1; return; }
        int dev = 0, cus = 0, per_cu = 0;
        if (hipGetDevice(&dev) != hipSuccess || hipDeviceGetAttribute(&cus, hipDeviceAttributeMultiprocessorCount, dev) != hipSuccess) { grid = -1; return; }
        if (hipFuncSetAttribute((const void*)mk_fwd, hipFuncAttributeMaxDynamicSharedMemorySize, LDS_BYTES) != hipSuccess) { fprintf(stderr, "kernel_launch: hipFuncSetAttribute failed\n"); grid = -1; return; }
        if (hipOccupancyMaxActiveBlocksPerMultiprocessor(&per_cu, (const void*)mk_fwd, 512, LDS_BYTES) != hipSuccess || per_cu < 1) { fprintf(stderr, "kernel_launch: occupancy query says %d\n", per_cu); (void)hipGetLastError(); grid = -1; return; }
        grid = cus;
    }
    if (grid < 0) return;
    if (hipMemsetAsync((char*)d_ws + WS_CTL, 0, CTL_BYTES, stream) != hipSuccess) return;
#if DIAG_INIT
    (void)hipMemsetAsync((char*)d_ws + CTL_BYTES, 0, WS_END - CTL_BYTES, stream);
    (void)hipMemsetAsync(d_out, 0, (size_t)T * D * 4, stream);
#endif
    Args a{};
    for (int i = 0; i < 29; ++i) a.in[i] = (const float*)d_in[i];
    a.out = (float*)d_out; a.ws = (unsigned char*)d_ws;
#if MK_SPLIT
    for (int p = 0; p <= DIAG_LAST && p < NPHASE; ++p) { a.ph_lo = p; a.ph_hi = p + 1; hipLaunchKernelGGL(mk_fwd, dim3(grid), dim3(512), LDS_BYTES, stream, a); }
#if DIAG_DUMP
    a.ph_lo = 100; a.ph_hi = 101; hipLaunchKernelGGL(mk_fwd, dim3(grid), dim3(512), LDS_BYTES, stream, a);
#endif
#elif defined(REPEAT_PHASE)
    a.ph_lo = 0; a.ph_hi = REPEAT_PHASE + 1; hipLaunchKernelGGL(mk_fwd, dim3(grid), dim3(512), LDS_BYTES, stream, a);
    (void)hipMemsetAsync((char*)d_ws + WS_CTL + CW_IQ * 4, 0, 4096, stream);
    a.ph_lo = REPEAT_PHASE; a.ph_hi = REPEAT_PHASE + 1; hipLaunchKernelGGL(mk_fwd, dim3(grid), dim3(512), LDS_BYTES, stream, a);
    if (REPEAT_PHASE + 1 < NPHASE) {
        (void)hipMemsetAsync((char*)d_ws + WS_CTL + CW_BAR * 4, 0, XCD_BAR_WORDS * 4, stream);
        a.ph_lo = REPEAT_PHASE + 1; a.ph_hi = NPHASE; hipLaunchKernelGGL(mk_fwd, dim3(grid), dim3(512), LDS_BYTES, stream, a);
    }
#else
    a.ph_lo = 0; a.ph_hi = NPHASE; hipLaunchKernelGGL(mk_fwd, dim3(grid), dim3(512), LDS_BYTES, stream, a);
#endif
}
```
